# Optimizing an MI355X kernel written in HIP

```python
import math
import jax
import jax.numpy as jnp
from jax import lax
import numpy as np

D_MODEL = 1024
BATCH = 8
SEQ = 2048
DEPTH = 2

CTX_LEN = 256
GRID_W = 64
HEAD_DIM = 64
ROPE_THETA = 10000.0
Q_BLOCK = 128
A_Q_HEADS = 8
A_KV_HEADS = 2
A_GROUP = A_Q_HEADS // A_KV_HEADS
A_Q_W = A_Q_HEADS * HEAD_DIM
A_KV_W = A_KV_HEADS * HEAD_DIM
F_GROUPS = 4
F_GROUP_W = 128
B_W = F_GROUPS * F_GROUP_W
C_HEADS = 4
C_V_DIM = 2 * HEAD_DIM
C_QK_W = C_HEADS * 2 * HEAD_DIM
C_V_W = C_HEADS * C_V_DIM
N_BRANCH = 3
GATE_W = N_BRANCH * D_MODEL
IN_W = A_Q_W + 2 * A_KV_W + B_W + 2 * C_QK_W + C_V_W + GATE_W
N_EXPERTS = 256
TOP_K = 8
N_GROUPS = 8
TOPK_GROUPS = 4
EXPERT_FF = 256
SHARED_FF = 256
ROUTED_SCALE = 2.5
MOE_BLOCK = 128
DEEPNORM_ALPHA = (2 * DEPTH) ** 0.25
DEEPNORM_BETA = (8 * DEPTH) ** -0.25
LN_EPS = 1e-5
RMS_EPS = 1e-6

kernel_name = 'hybrid_gqa_fourier_diffattn_moe_dit'


def _layer_norm(x, g=None, b=None):
    xf = x.astype(jnp.float32)
    mu = jnp.mean(xf, -1, keepdims=True)
    var = jnp.mean(jnp.square(xf - mu), -1, keepdims=True)
    y = (xf - mu) * lax.rsqrt(var + LN_EPS)
    if g is not None:
        y = y * g.astype(jnp.float32) + b.astype(jnp.float32)
    return y.astype(x.dtype)


def _rms_norm(x, g):
    xf = x.astype(jnp.float32)
    y = xf * lax.rsqrt(jnp.mean(xf * xf, -1, keepdims=True) + RMS_EPS)
    return (y * g.astype(jnp.float32)).astype(x.dtype)


def _modulate(h, shift, scale):
    return _layer_norm(h) * (1 + scale) + shift


def _axial_rope_tables(n_tok):
    rows_n = n_tok // GRID_W
    row = jnp.repeat(jnp.arange(rows_n, dtype=jnp.float32), GRID_W)
    col = jnp.tile(jnp.arange(GRID_W, dtype=jnp.float32), rows_n)
    axis_dim = HEAD_DIM // 2
    inv = jnp.power(ROPE_THETA, -jnp.arange(0, axis_dim, 2, dtype=jnp.float32) / axis_dim)
    ar = row[:, None] * inv[None]
    ac = col[:, None] * inv[None]
    ang = jnp.concatenate([ar, ar, ac, ac], -1)
    return jnp.cos(ang), jnp.sin(ang)


def _apply_rope(x, cos, sin):
    shape = (1, x.shape[1]) + (1,) * (x.ndim - 3) + (x.shape[-1],)
    cs = cos.reshape(shape).astype(x.dtype)
    sn = sin.reshape(shape).astype(x.dtype)
    a, b, c, d = jnp.split(x, 4, axis=-1)
    rot = jnp.concatenate([-b, a, -d, c], -1)
    return x * cs + rot * sn


def _blocks(t):
    b, s = t.shape[:2]
    t = t.reshape((b, s // Q_BLOCK, Q_BLOCK) + t.shape[2:])
    return jnp.moveaxis(t, 1, 0)


def _unblocks(t):
    t = jnp.moveaxis(t, 0, 1)
    return t.reshape((t.shape[0], t.shape[1] * t.shape[2]) + t.shape[3:])


def _gqa_attend(q, k, v):
    scale = HEAD_DIM ** -0.5

    def one(qb):
        s = jnp.einsum('bqhgd,bkhd->bhgqk', qb, k).astype(jnp.float32) * scale
        p = jax.nn.softmax(s, axis=-1).astype(v.dtype)
        return jnp.einsum('bhgqk,bkhd->bqhgd', p, v)

    return _unblocks(lax.map(one, _blocks(q)))


def _diff_attend(q1, q2, k1, k2, v, lam):
    scale = HEAD_DIM ** -0.5

    def one(qs):
        a, b = qs
        p1 = jax.nn.softmax(jnp.einsum('bqhd,bkhd->bhqk', a, k1).astype(jnp.float32) * scale, axis=-1)
        p2 = jax.nn.softmax(jnp.einsum('bqhd,bkhd->bhqk', b, k2).astype(jnp.float32) * scale, axis=-1)
        p = (p1 - lam * p2).astype(v.dtype)
        return jnp.einsum('bhqk,bkhe->bqhe', p, v)

    return _unblocks(lax.map(one, (_blocks(q1), _blocks(q2))))


def _fourier_mix(f):
    y = jnp.fft.fft2(f.astype(jnp.float32), axes=(1, 3), norm='ortho')
    return jnp.real(y).astype(f.dtype)


def _split_in(p):
    sizes = [A_Q_W, A_KV_W, A_KV_W, B_W, C_QK_W, C_QK_W, C_V_W, GATE_W]
    idx = [int(v) for v in np.cumsum(sizes)[:-1]]
    return jnp.split(p, idx, axis=-1)


def _mixer_inputs(u, w_in, qn, kn, rope):
    b, s, _ = u.shape
    qa, ka, va, fb, qc, kc, vc, gates = _split_in(u @ w_in)
    qa = _rms_norm(qa.reshape(b, s, A_KV_HEADS, A_GROUP, HEAD_DIM), qn)
    ka = _rms_norm(ka.reshape(b, s, A_KV_HEADS, HEAD_DIM), kn)
    va = va.reshape(b, s, A_KV_HEADS, HEAD_DIM)
    qc = qc.reshape(b, s, C_HEADS, 2, HEAD_DIM)
    kc = kc.reshape(b, s, C_HEADS, 2, HEAD_DIM)
    vc = vc.reshape(b, s, C_HEADS, C_V_DIM)
    if rope is not None:
        cos, sin = rope
        qa = _apply_rope(qa, cos, sin)
        ka = _apply_rope(ka, cos, sin)
        qc = _apply_rope(qc, cos, sin)
        kc = _apply_rope(kc, cos, sin)
    return {'qa': qa, 'ka': ka, 'va': va, 'fb': fb, 'qc': qc, 'kc': kc, 'vc': vc, 'gates': gates}


def _mixer_output(pq, k_a, v_a, k_c, v_c, lam, lam_init, subln_g, w_br_a, w_br_b, w_br_c, w_out):
    b, s = pq['fb'].shape[:2]
    o_a = _gqa_attend(pq['qa'], k_a, v_a).reshape(b, s, A_Q_W)
    o_b = _fourier_mix(pq['fb'].reshape(b, s, F_GROUPS, F_GROUP_W)).reshape(b, s, B_W)
    o_c = _diff_attend(pq['qc'][..., 0, :], pq['qc'][..., 1, :], k_c[..., 0, :], k_c[..., 1, :], v_c, lam)
    o_c = (_rms_norm(o_c, subln_g) * (1.0 - lam_init)).reshape(b, s, C_V_W)
    g = jax.nn.sigmoid(pq['gates'].reshape(b, s, N_BRANCH, D_MODEL))
    y = g[:, :, 0] * (o_a @ w_br_a) + g[:, :, 1] * (o_b @ w_br_b) + g[:, :, 2] * (o_c @ w_br_c)
    return y @ w_out


def _swiglu(h, wg, wu, wd):
    return (jax.nn.silu(h @ wg) * (h @ wu)) @ wd


def _route(h, w_r, b_r):
    t = h.shape[0]
    scores = jax.nn.sigmoid((h @ w_r).astype(jnp.float32))
    biased = scores + b_r.astype(jnp.float32)
    grp = biased.reshape(t, N_GROUPS, N_EXPERTS // N_GROUPS)
    grp_score = jnp.sum(lax.top_k(grp, 2)[0], -1)
    _, gidx = lax.top_k(grp_score, TOPK_GROUPS)
    gmask = jnp.sum(jax.nn.one_hot(gidx, N_GROUPS, dtype=jnp.float32), 1) > 0
    emask = jnp.repeat(gmask, N_EXPERTS // N_GROUPS, axis=1)
    _, idx = lax.top_k(jnp.where(emask, biased, -jnp.inf), TOP_K)
    w = jnp.take_along_axis(scores, idx, -1)
    w = w / jnp.sum(w, -1, keepdims=True) * ROUTED_SCALE
    return idx, w


def _routed_experts(h, idx, w, wg, wu, wd):
    t, d = h.shape
    n_assign = t * TOP_K
    n_slots = (n_assign + N_EXPERTS * (MOE_BLOCK - 1) + MOE_BLOCK - 1) // MOE_BLOCK * MOE_BLOCK
    nb = n_slots // MOE_BLOCK
    flat_e = idx.reshape(-1)
    flat_t = jnp.repeat(jnp.arange(t, dtype=jnp.int32), TOP_K)
    flat_w = w.reshape(-1)
    order = jnp.argsort(flat_e)
    e_sorted = flat_e[order]
    counts = jnp.bincount(flat_e, length=N_EXPERTS)
    padded = (counts + MOE_BLOCK - 1) // MOE_BLOCK * MOE_BLOCK
    pad_end = jnp.cumsum(padded)
    pad_start = pad_end - padded
    start = jnp.cumsum(counts) - counts
    dest = pad_start[e_sorted] + jnp.arange(n_assign, dtype=jnp.int32) - start[e_sorted]
    slot_tok = jnp.full((n_slots,), t, jnp.int32).at[dest].set(flat_t[order])
    slot_w = jnp.zeros((n_slots,), flat_w.dtype).at[dest].set(flat_w[order])
    blk_start = jnp.arange(nb, dtype=jnp.int32) * MOE_BLOCK
    blk_e = jnp.minimum(jnp.searchsorted(pad_end, blk_start, side='right'), N_EXPERTS - 1)
    h_pad = jnp.concatenate([h, jnp.zeros((1, d), h.dtype)], 0)

    def one(args):
        tok, e = args
        return _swiglu(h_pad[tok], wg[e], wu[e], wd[e])

    y = lax.map(one, (slot_tok.reshape(nb, MOE_BLOCK), blk_e))
    y = y.reshape(n_slots, d) * slot_w[:, None].astype(h.dtype)
    return jnp.zeros((t + 1, d), h.dtype).at[slot_tok].add(y)[:t]


def _moe(h, w_r, b_r, sg, su, sd, eg, eu, ed):
    idx, w = _route(h, w_r, b_r)
    return _swiglu(h, sg, su, sd) + _routed_experts(h, idx, w, eg, eu, ed)


def setup_inputs(seed: int = 0) -> dict:
    key = jax.random.key(seed)
    ks = jax.random.split(key, 32)
    D = D_MODEL

    def nrm(k, shape, s):
        return jax.random.normal(k, shape, jnp.float32) * s

    return {
        'x': nrm(ks[0], (BATCH, SEQ, D), 1.0),
        'c': nrm(ks[1], (BATCH, D), 1.0),
        'ctx': nrm(ks[2], (BATCH, CTX_LEN, D), 1.0),
        'c_ctx': nrm(ks[3], (D,), 1.0),
        'w_mod': nrm(ks[4], (DEPTH, D, 6 * D), 0.5 * D ** -0.5),
        'b_mod': nrm(ks[5], (DEPTH, 6 * D), 0.02),
        'w_in': nrm(ks[6], (DEPTH, D, IN_W), D ** -0.5),
        'qn_a': 1.0 + nrm(ks[7], (DEPTH, HEAD_DIM), 0.02),
        'kn_a': 1.0 + nrm(ks[8], (DEPTH, HEAD_DIM), 0.02),
        'lam_q1': nrm(ks[9], (DEPTH, HEAD_DIM), 0.1),
        'lam_k1': nrm(ks[10], (DEPTH, HEAD_DIM), 0.1),
        'lam_q2': nrm(ks[11], (DEPTH, HEAD_DIM), 0.1),
        'lam_k2': nrm(ks[12], (DEPTH, HEAD_DIM), 0.1),
        'subln_c': 1.0 + nrm(ks[13], (DEPTH, C_V_DIM), 0.02),
        'w_br_a': nrm(ks[14], (DEPTH, A_Q_W, D), A_Q_W ** -0.5),
        'w_br_b': nrm(ks[15], (DEPTH, B_W, D), B_W ** -0.5),
        'w_br_c': nrm(ks[16], (DEPTH, C_V_W, D), C_V_W ** -0.5),
        'w_out': nrm(ks[17], (DEPTH, D, D), DEEPNORM_BETA * D ** -0.5),
        'ln1_g': 1.0 + nrm(ks[18], (DEPTH, D), 0.02),
        'ln1_b': nrm(ks[19], (DEPTH, D), 0.02),
        'w_router': nrm(ks[20], (DEPTH, D, N_EXPERTS), D ** -0.5),
        'b_router': nrm(ks[21], (DEPTH, N_EXPERTS), 0.01),
        'w_sh_gate': nrm(ks[22], (DEPTH, D, SHARED_FF), D ** -0.5),
        'w_sh_up': nrm(ks[23], (DEPTH, D, SHARED_FF), D ** -0.5),
        'w_sh_down': nrm(ks[24], (DEPTH, SHARED_FF, D), DEEPNORM_BETA * SHARED_FF ** -0.5),
        'w_e_gate': nrm(ks[25], (DEPTH, N_EXPERTS, D, EXPERT_FF), D ** -0.5),
        'w_e_up': nrm(ks[26], (DEPTH, N_EXPERTS, D, EXPERT_FF), D ** -0.5),
        'w_e_down': nrm(ks[27], (DEPTH, N_EXPERTS, EXPERT_FF, D), DEEPNORM_BETA * EXPERT_FF ** -0.5),
        'ln2_g': 1.0 + nrm(ks[28], (DEPTH, D), 0.02),
        'ln2_b': nrm(ks[29], (DEPTH, D), 0.02),
    }


def reference(x, c, ctx, c_ctx, w_mod, b_mod, w_in, qn_a, kn_a, lam_q1, lam_k1, lam_q2, lam_k2,
              subln_c, w_br_a, w_br_b, w_br_c, w_out, ln1_g, ln1_b, w_router, b_router,
              w_sh_gate, w_sh_up, w_sh_down, w_e_gate, w_e_up, w_e_down, ln2_g, ln2_b):
    b, s, d = x.shape
    lc = ctx.shape[1]
    rope = _axial_rope_tables(s)
    sc = jax.nn.silu(c)
    scc = jax.nn.silu(c_ctx)
    h_lat, h_ctx = x, ctx
    for l in range(DEPTH):
        last = l == DEPTH - 1
        m_lat = (sc @ w_mod[l] + b_mod[l]).reshape(b, 1, 6, d)
        m_ctx = (scc @ w_mod[l] + b_mod[l]).reshape(1, 1, 6, d)
        lam = (jnp.exp(jnp.sum(lam_q1[l].astype(jnp.float32) * lam_k1[l].astype(jnp.float32)))
               - jnp.exp(jnp.sum(lam_q2[l].astype(jnp.float32) * lam_k2[l].astype(jnp.float32))))
        lam_init = 0.8 - 0.6 * math.exp(-0.3 * l)
        lam = lam + lam_init

        u_lat = _modulate(h_lat, m_lat[:, :, 0], m_lat[:, :, 1])
        u_ctx = _modulate(h_ctx, m_ctx[:, :, 0], m_ctx[:, :, 1])
        p_lat = _mixer_inputs(u_lat, w_in[l], qn_a[l], kn_a[l], rope)
        p_ctx = _mixer_inputs(u_ctx, w_in[l], qn_a[l], kn_a[l], None)
        ka_all = jnp.concatenate([p_ctx['ka'], p_lat['ka']], 1)
        va_all = jnp.concatenate([p_ctx['va'], p_lat['va']], 1)
        kc_all = jnp.concatenate([p_ctx['kc'], p_lat['kc']], 1)
        vc_all = jnp.concatenate([p_ctx['vc'], p_lat['vc']], 1)
        mix_lat = _mixer_output(p_lat, ka_all, va_all, kc_all, vc_all, lam, lam_init, subln_c[l],
                                w_br_a[l], w_br_b[l], w_br_c[l], w_out[l])
        h_lat = _layer_norm(DEEPNORM_ALPHA * h_lat + m_lat[:, :, 2] * mix_lat, ln1_g[l], ln1_b[l])
        if not last:
            mix_ctx = _mixer_output(p_ctx, p_ctx['ka'], p_ctx['va'], p_ctx['kc'], p_ctx['vc'], lam, lam_init,
                                    subln_c[l], w_br_a[l], w_br_b[l], w_br_c[l], w_out[l])
            h_ctx = _layer_norm(DEEPNORM_ALPHA * h_ctx + m_ctx[:, :, 2] * mix_ctx, ln1_g[l], ln1_b[l])

        u_lat = _modulate(h_lat, m_lat[:, :, 3], m_lat[:, :, 4])
        moe_args = (w_router[l], b_router[l], w_sh_gate[l], w_sh_up[l], w_sh_down[l],
                    w_e_gate[l], w_e_up[l], w_e_down[l])
        if not last:
            u_ctx = _modulate(h_ctx, m_ctx[:, :, 3], m_ctx[:, :, 4])
            tok = jnp.concatenate([u_ctx.reshape(-1, d), u_lat.reshape(-1, d)], 0)
            f = _moe(tok, *moe_args)
            f_ctx = f[: b * lc].reshape(b, lc, d)
            f_lat = f[b * lc:].reshape(b, s, d)
            h_ctx = _layer_norm(DEEPNORM_ALPHA * h_ctx + m_ctx[:, :, 5] * f_ctx, ln2_g[l], ln2_b[l])
        else:
            f_lat = _moe(u_lat.reshape(-1, d), *moe_args).reshape(b, s, d)
        h_lat = _layer_norm(DEEPNORM_ALPHA * h_lat + m_lat[:, :, 5] * f_lat, ln2_g[l], ln2_b[l])
    return h_lat
```

```cpp
#include <hip/hip_runtime.h>
#include <stdint.h>
#include <stdio.h>

#define DM 1024
#define NBATCH 8
#define SEQ 2048
#define CTXL 256
#define LTOT 2304
#define T_ALL 18432
#define IN_W 5888
#define PW 6400
#define C_QA 0
#define C_KA 512
#define C_VA 640
#define C_FA 768
#define C_QC 1792
#define C_KC 2304
#define C_VC 2816
#define C_G 3328
#define NEXP 256
#define NSLOT (T_ALL * 8)
#define NTHR 512
#define LDS_BYTES 163840
#define ALPHA 1.41421356237f

typedef unsigned short bf16_t;
#define ACT_BF16 1
#ifdef ACT_BF16
typedef bf16_t act_t;
#else
typedef float act_t;
#endif

__device__ __forceinline__ float bf2f(bf16_t v) { return __uint_as_float(((unsigned)v) << 16); }
__device__ __forceinline__ bf16_t f2bf(float f) { unsigned u = __float_as_uint(f); u += 0x7FFFu + ((u >> 16) & 1u); return (bf16_t)(u >> 16); }
__device__ __forceinline__ float ldv(const float* p, size_t i) { return p[i]; }
__device__ __forceinline__ float ldv(const bf16_t* p, size_t i) { return bf2f(p[i]); }
__device__ __forceinline__ void stv(float* p, size_t i, float v) { p[i] = v; }
__device__ __forceinline__ void stv(bf16_t* p, size_t i, float v) { p[i] = f2bf(v); }
__device__ __forceinline__ float4 ld4(const float* p, size_t i) { return *(const float4*)(p + i); }
__device__ __forceinline__ float4 ld4(const bf16_t* p, size_t i) { uint2 r = *(const uint2*)(p + i); float4 o; o.x = __uint_as_float(r.x << 16); o.y = __uint_as_float(r.x & 0xFFFF0000u); o.z = __uint_as_float(r.y << 16); o.w = __uint_as_float(r.y & 0xFFFF0000u); return o; }
__device__ __forceinline__ void st4(float* p, size_t i, float4 v) { *(float4*)(p + i) = v; }
__device__ __forceinline__ void st4(bf16_t* p, size_t i, float4 v) { uint2 r; r.x = (unsigned)f2bf(v.x) | ((unsigned)f2bf(v.y) << 16); r.y = (unsigned)f2bf(v.z) | ((unsigned)f2bf(v.w) << 16); *(uint2*)(p + i) = r; }

#define XB_TMO      128
#define XB_XCNT(j)  (256  + 64 * (j))
#define XB_XSUB(j)  (1280 + 64 * (j))
#define XB_XGEN(j)  (2304 + 64 * (j))
#define XB_TOP      3328
#define XB_TOPGEN   3392
#define XCD_BAR_WORDS 3456
#define XB_SPIN_CAP (1u << 27)
#define LAS __attribute__((address_space(3)))

__device__ __forceinline__ unsigned xb_ld(unsigned* p)              { return __hip_atomic_load(p, __ATOMIC_RELAXED, __HIP_MEMORY_SCOPE_AGENT); }
__device__ __forceinline__ unsigned xb_add(unsigned* p, unsigned v) { return __hip_atomic_fetch_add(p, v, __ATOMIC_RELAXED, __HIP_MEMORY_SCOPE_AGENT); }
__device__ __forceinline__ unsigned xb_xcc_id() { return (unsigned)__builtin_amdgcn_s_getreg((3 << 11) | 20) & 0xFu; }
#define XB_SPIN(cond, bar) do { unsigned _sp = 0; while (cond) { __builtin_amdgcn_s_sleep(1); \
    if ((++_sp & 255u) == 0u) { if (xb_ld(&(bar)[XB_TMO])) break; if (_sp > XB_SPIN_CAP) { atomicAdd(&(bar)[XB_TMO], 1u); break; } } } } while (0)

struct XcdBarrier { unsigned* bar; unsigned x; volatile LAS unsigned* st; };

__device__ __forceinline__ XcdBarrier xcd_barrier_post(unsigned* bar, volatile LAS unsigned* st) {
    XcdBarrier b; b.bar = bar; b.x = xb_xcc_id(); b.st = st;
    if (threadIdx.x == 0) (void)xb_add(&bar[XB_XCNT(b.x)], 1u);
    return b;
}
__device__ __forceinline__ void xcd_barrier_complete(unsigned* bar, unsigned x, unsigned& nloc, unsigned& nx) {
    const unsigned G = gridDim.x * gridDim.y * gridDim.z;
    unsigned sum, cnt, mine, sp = 0u;
    for (;;) {
        sum = 0u; cnt = 0u; mine = 0u;
#pragma unroll
        for (unsigned j = 0; j < 16; ++j) { const unsigned c = xb_ld(&bar[XB_XCNT(j)]); sum += c; cnt += (c > 0u) ? 1u : 0u; mine = (j == x) ? c : mine; }
        if (sum == G) break;
        __builtin_amdgcn_s_sleep(1);
        if ((++sp & 255u) == 0u) { if (xb_ld(&bar[XB_TMO])) break; if (sp > XB_SPIN_CAP) { atomicAdd(&bar[XB_TMO], 1u); break; } }
    }
    nloc = mine > 0u ? mine : 1u; nx = cnt > 0u ? cnt : 1u;
}
__device__ __forceinline__ void xcd_barrier(const XcdBarrier& b) {
    asm volatile("s_waitcnt vmcnt(0)" ::: "memory");
    __syncthreads();
    if (threadIdx.x == 0) {
        unsigned* bar = b.bar;
        __builtin_amdgcn_s_waitcnt(0);
        unsigned nloc = b.st[0], nx = b.st[1];
        if (nloc == 0u) { xcd_barrier_complete(bar, b.x, nloc, nx); b.st[0] = nloc; b.st[1] = nx; }
        const unsigned old = xb_add(&bar[XB_XSUB(b.x)], 1u);
        const unsigned gen = old / nloc;
        if (old + 1u == (gen + 1u) * nloc) {
            __builtin_amdgcn_fence(__ATOMIC_RELEASE, "agent");
            asm volatile("s_waitcnt vmcnt(0)" ::: "memory");
            const unsigned og = xb_add(&bar[XB_TOP], 1u);
            const unsigned tg = og / nx;
            if (og + 1u == (tg + 1u) * nx) xb_add(&bar[XB_TOPGEN], 1u);
            else XB_SPIN(xb_ld(&bar[XB_TOPGEN]) == tg, bar);
            __builtin_amdgcn_fence(__ATOMIC_ACQUIRE, "agent");
            xb_add(&bar[XB_XGEN(b.x)], 1u);
            asm volatile("s_waitcnt vmcnt(0)" ::: "memory");
        } else {
            XB_SPIN(xb_ld(&bar[XB_XGEN(b.x)]) == gen, bar);
            __builtin_amdgcn_fence(__ATOMIC_ACQUIRE, "agent");
            asm volatile("s_waitcnt vmcnt(0)" ::: "memory");
        }
    }
    __syncthreads();
}

#define CONV_LIM0 244
struct Params {
    const float *x, *c, *ctx, *c_ctx, *w_mod, *b_mod, *w_in, *qn, *kn, *lq1, *lk1, *lq2, *lk2, *subln,
                *wa, *wb, *wc, *wout, *ln1g, *ln1b, *wr, *br, *sg, *su, *sd, *eg, *eu, *ed, *ln2g, *ln2b;
    float* out;
    unsigned* bar;
    float *mod, *WF, *ropec, *ropes, *tc, *ts, *lam, *hbuf, *z, *logits, *f, *slot_w, *rw;
    act_t *u, *P, *oa, *ob, *oc, *y, *shact, *Hs, *Ys;
    int *ridx, *lrank, *cntWG, *slot_tok, *tok_slot, *eoff;
    bf16_t *Wt_in, *Wt_br, *Wt_out, *Wt_g, *Wt_sd;
    float* ytmp;
    bf16_t *Wt_e1, *Wt_e2;
    unsigned char* PF;
    unsigned char* u8;
    unsigned char* Gq;
    bf16_t *VTa, *VTc;
    unsigned* actr;
    bf16_t *De, *Do, *Dc, *XTe, *XTo, *XTc;
};

__device__ __forceinline__ float wave_sum(float v) {
#pragma unroll
    for (int o = 32; o > 0; o >>= 1) v += __shfl_xor(v, o);
    return v;
}
__device__ __forceinline__ float wave_max(float v) {
#pragma unroll
    for (int o = 32; o > 0; o >>= 1) v = fmaxf(v, __shfl_xor(v, o));
    return v;
}
__device__ __forceinline__ float sigmoidf_(float v) { return 1.f / (1.f + expf(-v)); }
__device__ __forceinline__ float siluf_(float v) { return v / (1.f + expf(-v)); }
__device__ __forceinline__ float lam_init_of(int l) { return l == 0 ? 0.2f : 0.35550906759f; }

__device__ __forceinline__ const float* in_row(const Params& p, int r) {
    const int b = r / LTOT, j = r - b * LTOT;
    return j < CTXL ? p.ctx + ((size_t)b * CTXL + j) * DM : p.x + ((size_t)b * SEQ + (j - CTXL)) * DM;
}
__device__ __forceinline__ int mod_idx(int r) { const int b = r / LTOT, j = r - b * LTOT; return j < CTXL ? 8 : b; }
__device__ __forceinline__ const float* modv(const Params& p, int l, int mi, int i) { return p.mod + ((size_t)(l * 9 + mi) * 6 + i) * DM; }

__device__ __forceinline__ void ln_stats(const float (&v)[16], float& mu, float& rstd) {
    float s = 0.f;
#pragma unroll
    for (int i = 0; i < 16; ++i) s += v[i];
    mu = wave_sum(s) * (1.f / DM);
    float q = 0.f;
#pragma unroll
    for (int i = 0; i < 16; ++i) { const float d = v[i] - mu; q += d * d; }
    rstd = rsqrtf(wave_sum(q) * (1.f / DM) + 1e-5f);
}
__device__ __forceinline__ void load_row16(const float* src, int lane, float (&v)[16]) {
#pragma unroll
    for (int i = 0; i < 4; ++i) { const float4 t = *(const float4*)(src + i * 256 + lane * 4); v[i * 4 + 0] = t.x; v[i * 4 + 1] = t.y; v[i * 4 + 2] = t.z; v[i * 4 + 3] = t.w; }
}

template <class FA, class FB>
__device__ __forceinline__ void sgemm_tile(float (&acc)[4][4], int K, FA fa, FB fb, float* lds) {
    float* As = lds;
    float* Bs = lds + 16 * 64;
    const int tid = threadIdx.x, ty = tid >> 5, tx = tid & 31;
#pragma unroll
    for (int i = 0; i < 4; ++i)
#pragma unroll
        for (int j = 0; j < 4; ++j) acc[i][j] = 0.f;
#pragma unroll 1
    for (int k0 = 0; k0 < K; k0 += 16) {
        __syncthreads();
#pragma unroll
        for (int i = 0; i < 2; ++i) { const int e = tid + i * NTHR; const int r = e >> 4, kk = e & 15; As[kk * 64 + r] = fa(r, k0 + kk); }
#pragma unroll
        for (int i = 0; i < 4; ++i) { const int e = tid + i * NTHR; const int kk = e >> 7, c = e & 127; Bs[kk * 128 + c] = fb(k0 + kk, c); }
        __syncthreads();
#pragma unroll 4
        for (int kk = 0; kk < 16; ++kk) {
            const float4 a = *(const float4*)&As[kk * 64 + ty * 4];
            const float4 b = *(const float4*)&Bs[kk * 128 + tx * 4];
            const float av[4] = {a.x, a.y, a.z, a.w}, bv[4] = {b.x, b.y, b.z, b.w};
#pragma unroll
            for (int i = 0; i < 4; ++i)
#pragma unroll
                for (int j = 0; j < 4; ++j) acc[i][j] += av[i] * bv[j];
        }
    }
}

__device__ __noinline__ void phase_pro(const Params& p, float* lds) {
    const int tid = threadIdx.x, bid = blockIdx.x, nb = gridDim.x;
    const int gtid = bid * NTHR + tid, gn = nb * NTHR;
    for (int i = tid; i < 9 * 1024; i += NTHR) { const int r = i >> 10, k = i & 1023; const float v = r < 8 ? p.c[r * 1024 + k] : p.c_ctx[k]; lds[i] = siluf_(v); }
    __syncthreads();
    float* red = lds + 9 * 1024;
    for (int g = bid; g < 192; g += nb) {
        const int l = g / 96, col0 = (g % 96) * 64, c4 = tid & 15, kc = tid >> 4;
        float acc[9][4];
#pragma unroll
        for (int i = 0; i < 9; ++i) { acc[i][0] = 0.f; acc[i][1] = 0.f; acc[i][2] = 0.f; acc[i][3] = 0.f; }
        const float* w = p.w_mod + (size_t)l * 1024 * 6144 + col0 + c4 * 4;
#pragma unroll 8
        for (int k = kc * 32; k < kc * 32 + 32; ++k) {
            const float4 wv = *(const float4*)(w + (size_t)k * 6144);
#pragma unroll
            for (int i = 0; i < 9; ++i) { const float s = lds[i * 1024 + k]; acc[i][0] += s * wv.x; acc[i][1] += s * wv.y; acc[i][2] += s * wv.z; acc[i][3] += s * wv.w; }
        }
#pragma unroll
        for (int i = 0; i < 9; ++i) *(float4*)&red[(kc * 9 + i) * 64 + c4 * 4] = make_float4(acc[i][0], acc[i][1], acc[i][2], acc[i][3]);
        __syncthreads();
        for (int o = tid; o < 9 * 64; o += NTHR) { const int i = o >> 6, c = o & 63;
            float s = p.b_mod[l * 6144 + col0 + c];
#pragma unroll 8
            for (int k2 = 0; k2 < 32; ++k2) s += red[(k2 * 9 + i) * 64 + c];
            p.mod[(size_t)(l * 9 + i) * 6144 + col0 + c] = s; }
        __syncthreads();
    }
    for (int i = gtid; i < 2048 * 32; i += gn) {
        const int s = i >> 5, j = i & 31, axis = j >> 4, fi = j & 15;
        const double pos = axis ? (double)(s & 63) : (double)(s >> 6);
        const double inv = pow(10000.0, -(double)fi / 16.0);
        const double ang = (double)(float)((float)pos * (float)inv);
        p.ropec[i] = (float)cos(ang); p.ropes[i] = (float)sin(ang);
    }
    for (int i = gtid; i < 2048; i += gn) { p.tc[i] = (float)cospi((double)i / 1024.0); p.ts[i] = (float)sinpi((double)i / 1024.0); }
    if (bid == 0 && tid < 128) {
        const int l = tid >> 6, lane = tid & 63;
        const float d1 = wave_sum(p.lq1[l * 64 + lane] * p.lk1[l * 64 + lane]);
        const float d2 = wave_sum(p.lq2[l * 64 + lane] * p.lk2[l * 64 + lane]);
        if (lane == 0) { p.lam[l] = expf(d1) - expf(d2) + lam_init_of(l); }
        if (lane < 16) p.actr[l * 32 + lane] = 0u;
    }
    __syncthreads();
    float* t128 = lds;
    if (tid < 128) { t128[tid] = (float)cospi((double)tid / 64.0); t128[128 + tid] = (float)sinpi((double)tid / 64.0); }
    __syncthreads();
    typedef const __attribute__((address_space(4))) float* cfp;
    const int lane = tid & 63;
    for (int it_ = bid * 8 + (tid >> 6); it_ < 2 * 1024 * 4; it_ += nb * 8) {
        const int it = __builtin_amdgcn_readfirstlane(it_), l = it >> 12, k = (it >> 2) & 1023, g = it & 3;
        const unsigned long long wa = (unsigned long long)(p.w_in + ((size_t)l * 1024 + k) * IN_W + 768 + g * 128);
        cfp w = (cfp)(((unsigned long long)(unsigned)__builtin_amdgcn_readfirstlane((int)(wa >> 32)) << 32) | (unsigned)__builtin_amdgcn_readfirstlane((int)wa));
        float c0 = 0.f, s0 = 0.f, c1 = 0.f, s1 = 0.f;
#pragma unroll 8
        for (int c = 0; c < 128; ++c) {
            const float wv = w[c];
            const int i0 = (c * lane) & 127, i1 = i0 ^ ((c & 1) << 6);
            c0 += wv * t128[i0]; s0 += wv * t128[128 + i0]; c1 += wv * t128[i1]; s1 += wv * t128[128 + i1];
        }
        float* o = p.WF + ((size_t)l * 1024 + k) * 1024 + g * 128;
        o[lane] = c0; o[lane + 64] = c1; o[512 + lane] = s0; o[512 + lane + 64] = s1;
    }
}

__device__ __forceinline__ void st_fp8x4(unsigned char* p8, size_t i, float4 o) {
    int q8 = 0;
    q8 = __builtin_amdgcn_cvt_pk_fp8_f32(fminf(fmaxf(o.x * 16.f, -448.f), 448.f), fminf(fmaxf(o.y * 16.f, -448.f), 448.f), q8, false);
    q8 = __builtin_amdgcn_cvt_pk_fp8_f32(fminf(fmaxf(o.z * 16.f, -448.f), 448.f), fminf(fmaxf(o.w * 16.f, -448.f), 448.f), q8, true);
    *(int*)(p8 + i) = q8;
}
__device__ __noinline__ void phase_lnmod0(const Params& p) {
    const int wid = threadIdx.x >> 6, lane = threadIdx.x & 63;
    const int stride = gridDim.x * 8;
    auto proc = [&](int r, float (&v)[16]) {
        float mu, rstd; ln_stats(v, mu, rstd);
        const int mi = mod_idx(r);
        const float* sh = modv(p, 0, mi, 0); const float* sc = modv(p, 0, mi, 1);
#pragma unroll
        for (int i = 0; i < 4; ++i) {
            const int c = i * 256 + lane * 4;
            const float4 s4 = *(const float4*)(sh + c), c4 = *(const float4*)(sc + c);
            float4 o; o.x = (v[i * 4 + 0] - mu) * rstd * (1.f + c4.x) + s4.x; o.y = (v[i * 4 + 1] - mu) * rstd * (1.f + c4.y) + s4.y;
            o.z = (v[i * 4 + 2] - mu) * rstd * (1.f + c4.z) + s4.z; o.w = (v[i * 4 + 3] - mu) * rstd * (1.f + c4.w) + s4.w;
            st_fp8x4(p.u8, (size_t)r * DM + c, o);
        } };
    for (int r = blockIdx.x * 8 + wid; r < T_ALL; r += 2 * stride) {
        const int r2 = r + stride;
        float va[16], vb[16];
        load_row16(in_row(p, r), lane, va);
        if (r2 < T_ALL) load_row16(in_row(p, r2), lane, vb);
        proc(r, va);
        if (r2 < T_ALL) proc(r2, vb);
    }
}

__device__ __noinline__ void phase_inproj(const Params& p, int l, float* lds) {
    const int tid = threadIdx.x, ty = tid >> 5, tx = tid & 31;
    const float* win = p.w_in + (size_t)l * 1024 * IN_W;
    const float* wf = p.WF + (size_t)l * 1024 * 1024;
    for (int t = blockIdx.x; t < 288 * 50; t += gridDim.x) {
        const int rt = t / 50, ct = t % 50, col0 = ct * 128;
        float acc[4][4];
        sgemm_tile(acc, 1024,
            [&](int r, int k) { return ldv(p.u, (size_t)(rt * 64 + r) * DM + k); },
            [&](int k, int c) { const int col = col0 + c;
                if (col < 768) return win[(size_t)k * IN_W + col];
                if (col < 1792) return wf[(size_t)k * 1024 + (col - 768)];
                return win[(size_t)k * IN_W + (col - 512)]; }, lds);
#pragma unroll
        for (int i = 0; i < 4; ++i) { const size_t row = rt * 64 + ty * 4 + i;
            st4(p.P, row * PW + col0 + tx * 4, make_float4(acc[i][0], acc[i][1], acc[i][2], acc[i][3])); }
    }
}

__device__ __forceinline__ void load64(const float* p, float (&kr)[64]) {
#pragma unroll
    for (int i = 0; i < 16; ++i) { const float4 t = *(const float4*)(p + i * 4); kr[i * 4] = t.x; kr[i * 4 + 1] = t.y; kr[i * 4 + 2] = t.z; kr[i * 4 + 3] = t.w; }
}
__device__ __forceinline__ void load64(const bf16_t* p, float (&kr)[64]) {
#pragma unroll
    for (int i = 0; i < 16; ++i) { const float4 t = ld4(p, i * 4); kr[i * 4] = t.x; kr[i * 4 + 1] = t.y; kr[i * 4 + 2] = t.z; kr[i * 4 + 3] = t.w; }
}
template <int QB, int NMAP, int VD>
__device__ __noinline__ void attn_unit(const Params& p, int l, int b, int head, int qblk, bool ctxq, float* lds) {
    const int L = ctxq ? CTXL : LTOT;
    float* S = lds;
    float* Q = lds + 36864;
    const int tid = threadIdx.x, wid = tid >> 6, lane = tid & 63;
    const size_t rowbase = (size_t)b * LTOT;
    const int jq0 = (ctxq ? 0 : CTXL) + qblk * QB;
    const bool gqa = (NMAP == 1);
    const int qcol = gqa ? C_QA + head * 64 : C_QC + head * 128;
    const int kcol = gqa ? C_KA + (head >> 2) * 64 : C_KC + head * 128;
    const int vcol = gqa ? C_VA + (head >> 2) * 64 : C_VC + head * 128;
    __syncthreads();
    for (int i = tid; i < NMAP * QB * 64; i += NTHR) { const int m = i / (QB * 64), q = (i >> 6) % QB, d = i & 63;
        Q[i] = ldv(p.P, (rowbase + jq0 + q) * PW + qcol + m * 64 + d) * 0.125f; }
    __syncthreads();
    for (int j = tid; j < L; j += NTHR) {
#pragma unroll 1
        for (int m = 0; m < NMAP; ++m) {
            float kr[64]; load64(p.P + (rowbase + j) * PW + kcol + m * 64, kr);
#pragma unroll 1
            for (int q = 0; q < QB; ++q) {
                const float* qp = Q + (m * QB + q) * 64; float d = 0.f;
#pragma unroll
                for (int e = 0; e < 64; ++e) d += qp[e] * kr[e];
                S[(m * QB + q) * L + j] = d;
            }
        }
    }
    __syncthreads();
#pragma unroll
    for (int rr = 0; rr < 2; ++rr) {
        float* sr = S + (wid * 2 + rr) * L;
        float mx = -3.0e38f;
        for (int j = lane; j < L; j += 64) mx = fmaxf(mx, sr[j]);
        mx = wave_max(mx);
        float sum = 0.f;
        for (int j = lane; j < L; j += 64) { const float e = expf(sr[j] - mx); sr[j] = e; sum += e; }
        sum = wave_sum(sum);
        const float inv = 1.f / sum;
        for (int j = lane; j < L; j += 64) sr[j] *= inv;
    }
    __syncthreads();
    if (NMAP == 2) {
        const float lam = p.lam[l];
        for (int i = tid; i < QB * L; i += NTHR) S[i] -= lam * S[QB * L + i];
        __syncthreads();
    }
    const int q = tid / (VD / 2), e = (tid % (VD / 2)) * 2;
    float o0 = 0.f, o1 = 0.f;
    const float* sq = S + q * L;
    const act_t* vp = p.P + rowbase * PW + vcol + e;
#pragma unroll 4
    for (int j = 0; j < L; ++j) { const float pj = sq[j]; o0 += pj * ldv(vp, (size_t)j * PW); o1 += pj * ldv(vp, (size_t)j * PW + 1); }
    const size_t orow = rowbase + jq0 + q;
    if (gqa) { stv(p.oa, orow * 512 + head * 64 + e, o0); stv(p.oa, orow * 512 + head * 64 + e + 1, o1); }
    else {
        const float ss = wave_sum(o0 * o0 + o1 * o1);
        const float sc = rsqrtf(ss * (1.f / 128.f) + 1e-6f) * (1.f - lam_init_of(l));
        stv(p.oc, orow * 512 + head * 128 + e, o0 * sc * p.subln[l * 128 + e]); stv(p.oc, orow * 512 + head * 128 + e + 1, o1 * sc * p.subln[l * 128 + e + 1]);
    }
}
__device__ __forceinline__ void phase_attn(const Params& p, int l, bool do_ctx, float* lds) {
    for (int t = blockIdx.x; t < 8192; t += gridDim.x) attn_unit<16, 1, 64>(p, l, t >> 10, (t >> 7) & 7, t & 127, false, lds);
    for (int t = blockIdx.x; t < 8192; t += gridDim.x) attn_unit<8, 2, 128>(p, l, t >> 10, (t >> 8) & 3, t & 255, false, lds);
    if (do_ctx) {
        for (int t = blockIdx.x; t < 1024; t += gridDim.x) attn_unit<16, 1, 64>(p, l, t >> 7, (t >> 4) & 7, t & 15, true, lds);
        for (int t = blockIdx.x; t < 1024; t += gridDim.x) attn_unit<8, 2, 128>(p, l, t >> 7, (t >> 5) & 3, t & 31, true, lds);
    }
}

__device__ __noinline__ void phase_fourier(const Params& p, bool do_ctx, float* lds) {
    const int tid = threadIdx.x, ty = tid >> 5, tx = tid & 31;
    for (int t = blockIdx.x; t < 8 * 32 * 4; t += gridDim.x) {
        const int b = t >> 7, rt = (t >> 2) & 31, ct = t & 3;
        float acc[4][4];
        sgemm_tile(acc, 4096,
            [&](int r, int k) { const int kk = rt * 64 + r, n = k & 2047, m = (kk * n) & 2047; return k < 2048 ? p.tc[m] : -p.ts[m]; },
            [&](int k, int c) { const int n = k & 2047, wh = k >> 11; return ldv(p.P, ((size_t)b * LTOT + CTXL + n) * PW + C_FA + wh * 512 + ct * 128 + c); }, lds);
#pragma unroll
        for (int i = 0; i < 4; ++i) { const size_t row = (size_t)b * LTOT + CTXL + rt * 64 + ty * 4 + i; const float s = 1.f / 512.f;
            st4(p.ob, row * 512 + ct * 128 + tx * 4, make_float4(acc[i][0] * s, acc[i][1] * s, acc[i][2] * s, acc[i][3] * s)); }
    }
    if (do_ctx) {
        for (int t = blockIdx.x; t < 8 * 4 * 4; t += gridDim.x) {
            const int b = t >> 4, rt = (t >> 2) & 3, ct = t & 3;
            float acc[4][4];
            sgemm_tile(acc, 512,
                [&](int r, int k) { const int kk = rt * 64 + r, n = k & 255, m = (kk * n * 8) & 2047; return k < 256 ? p.tc[m] : -p.ts[m]; },
                [&](int k, int c) { const int n = k & 255, wh = k >> 8; return ldv(p.P, ((size_t)b * LTOT + n) * PW + C_FA + wh * 512 + ct * 128 + c); }, lds);
#pragma unroll
            for (int i = 0; i < 4; ++i) { const size_t row = (size_t)b * LTOT + rt * 64 + ty * 4 + i; const float s = 0.00552427172802f;
                st4(p.ob, row * 512 + ct * 128 + tx * 4, make_float4(acc[i][0] * s, acc[i][1] * s, acc[i][2] * s, acc[i][3] * s)); }
        }
    }
}

__device__ __noinline__ void phase_ygemm(const Params& p, int l, float* lds) {
    const int tid = threadIdx.x, ty = tid >> 5, tx = tid & 31;
    for (int t = blockIdx.x; t < 288 * 8; t += gridDim.x) {
        const int rt = t >> 3, ct = t & 7, col0 = ct * 128;
        float tot[4][4];
#pragma unroll
        for (int i = 0; i < 4; ++i)
#pragma unroll
            for (int j = 0; j < 4; ++j) tot[i][j] = 0.f;
#pragma unroll 1
        for (int br = 0; br < 3; ++br) {
            const act_t* o = br == 0 ? p.oa : br == 1 ? p.ob : p.oc;
            const float* w = (br == 0 ? p.wa : br == 1 ? p.wb : p.wc) + (size_t)l * 512 * 1024;
            float acc[4][4];
            sgemm_tile(acc, 512,
                [&](int r, int k) { return ldv(o, (size_t)(rt * 64 + r) * 512 + k); },
                [&](int k, int c) { return w[(size_t)k * 1024 + col0 + c]; }, lds);
#pragma unroll
            for (int i = 0; i < 4; ++i) { const size_t row = rt * 64 + ty * 4 + i;
                const float4 g = ld4(p.P, row * PW + C_G + br * 1024 + col0 + tx * 4);
                tot[i][0] += sigmoidf_(g.x) * acc[i][0]; tot[i][1] += sigmoidf_(g.y) * acc[i][1]; tot[i][2] += sigmoidf_(g.z) * acc[i][2]; tot[i][3] += sigmoidf_(g.w) * acc[i][3]; }
        }
#pragma unroll
        for (int i = 0; i < 4; ++i) { const size_t row = rt * 64 + ty * 4 + i; st4(p.y, row * DM + col0 + tx * 4, make_float4(tot[i][0], tot[i][1], tot[i][2], tot[i][3])); }
    }
}

__device__ __noinline__ void phase_outproj(const Params& p, int l, float* lds) {
    const int tid = threadIdx.x, ty = tid >> 5, tx = tid & 31;
    const float* w = p.wout + (size_t)l * 1024 * 1024;
    for (int t = blockIdx.x; t < 288 * 8; t += gridDim.x) {
        const int rt = t >> 3, ct = t & 7, col0 = ct * 128;
        float acc[4][4];
        sgemm_tile(acc, 1024,
            [&](int r, int k) { return ldv(p.y, (size_t)(rt * 64 + r) * DM + k); },
            [&](int k, int c) { return w[(size_t)k * 1024 + col0 + c]; }, lds);
#pragma unroll
        for (int i = 0; i < 4; ++i) { const int row = rt * 64 + ty * 4 + i; const int c = col0 + tx * 4;
            const float* hrow = l == 0 ? in_row(p, row) : p.hbuf + (size_t)row * DM;
            const float4 h4 = *(const float4*)(hrow + c); const float4 m4 = *(const float4*)(modv(p, l, mod_idx(row), 2) + c);
            float4 o; o.x = ALPHA * h4.x + m4.x * acc[i][0]; o.y = ALPHA * h4.y + m4.y * acc[i][1]; o.z = ALPHA * h4.z + m4.z * acc[i][2]; o.w = ALPHA * h4.w + m4.w * acc[i][3];
            *(float4*)(p.z + (size_t)row * DM + c) = o; }
    }
}

__device__ __noinline__ void phase_ln1(const Params& p, int l) {
    const int wid = threadIdx.x >> 6, lane = threadIdx.x & 63;
    const int stride = gridDim.x * 8;
    const float* g = p.ln1g + l * DM; const float* bb = p.ln1b + l * DM;
    auto load = [&](int r, float (&v)[16]) {
#pragma unroll
        for (int i = 0; i < 4; ++i) { const float4 t = ld4((const bf16_t*)p.z, (size_t)r * DM + i * 256 + lane * 4); v[i * 4] = t.x; v[i * 4 + 1] = t.y; v[i * 4 + 2] = t.z; v[i * 4 + 3] = t.w; } };
    auto proc = [&](int r, float (&v)[16]) {
        float mu, rstd; ln_stats(v, mu, rstd);
#pragma unroll
        for (int i = 0; i < 4; ++i) { const int c = i * 256 + lane * 4; const float4 g4 = *(const float4*)(g + c), b4 = *(const float4*)(bb + c);
            v[i * 4 + 0] = (v[i * 4 + 0] - mu) * rstd * g4.x + b4.x; v[i * 4 + 1] = (v[i * 4 + 1] - mu) * rstd * g4.y + b4.y;
            v[i * 4 + 2] = (v[i * 4 + 2] - mu) * rstd * g4.z + b4.z; v[i * 4 + 3] = (v[i * 4 + 3] - mu) * rstd * g4.w + b4.w;
            st4((bf16_t*)p.hbuf, (size_t)r * DM + c, make_float4(v[i * 4], v[i * 4 + 1], v[i * 4 + 2], v[i * 4 + 3])); }
        ln_stats(v, mu, rstd);
        const int mi = mod_idx(r);
        const float* sh = modv(p, l, mi, 3); const float* sc = modv(p, l, mi, 4);
#pragma unroll
        for (int i = 0; i < 4; ++i) { const int c = i * 256 + lane * 4; const float4 s4 = *(const float4*)(sh + c), c4 = *(const float4*)(sc + c);
            float4 o; o.x = (v[i * 4 + 0] - mu) * rstd * (1.f + c4.x) + s4.x; o.y = (v[i * 4 + 1] - mu) * rstd * (1.f + c4.y) + s4.y;
            o.z = (v[i * 4 + 2] - mu) * rstd * (1.f + c4.z) + s4.z; o.w = (v[i * 4 + 3] - mu) * rstd * (1.f + c4.w) + s4.w;
            st4(p.u, (size_t)r * DM + c, o);
            { int q8 = 0;
              q8 = __builtin_amdgcn_cvt_pk_fp8_f32(fminf(fmaxf(o.x * 16.f, -448.f), 448.f), fminf(fmaxf(o.y * 16.f, -448.f), 448.f), q8, false);
              q8 = __builtin_amdgcn_cvt_pk_fp8_f32(fminf(fmaxf(o.z * 16.f, -448.f), 448.f), fminf(fmaxf(o.w * 16.f, -448.f), 448.f), q8, true);
              *(int*)(p.u8 + (size_t)r * DM + c) = q8; } } };
    for (int r = blockIdx.x * 8 + wid; r < T_ALL; r += 2 * stride) {
        const int r2 = r + stride;
        const bool okA = !(l == 1 && (r % LTOT) < CTXL), okB = r2 < T_ALL && !(l == 1 && (r2 % LTOT) < CTXL);
        float va[16], vb[16];
        if (okA) load(r, va);
        if (okB) load(r2, vb);
        if (okA) proc(r, va);
        if (okB) proc(r2, vb);
    }
}

__device__ __noinline__ void phase_router_shared(const Params& p, int l, float* lds) {
    const int tid = threadIdx.x, ty = tid >> 5, tx = tid & 31;
    const float* wr = p.wr + (size_t)l * 1024 * 256; const float* sg = p.sg + (size_t)l * 1024 * 256; const float* su = p.su + (size_t)l * 1024 * 256;
    for (int t = blockIdx.x; t < 288 * 4; t += gridDim.x) {
        const int rt = t >> 2, kind = (t >> 1) & 1, ct = t & 1, col0 = ct * 128;
        auto fa = [&](int r, int k) { return ldv(p.u, (size_t)(rt * 64 + r) * DM + k); };
        if (kind == 0) {
            float acc[4][4];
            sgemm_tile(acc, 1024, fa, [&](int k, int c) { return wr[(size_t)k * 256 + col0 + c]; }, lds);
#pragma unroll
            for (int i = 0; i < 4; ++i) { const size_t row = rt * 64 + ty * 4 + i; *(float4*)(p.logits + row * 256 + col0 + tx * 4) = make_float4(acc[i][0], acc[i][1], acc[i][2], acc[i][3]); }
        } else {
            float ag[4][4], au[4][4];
            sgemm_tile(ag, 1024, fa, [&](int k, int c) { return sg[(size_t)k * 256 + col0 + c]; }, lds);
            sgemm_tile(au, 1024, fa, [&](int k, int c) { return su[(size_t)k * 256 + col0 + c]; }, lds);
#pragma unroll
            for (int i = 0; i < 4; ++i) { const size_t row = rt * 64 + ty * 4 + i;
                st4(p.shact, row * 256 + col0 + tx * 4, make_float4(siluf_(ag[i][0]) * au[i][0], siluf_(ag[i][1]) * au[i][1], siluf_(ag[i][2]) * au[i][2], siluf_(ag[i][3]) * au[i][3])); }
        }
    }
}

__device__ __noinline__ void phase_route(const Params& p, int l, float* lds) {
    const int tid = threadIdx.x, wid = tid >> 6, lane = tid & 63, bid = blockIdx.x;
    int* asg = (int*)lds;
    unsigned* bm = (unsigned*)lds + 640;
    for (int i = tid; i < 768; i += NTHR) bm[i] = 0u;
    __syncthreads();
    const float4 b4 = *(const float4*)(p.br + l * 256 + lane * 4);
    const float bz_[4] = {b4.x, b4.y, b4.z, b4.w};
    float4 l4n = *(const float4*)(p.logits + (size_t)(bid * 72 + wid) * 256 + lane * 4);
    for (int tl = wid; tl < 72; tl += 8) {
        const int t = bid * 72 + tl;
        const float4 l4 = l4n;
        if (tl + 8 < 72) l4n = *(const float4*)(p.logits + (size_t)(t + 8) * 256 + lane * 4);
        if (l == 1 && (t % LTOT) < CTXL) { if (lane < 8) asg[tl * 8 + lane] = -1; continue; }
        const float lg[4] = {l4.x, l4.y, l4.z, l4.w};
        float s[4], bz[4];
#pragma unroll
        for (int i = 0; i < 4; ++i) { s[i] = sigmoidf_(lg[i]); bz[i] = s[i] + bz_[i]; }
        float m1 = -3.0e38f, m2 = -3.0e38f;
#pragma unroll
        for (int i = 0; i < 4; ++i) { const float v = bz[i]; if (v > m1) { m2 = m1; m1 = v; } else if (v > m2) m2 = v; }
#pragma unroll
        for (int o = 1; o < 8; o <<= 1) { const float o1 = __shfl_xor(m1, o), o2 = __shfl_xor(m2, o); const float n1 = fmaxf(m1, o1), n2 = fmaxf(fminf(m1, o1), fmaxf(m2, o2)); m1 = n1; m2 = n2; }
        const float gs = m1 + m2; const int g = lane >> 3; int rank = 0;
#pragma unroll
        for (int j = 0; j < 8; ++j) { const float o = __int_as_float(__builtin_amdgcn_readlane(__float_as_int(gs), j * 8)); rank += ((o > gs) || (o == gs && j < g)) ? 1 : 0; }
        const bool gsel = rank < 4;
        unsigned key[4];
#pragma unroll
        for (int i = 0; i < 4; ++i) { const unsigned bits = __float_as_uint(bz[i]); const unsigned k = (bits & 0x80000000u) ? ~bits : (bits | 0x80000000u); key[i] = gsel ? k : 0u; }
        unsigned T = 0u;
#pragma unroll 1
        for (int bit = 31; bit >= 0; --bit) {
            const unsigned Tt = T | (1u << bit);
            const int cnt = __builtin_popcountll(__builtin_amdgcn_ballot_w64(key[0] >= Tt)) + __builtin_popcountll(__builtin_amdgcn_ballot_w64(key[1] >= Tt))
                          + __builtin_popcountll(__builtin_amdgcn_ballot_w64(key[2] >= Tt)) + __builtin_popcountll(__builtin_amdgcn_ballot_w64(key[3] >= Tt));
            if (cnt >= 8) T = Tt;
        }
        unsigned long long mg[4], me[4];
        int n_gt = 0;
#pragma unroll
        for (int i = 0; i < 4; ++i) { mg[i] = __builtin_amdgcn_ballot_w64(key[i] > T); me[i] = __builtin_amdgcn_ballot_w64(key[i] == T); n_gt += __builtin_popcountll(mg[i]); }
        const int need_eq = 8 - n_gt;
        const unsigned long long below = (lane == 0) ? 0ull : (~0ull >> (64 - lane));
        int eq_lower = 0;
#pragma unroll
        for (int i = 0; i < 4; ++i) eq_lower += __builtin_popcountll(me[i] & below);
        bool selm[4]; int eqrun = 0;
#pragma unroll
        for (int i = 0; i < 4; ++i) { const bool isgt = key[i] > T, iseq = key[i] == T; selm[i] = isgt || (iseq && (eq_lower + eqrun) < need_eq); eqrun += iseq ? 1 : 0; }
        unsigned long long ms[4]; int pos = 0;
#pragma unroll
        for (int i = 0; i < 4; ++i) { ms[i] = __builtin_amdgcn_ballot_w64(selm[i]); pos += __builtin_popcountll(ms[i] & below); }
        float mysum = 0.f;
#pragma unroll
        for (int i = 0; i < 4; ++i) mysum += selm[i] ? s[i] : 0.f;
        const float inv = 2.5f / wave_sum(mysum);
#pragma unroll
        for (int i = 0; i < 4; ++i) { if (selm[i]) { p.ridx[(size_t)t * 8 + pos] = lane * 4 + i; p.rw[(size_t)t * 8 + pos] = s[i] * inv; asg[tl * 8 + pos] = lane * 4 + i; ++pos;
                atomicOr(&bm[(lane * 4 + i) * 3 + (tl >> 5)], 1u << (tl & 31)); } }
    }
    __syncthreads();
    if (tid < 256) p.cntWG[bid * 256 + tid] = __builtin_popcount(bm[tid * 3]) + __builtin_popcount(bm[tid * 3 + 1]) + __builtin_popcount(bm[tid * 3 + 2]);
    for (int a = tid; a < 576; a += NTHR) { const int e = asg[a];
        if (e >= 0) { const int tl = a >> 3, w = tl >> 5, bit = tl & 31;
            int rk = __builtin_popcount(bm[e * 3 + w] & ((1u << bit) - 1u));
            if (w > 0) rk += __builtin_popcount(bm[e * 3]);
            if (w > 1) rk += __builtin_popcount(bm[e * 3 + 1]);
            p.lrank[(size_t)bid * 576 + a] = rk; } }
    __syncthreads();
}

__device__ __noinline__ void phase_slots(const Params& p, bool skip_ctx, float* lds) {
    const int tid = threadIdx.x, bid = blockIdx.x;
    int* tot = (int*)lds; int* pre = tot + 256; int* off = pre + 256;
    int* part = off + 320;
    {
        const int e = tid & 255, h = tid >> 8;
        int s = 0, mine = 0;
#pragma unroll 8
        for (int w = h * 128; w < h * 128 + 128; ++w) { const int c = p.cntWG[w * 256 + e]; s += c; mine += (w < bid) ? c : 0; }
        part[(h * 2 + 0) * 256 + e] = s; part[(h * 2 + 1) * 256 + e] = mine;
    }
    __syncthreads();
    if (tid < 256) { tot[tid] = part[tid] + part[512 + tid]; pre[tid] = part[256 + tid] + part[768 + tid]; }
    __syncthreads();
    if (tid < 64) {
        const int a0 = tot[tid * 4], a1 = tot[tid * 4 + 1], a2 = tot[tid * 4 + 2], a3 = tot[tid * 4 + 3];
        const int ls = a0 + a1 + a2 + a3; int inc = ls;
#pragma unroll
        for (int o = 1; o < 64; o <<= 1) { const int t2 = __shfl_up(inc, o); if (tid >= o) inc += t2; }
        const int ex = inc - ls;
        off[tid * 4] = ex; off[tid * 4 + 1] = ex + a0; off[tid * 4 + 2] = ex + a0 + a1; off[tid * 4 + 3] = ex + a0 + a1 + a2;
        if (tid == 63) off[256] = inc;
    }
    __syncthreads();
    if (bid == 0 && tid <= 256) p.eoff[tid] = off[tid];
    for (int a = tid; a < 576; a += NTHR) {
        const int t = bid * 72 + (a >> 3);
        if (skip_ctx && (t % LTOT) < CTXL) continue;
        const int e = p.ridx[(size_t)t * 8 + (a & 7)];
        const int slot = off[e] + pre[e] + p.lrank[(size_t)bid * 576 + a];
        p.slot_tok[slot] = t; p.tok_slot[(size_t)t * 8 + (a & 7)] = slot;
    }
}

__device__ __forceinline__ int build_units(const Params& p, int* ustart  ) {
    __syncthreads();
    if (threadIdx.x == 0) { int s = 0; for (int e = 0; e < 256; ++e) { ustart[e] = s; s += (p.eoff[e + 1] - p.eoff[e] + 63) >> 6; } ustart[256] = s; }
    __syncthreads();
    return ustart[256];
}
__device__ __forceinline__ int find_expert(const int* ustart, int ub) { int lo = 0, hi = 255; while (lo < hi) { const int mid = (lo + hi + 1) >> 1; if (ustart[mid] <= ub) lo = mid; else hi = mid - 1; } return lo; }
__device__ __noinline__ void phase_exp_up(const Params& p, int l, float* lds) {
    const int tid = threadIdx.x, ty = tid >> 5, tx = tid & 31;
    int* ustart = (int*)(lds + 4096);
    const int nub = build_units(p, ustart);
    for (int t = blockIdx.x; t < nub * 2; t += gridDim.x) {
        const int ub = t >> 1, ct = t & 1, col0 = ct * 128;
        const int e = find_expert(ustart, ub);
        const int s0 = p.eoff[e] + (ub - ustart[e]) * 64, s1 = p.eoff[e + 1];
        const float* wg = p.eg + ((size_t)l * 256 + e) * 1024 * 256; const float* wu = p.eu + ((size_t)l * 256 + e) * 1024 * 256;
        auto fa = [&](int r, int k) { const int s = s0 + r; return s < s1 ? ldv(p.u, (size_t)p.slot_tok[s] * DM + k) : 0.f; };
        float ag[4][4], au[4][4];
        sgemm_tile(ag, 1024, fa, [&](int k, int c) { return wg[(size_t)k * 256 + col0 + c]; }, lds);
        sgemm_tile(au, 1024, fa, [&](int k, int c) { return wu[(size_t)k * 256 + col0 + c]; }, lds);
#pragma unroll
        for (int i = 0; i < 4; ++i) { const int s = s0 + ty * 4 + i;
            if (s < s1) st4(p.Hs, (size_t)s * 256 + col0 + tx * 4, make_float4(siluf_(ag[i][0]) * au[i][0], siluf_(ag[i][1]) * au[i][1], siluf_(ag[i][2]) * au[i][2], siluf_(ag[i][3]) * au[i][3])); }
    }
}
__device__ __noinline__ void phase_exp_down(const Params& p, int l, float* lds) {
    const int tid = threadIdx.x, ty = tid >> 5, tx = tid & 31;
    int* ustart = (int*)(lds + 4096);
    const int nub = build_units(p, ustart);
    for (int t = blockIdx.x; t < nub * 8; t += gridDim.x) {
        const int ub = t >> 3, ct = t & 7, col0 = ct * 128;
        const int e = find_expert(ustart, ub);
        const int s0 = p.eoff[e] + (ub - ustart[e]) * 64, s1 = p.eoff[e + 1];
        const float* wd = p.ed + ((size_t)l * 256 + e) * 256 * 1024;
        float acc[4][4];
        sgemm_tile(acc, 256,
            [&](int r, int k) { const int s = s0 + r; return s < s1 ? ldv(p.Hs, (size_t)s * 256 + k) : 0.f; },
            [&](int k, int c) { return wd[(size_t)k * 1024 + col0 + c]; }, lds);
#pragma unroll
        for (int i = 0; i < 4; ++i) { const int s = s0 + ty * 4 + i;
            if (s < s1) { const float w = p.slot_w[s]; st4(p.Ys, (size_t)s * DM + col0 + tx * 4, make_float4(acc[i][0] * w, acc[i][1] * w, acc[i][2] * w, acc[i][3] * w)); } }
    }
}

__device__ __noinline__ void phase_ln2(const Params& p, int l) {
    const int wid = threadIdx.x >> 6, lane = threadIdx.x & 63;
    const int stride = gridDim.x * 8;
    int r = blockIdx.x * 8 + wid;
    int4 sa = make_int4(0, 0, 0, 0), sb = sa;
    if (r < T_ALL && !(l == 1 && (r % LTOT) < CTXL)) { sa = *(const int4*)(p.tok_slot + (size_t)r * 8); sb = *(const int4*)(p.tok_slot + (size_t)r * 8 + 4); }
    for (; r < T_ALL; r += stride) {
        const int rn = r + stride;
        int4 na = make_int4(0, 0, 0, 0), nb = na;
        if (rn < T_ALL && !(l == 1 && (rn % LTOT) < CTXL)) { na = *(const int4*)(p.tok_slot + (size_t)rn * 8); nb = *(const int4*)(p.tok_slot + (size_t)rn * 8 + 4); }
        const int sl[8] = {sa.x, sa.y, sa.z, sa.w, sb.x, sb.y, sb.z, sb.w};
        sa = na; sb = nb;
        if (l == 1 && (r % LTOT) < CTXL) continue;
        const float4 wa = *(const float4*)(p.rw + (size_t)r * 8), wb = *(const float4*)(p.rw + (size_t)r * 8 + 4);
        const float wk[8] = {wa.x, wa.y, wa.z, wa.w, wb.x, wb.y, wb.z, wb.w};
        unsigned yraw[8][4];
        const unsigned char* ys8 = (const unsigned char*)p.Ys;
#pragma unroll
        for (int k = 0; k < 8; ++k)
#pragma unroll
            for (int i = 0; i < 4; ++i) yraw[k][i] = *(const unsigned*)(ys8 + (size_t)sl[k] * DM + i * 256 + lane * 4);
        float ft[16];
#pragma unroll
        for (int i = 0; i < 4; ++i) { const int q = *(const int*)((const unsigned char*)p.f + (size_t)r * DM + i * 256 + lane * 4);
            ft[i * 4] = __builtin_amdgcn_cvt_f32_fp8(q, 0) * (1.f / 32.f); ft[i * 4 + 1] = __builtin_amdgcn_cvt_f32_fp8(q, 1) * (1.f / 32.f); ft[i * 4 + 2] = __builtin_amdgcn_cvt_f32_fp8(q, 2) * (1.f / 32.f); ft[i * 4 + 3] = __builtin_amdgcn_cvt_f32_fp8(q, 3) * (1.f / 32.f); }
        float fr8[16];
#pragma unroll
        for (int i = 0; i < 16; ++i) fr8[i] = 0.f;
#pragma unroll
        for (int k = 0; k < 8; ++k)
#pragma unroll
            for (int i = 0; i < 4; ++i) { const int q = (int)yraw[k][i];
                fr8[i * 4] += wk[k] * __builtin_amdgcn_cvt_f32_fp8(q, 0); fr8[i * 4 + 1] += wk[k] * __builtin_amdgcn_cvt_f32_fp8(q, 1); fr8[i * 4 + 2] += wk[k] * __builtin_amdgcn_cvt_f32_fp8(q, 2); fr8[i * 4 + 3] += wk[k] * __builtin_amdgcn_cvt_f32_fp8(q, 3); }
#pragma unroll
        for (int i = 0; i < 16; ++i) ft[i] += fr8[i] * (1.f / 16.f);
        float v[16];
#pragma unroll
        for (int i = 0; i < 4; ++i) { const float4 t = ld4((const bf16_t*)p.hbuf, (size_t)r * DM + i * 256 + lane * 4); v[i * 4] = t.x; v[i * 4 + 1] = t.y; v[i * 4 + 2] = t.z; v[i * 4 + 3] = t.w; }
        const int mi = mod_idx(r);
        const float* m5 = modv(p, l, mi, 5);
#pragma unroll
        for (int i = 0; i < 4; ++i) { const float4 m4 = *(const float4*)(m5 + i * 256 + lane * 4);
            v[i * 4] = ALPHA * v[i * 4] + m4.x * ft[i * 4]; v[i * 4 + 1] = ALPHA * v[i * 4 + 1] + m4.y * ft[i * 4 + 1]; v[i * 4 + 2] = ALPHA * v[i * 4 + 2] + m4.z * ft[i * 4 + 2]; v[i * 4 + 3] = ALPHA * v[i * 4 + 3] + m4.w * ft[i * 4 + 3]; }
        float mu, rstd; ln_stats(v, mu, rstd);
        const float* g = p.ln2g + l * DM; const float* bb = p.ln2b + l * DM;
        const int b = r / LTOT, j = r - b * LTOT;
#pragma unroll
        for (int i = 0; i < 4; ++i) { const int c = i * 256 + lane * 4; const float4 g4 = *(const float4*)(g + c), b4 = *(const float4*)(bb + c);
            v[i * 4 + 0] = (v[i * 4 + 0] - mu) * rstd * g4.x + b4.x; v[i * 4 + 1] = (v[i * 4 + 1] - mu) * rstd * g4.y + b4.y;
            v[i * 4 + 2] = (v[i * 4 + 2] - mu) * rstd * g4.z + b4.z; v[i * 4 + 3] = (v[i * 4 + 3] - mu) * rstd * g4.w + b4.w;
            const float4 o = make_float4(v[i * 4], v[i * 4 + 1], v[i * 4 + 2], v[i * 4 + 3]);
            if (l == 1) { if (j >= CTXL) *(float4*)(p.out + ((size_t)b * SEQ + (j - CTXL)) * DM + c) = o; }
            else st4((bf16_t*)p.hbuf, (size_t)r * DM + c, o); }
        if (l == 0) {
            ln_stats(v, mu, rstd);
            const float* sh = modv(p, 1, mi, 0); const float* sc = modv(p, 1, mi, 1);
#pragma unroll
            for (int i = 0; i < 4; ++i) { const int c = i * 256 + lane * 4; const float4 s4 = *(const float4*)(sh + c), c4 = *(const float4*)(sc + c);
                float4 o; o.x = (v[i * 4 + 0] - mu) * rstd * (1.f + c4.x) + s4.x; o.y = (v[i * 4 + 1] - mu) * rstd * (1.f + c4.y) + s4.y;
                o.z = (v[i * 4 + 2] - mu) * rstd * (1.f + c4.z) + s4.z; o.w = (v[i * 4 + 3] - mu) * rstd * (1.f + c4.w) + s4.w;
                st_fp8x4(p.u8, (size_t)r * DM + c, o); }
        }
    }
}

template <class T> __device__ __forceinline__ T* uni(T* p) { const unsigned long long v = (unsigned long long)p; const unsigned lo = __builtin_amdgcn_readfirstlane((unsigned)v), hi = __builtin_amdgcn_readfirstlane((unsigned)(v >> 32)); return (T*)(((unsigned long long)hi << 32) | lo); }
__device__ __forceinline__ int uni(int v) { return __builtin_amdgcn_readfirstlane(v); }
namespace pg8 {
#define PG8_LAS __attribute__((address_space(3)))
#define GAS __attribute__((address_space(1)))
typedef short bf16x8 __attribute__((ext_vector_type(8)));
typedef float f32x4 __attribute__((ext_vector_type(4)));
typedef unsigned u32x4 __attribute__((ext_vector_type(4)));
constexpr int BM = 256, BK = 64, HALF = 128, HTB = HALF * BK * 2, STAGE_BYTES = 8 * HTB, NXCD = 8, WGM = 8;
__host__ __device__ __forceinline__ int lds_byte(int r, int c) { const int st = (r >> 4) * 2 + (c >> 5), rr = r & 15, cc = c & 31, ob = rr * 64 + cc * 2; return st * 1024 + (ob ^ (((ob >> 9) & 1) << 5)); }
__host__ __device__ __forceinline__ void stage_rc(int b, int& R, int& C) { const int st = b / 1024, sb = b % 1024, swz = sb ^ (((sb >> 9) & 1) << 5); R = (st >> 1) * 16 + swz / 64; C = (st & 1) * 32 + (swz % 64) / 2; }
__host__ __device__ __forceinline__ int perm32(int rho) { const int n = rho >> 4, i = rho & 15; return 8 * (i >> 2) + 4 * n + (i & 3); }
struct Unit { const char* a; const char* b; int pm, pn, aux; };
typedef __bf16 bf16n2 __attribute__((ext_vector_type(2)));
typedef float f32n2 __attribute__((ext_vector_type(2)));
__device__ __forceinline__ unsigned cvt_pk_bf16(float lo, float hi) { return __builtin_bit_cast(unsigned, __builtin_convertvector((f32n2){lo, hi}, bf16n2)); }
__device__ __forceinline__ u32x4 pack8(const f32x4 v0, const f32x4 v1) { u32x4 w; w.x = cvt_pk_bf16(v0[0], v0[1]); w.y = cvt_pk_bf16(v0[2], v0[3]); w.z = cvt_pk_bf16(v1[0], v1[1]); w.w = cvt_pk_bf16(v1[2], v1[3]); return w; }

typedef int i32x8 __attribute__((ext_vector_type(8)));
typedef int i32x4 __attribute__((ext_vector_type(4)));
__device__ __forceinline__ f32x4 mfma_fp8(const bf16x8 (&b)[2], const bf16x8 (&a)[2], f32x4 c) {
    const i32x8 bv = __builtin_shufflevector(__builtin_bit_cast(i32x4, b[0]), __builtin_bit_cast(i32x4, b[1]), 0, 1, 2, 3, 4, 5, 6, 7);
    const i32x8 av = __builtin_shufflevector(__builtin_bit_cast(i32x4, a[0]), __builtin_bit_cast(i32x4, a[1]), 0, 1, 2, 3, 4, 5, 6, 7);
    asm volatile("v_mfma_f32_16x16x128_f8f6f4 %0, %1, %2, %0" : "+v"(c) : "v"(bv), "v"(av));
    return c;
}
typedef unsigned u32x2f __attribute__((ext_vector_type(2)));
__device__ __forceinline__ u32x2f pack8_fp8(const f32x4 v0, const f32x4 v1, const float s) {
    f32x4 a = v0 * s, b = v1 * s;
#pragma unroll
    for (int j = 0; j < 4; ++j) { a[j] = fminf(fmaxf(a[j], -448.f), 448.f); b[j] = fminf(fmaxf(b[j], -448.f), 448.f); }
    int q0 = 0, q1 = 0;
    q0 = __builtin_amdgcn_cvt_pk_fp8_f32(a[0], a[1], q0, false); q0 = __builtin_amdgcn_cvt_pk_fp8_f32(a[2], a[3], q0, true);
    q1 = __builtin_amdgcn_cvt_pk_fp8_f32(b[0], b[1], q1, false); q1 = __builtin_amdgcn_cvt_pk_fp8_f32(b[2], b[3], q1, true);
    return (u32x2f){(unsigned)q0, (unsigned)q1};
}
struct TileOrder {
    int nM, nN, nwg, G, c, sub, pn_off; bool skipctx;
    const char *A0, *B0; size_t a_tile, b_tile, a_sub, b_sub;
    __device__ __forceinline__ unsigned row_off(const Unit&, int) const { return 0u; }
    __device__ void init(int M, int N, int G_, int c_, int sub_) { nM = M / BM; nN = N / BM; nwg = nM * nN; G = G_; c = c_; sub = sub_; skipctx = false; pn_off = 0; }
    __device__ bool next(int i, Unit& u) const {
        const int ti = i / sub, s = i - ti * sub;
        const long L = (long)ti * G + c; if (L >= nwg) return false;
        int wgid = (int)L; { const int q = nwg / NXCD, r = nwg % NXCD, xcd = wgid % NXCD, off = wgid / NXCD; wgid = (xcd < r ? xcd * (q + 1) : r * (q + 1) + (xcd - r) * q) + off; }
        const int nig = WGM * nN, gid = wgid / nig, fm = gid * WGM, gsz = (nM - fm) < WGM ? (nM - fm) : WGM;
        u.pm = fm + ((wgid % nig) % gsz); u.pn = (wgid % nig) / gsz + pn_off; u.aux = s;
        if (skipctx) u.pm = (u.pm >> 3) * 9 + 1 + (u.pm & 7);
        u.a = A0 + (size_t)s * a_sub + (size_t)u.pm * a_tile; u.b = B0 + (size_t)s * b_sub + (size_t)u.pn * b_tile;
        return true;
    }
};

struct CtxKVOrder {
    int G, c; const char *A0, *B0; size_t a_tile, b_tile;
    __device__ __forceinline__ unsigned row_off(const Unit&, int) const { return 0u; }
    __device__ __forceinline__ bool next(int i, Unit& u) const {
        const int uid = i * G + c; if (uid >= 40) return false;
        const int b = uid / 5, k = uid - b * 5;
        u.pm = b * 9; u.pn = k == 0 ? 2 : 8 + k; u.aux = 0;
        u.a = A0 + (size_t)u.pm * a_tile; u.b = B0 + (size_t)u.pn * b_tile;
        return true;
    }
};
template <bool GATHER = false, bool FP8 = false, class Epi, class Sched>
__device__ __forceinline__ void gemm_phase(PG8_LAS unsigned char* lds, const int K, const int lda, const int ldb, const Sched& S, const Epi& E) {
    int tid = threadIdx.x; asm volatile("" : "+v"(tid));
    const int wid = __builtin_amdgcn_readfirstlane(tid >> 6), lane = tid & 63, wr = wid >> 2, wc = wid & 3, fr = lane & 15, fq = lane >> 4;
    const int nt = K / BK;
    unsigned voffA[2], voffB[2];
#pragma unroll
    for (int i = 0; i < 2; ++i) { int R, C; stage_rc(tid * 16 + i * 8192, R, C); const int Rb = (R & ~31) + perm32(R & 31);
        voffA[i] = (unsigned)(R * lda + C) * 2u; voffB[i] = (unsigned)(Rb * ldb + C) * 2u; }
    unsigned gc[2][2], gn[2][2];
    const size_t kstep = (size_t)(BK * 2);
    const size_t hstepA = (size_t)HALF * lda * 2, hstepB = (size_t)HALF * ldb * 2;
    const unsigned ldsw = (unsigned)wid * 1024u;
    const int aoff = lds_byte(wr * 64 + fr, fq * 8), boff = lds_byte(wc * 32 + fr, fq * 8);
#define PG8_SA(b, h) (((b) * 2 + (h)) * HTB)
#define PG8_SB(b, h) ((4 + (b) * 2 + (h)) * HTB)
#define PG8_STAGE(bufoff, gbase, voff) do { _Pragma("unroll") for (int _i = 0; _i < 2; ++_i) \
        __builtin_amdgcn_global_load_lds((const unsigned*)((const char*)(gbase) + (voff)[_i]), (PG8_LAS unsigned*)(lds + (bufoff) + ldsw + _i * 8192), 16, 0, 0); } while (0)
#define PG8_STAGE_A(bufoff, gbase, h, late) do { _Pragma("unroll") for (int _i = 0; _i < 2; ++_i) { \
        const size_t _o = GATHER ? (size_t)(((late) && last) ? gn[h][_i] : gc[h][_i]) : (size_t)voffA[_i] + (size_t)(h) * hstepA; \
        __builtin_amdgcn_global_load_lds((const unsigned*)((const char*)(gbase) + _o), (PG8_LAS unsigned*)(lds + (bufoff) + ldsw + _i * 8192), 16, 0, 0); } } while (0)
#define PG8_GOFF(dst, un) do { if (GATHER) { _Pragma("unroll") for (int _h = 0; _h < 2; ++_h) _Pragma("unroll") for (int _i = 0; _i < 2; ++_i) { int _R, _C; stage_rc(tid * 16 + _i * 8192, _R, _C); dst[_h][_i] = S.row_off(un, _h * HALF + _R) + (unsigned)(_C * 2); } } } while (0)
#define PG8_LDA(dst, b, h) do { _Pragma("unroll") for (int m = 0; m < 4; ++m) _Pragma("unroll") for (int k = 0; k < 2; ++k) dst[m][k] = *(const PG8_LAS bf16x8*)(lds + PG8_SA(b, h) + aoff + m * 2048 + k * 1024); } while (0)
#define PG8_LDB(dst, b, h) do { _Pragma("unroll") for (int n = 0; n < 2; ++n) _Pragma("unroll") for (int k = 0; k < 2; ++k) dst[n][k] = *(const PG8_LAS bf16x8*)(lds + PG8_SB(b, h) + boff + n * 2048 + k * 1024); } while (0)
#define PG8_MMA(ai, bj, At, Bt) do { __builtin_amdgcn_s_setprio(1); _Pragma("unroll") for (int m = 0; m < 4; ++m) _Pragma("unroll") for (int n = 0; n < 2; ++n) { \
        if constexpr (FP8) acc[ai][bj][m][n] = mfma_fp8(Bt[n], At[m], acc[ai][bj][m][n]); \
        else { _Pragma("unroll") for (int k = 0; k < 2; ++k) acc[ai][bj][m][n] = __builtin_amdgcn_mfma_f32_16x16x32_bf16(Bt[n][k], At[m][k], acc[ai][bj][m][n], 0, 0, 0); } } \
        __builtin_amdgcn_s_setprio(0); } while (0)
#define PG8_WAIT_V(n) asm volatile("s_waitcnt vmcnt(" #n ")" ::: "memory")
#define PG8_WAIT_L(n) asm volatile("s_waitcnt lgkmcnt(" #n ")" ::: "memory")
#define PG8_BAR __builtin_amdgcn_s_barrier()
#define PG8_SCHED __builtin_amdgcn_sched_barrier(0)
    Unit cur, nxt; int ui = 0;
    if (!S.next(0, cur)) return;
    f32x4 acc[2][2][4][2];
#pragma unroll
    for (int a = 0; a < 2; ++a)
#pragma unroll
        for (int b = 0; b < 2; ++b)
#pragma unroll
            for (int m = 0; m < 4; ++m)
#pragma unroll
                for (int n = 0; n < 2; ++n) acc[a][b][m][n] = (f32x4){0.f, 0.f, 0.f, 0.f};
    bf16x8 At[4][2], B0[2][2], B1[2][2];
    const char* cA = cur.a; const char* cB = cur.b;
    PG8_GOFF(gc, cur); PG8_GOFF(gn, cur);
    { const bool last = false;
    PG8_STAGE(PG8_SB(0, 0), cB, voffB); PG8_STAGE_A(PG8_SA(0, 0), cA, 0, false); PG8_STAGE(PG8_SB(0, 1), cB + hstepB, voffB); PG8_STAGE_A(PG8_SA(0, 1), cA, 1, false);
    if (wr == 1) PG8_BAR;
    PG8_WAIT_V(4); PG8_BAR;
    PG8_STAGE(PG8_SB(1, 0), cB + kstep, voffB); PG8_STAGE_A(PG8_SA(1, 0), cA + kstep, 0, false); PG8_STAGE(PG8_SB(1, 1), cB + hstepB + kstep, voffB); }
    PG8_WAIT_V(6); PG8_BAR;
    for (;;) {
        const bool has_next = S.next(ui + 1, nxt);
        const char* nA = has_next ? nxt.a : cA; const char* nB = has_next ? nxt.b : cB;
        if (has_next) PG8_GOFF(gn, nxt);
#pragma unroll 1
        for (int t = 0; t < nt; t += 2) {
            const bool last = (t == nt - 2);
            const char* a1 = cA + (size_t)(t + 1) * kstep;
            const char* a2 = last ? nA : cA + (size_t)(t + 2) * kstep; const char* b2 = last ? nB : cB + (size_t)(t + 2) * kstep;
            const char* a3 = a2 + kstep; const char* b3 = b2 + kstep;
            PG8_LDB(B0, 0, 0); PG8_SCHED; PG8_LDA(At, 0, 0); PG8_STAGE_A(PG8_SA(1, 1), a1, 1, false);
            PG8_WAIT_L(8); PG8_BAR; PG8_WAIT_L(0); PG8_MMA(0, 0, At, B0); PG8_BAR; PG8_SCHED;
            PG8_LDB(B1, 0, 1); PG8_STAGE(PG8_SB(0, 0), b2, voffB);
            PG8_BAR; PG8_WAIT_L(0); PG8_MMA(0, 1, At, B1); PG8_BAR;
            PG8_LDA(At, 0, 1); PG8_STAGE_A(PG8_SA(0, 0), a2, 0, true);
            PG8_BAR; PG8_WAIT_L(0); PG8_MMA(1, 0, At, B0); PG8_BAR; PG8_SCHED;
            PG8_STAGE(PG8_SB(0, 1), b2 + hstepB, voffB);
            PG8_WAIT_V(6); PG8_BAR; PG8_MMA(1, 1, At, B1); PG8_BAR;
            PG8_LDB(B0, 1, 0); PG8_SCHED; PG8_LDA(At, 1, 0); PG8_STAGE_A(PG8_SA(0, 1), a2, 1, true);
            PG8_WAIT_L(8); PG8_BAR; PG8_WAIT_L(0); PG8_MMA(0, 0, At, B0); PG8_BAR; PG8_SCHED;
            PG8_LDB(B1, 1, 1); PG8_STAGE(PG8_SB(1, 0), b3, voffB);
            PG8_BAR; PG8_WAIT_L(0); PG8_MMA(0, 1, At, B1); PG8_BAR;
            PG8_LDA(At, 1, 1); PG8_STAGE_A(PG8_SA(1, 0), a3, 0, true);
            PG8_BAR; PG8_WAIT_L(0); PG8_MMA(1, 0, At, B0); PG8_BAR; PG8_SCHED;
            PG8_STAGE(PG8_SB(1, 1), b3 + hstepB, voffB);
            PG8_WAIT_V(6); PG8_BAR; PG8_MMA(1, 1, At, B1); PG8_BAR;
        }
        if constexpr (FP8) asm volatile("s_nop 7\n\ts_nop 7\n\ts_nop 7" ::: "memory");
        const bool keep = E(acc, cur, wr, wc, fr, fq);
        if (!has_next) break;
        if (!keep) {
#pragma unroll
        for (int a = 0; a < 2; ++a)
#pragma unroll
            for (int b = 0; b < 2; ++b)
#pragma unroll
                for (int m = 0; m < 4; ++m)
#pragma unroll
                    for (int n = 0; n < 2; ++n) acc[a][b][m][n] = (f32x4){0.f, 0.f, 0.f, 0.f}; }
        cur = nxt; cA = nA; cB = nB; ++ui;
        if (GATHER) {
#pragma unroll
            for (int _h = 0; _h < 2; ++_h)
#pragma unroll
                for (int _i = 0; _i < 2; ++_i) gc[_h][_i] = gn[_h][_i]; }
    }
    PG8_WAIT_V(0);
    if (wr == 0) PG8_BAR;
    PG8_BAR;
#undef PG8_SA
#undef PG8_SB
#undef PG8_STAGE
#undef PG8_STAGE_A
#undef PG8_GOFF
#undef PG8_LDA
#undef PG8_LDB
#undef PG8_MMA
#undef PG8_WAIT_V
#undef PG8_WAIT_L
#undef PG8_BAR
#undef PG8_SCHED
}
typedef f32x4 Acc[2][2][4][2];

struct EpiStoreBf16 {
    bf16_t* O; int ldc;
    __device__ __forceinline__ bool operator()(Acc& acc, const Unit& u, int wr, int wc, int fr, int fq) const {
        const int row0 = u.pm * BM + wr * 64 + fr, col0 = u.pn * BM + wc * 32 + 8 * fq;
#pragma unroll
        for (int ai = 0; ai < 2; ++ai)
#pragma unroll
            for (int m = 0; m < 4; ++m) { bf16_t* rowp = O + (size_t)(row0 + ai * HALF + m * 16) * ldc + col0;
#pragma unroll
                for (int bj = 0; bj < 2; ++bj) *(GAS u32x4*)(rowp + bj * HALF) = pack8(acc[ai][bj][m][0], acc[ai][bj][m][1]); }
        return false;
    }
};
struct EpiStoreFp8 {
    unsigned char* O; int ldc; float scale;
    __device__ __forceinline__ bool operator()(Acc& acc, const Unit& u, int wr, int wc, int fr, int fq) const {
        const int row0 = u.pm * BM + wr * 64 + fr, col0 = u.pn * BM + wc * 32 + 8 * fq;
#pragma unroll
        for (int ai = 0; ai < 2; ++ai)
#pragma unroll
            for (int m = 0; m < 4; ++m) { unsigned char* rowp = O + (size_t)(row0 + ai * HALF + m * 16) * ldc + col0;
#pragma unroll
                for (int bj = 0; bj < 2; ++bj) *(GAS u32x2f*)(rowp + bj * HALF) = pack8_fp8(acc[ai][bj][m][0], acc[ai][bj][m][1], scale); }
        return false;
    }
};
struct EpiInproj {
    bf16_t* O; unsigned char* Gq; unsigned char* PF;
    __device__ __forceinline__ bool operator()(Acc& acc, const Unit& u, int wr, int wc, int fr, int fq) const {
        const int row0 = u.pm * BM + wr * 64 + fr, cw = wc * 32 + 8 * fq;
        const float sc = (u.pn >= 3 && u.pn < 7) ? 1.f / (16.f * 64.f) : 1.f / (16.f * 256.f);
        if (u.pn >= 3 && u.pn < 7) {
#pragma unroll
            for (int ai = 0; ai < 2; ++ai)
#pragma unroll
                for (int m = 0; m < 4; ++m) { unsigned char* rowp = PF + (size_t)(row0 + ai * HALF + m * 16) * 1024 + (u.pn - 3) * BM + cw;
#pragma unroll
                    for (int bj = 0; bj < 2; ++bj) *(GAS u32x2f*)(rowp + bj * HALF) = pack8_fp8(acc[ai][bj][m][0], acc[ai][bj][m][1], sc * 4.f); }
        } else if (u.pn < 13) {
#pragma unroll
            for (int ai = 0; ai < 2; ++ai)
#pragma unroll
                for (int m = 0; m < 4; ++m) { bf16_t* rowp = O + (size_t)(row0 + ai * HALF + m * 16) * PW + u.pn * BM + cw;
#pragma unroll
                    for (int bj = 0; bj < 2; ++bj) *(GAS u32x4*)(rowp + bj * HALF) = pack8(acc[ai][bj][m][0] * sc, acc[ai][bj][m][1] * sc); }
        } else {
            typedef unsigned u32x2e __attribute__((ext_vector_type(2)));
#pragma unroll
            for (int ai = 0; ai < 2; ++ai)
#pragma unroll
                for (int m = 0; m < 4; ++m) { unsigned char* rowp = Gq + (size_t)(row0 + ai * HALF + m * 16) * 1536 + (((u.pn - 13) * BM + cw) >> 1);
#pragma unroll
                    for (int bj = 0; bj < 2; ++bj) { f32x4 a0 = acc[ai][bj][m][0] * sc, a1 = acc[ai][bj][m][1] * sc;
                        unsigned w4 = 0u;
#pragma unroll
                        for (int j = 0; j < 4; ++j) { const float g0 = __builtin_amdgcn_rcpf(1.f + __expf(-a0[j])), g1 = __builtin_amdgcn_rcpf(1.f + __expf(-a1[j]));
                            const unsigned n0 = (unsigned)fminf(g0 * 16.f, 15.f), n1 = (unsigned)fminf(g1 * 16.f, 15.f);
                            w4 |= (n0 << (4 * j)) | (n1 << (16 + 4 * j)); }
                        *(GAS unsigned*)(rowp + bj * (HALF / 2)) = w4; } }
        }
        return false;
    }
};
struct EpiF32 {
    float* C; int ldc;
    __device__ __forceinline__ bool operator()(Acc& acc, const Unit& u, int wr, int wc, int fr, int fq) const {
        const int row0 = u.pm * BM + wr * 64 + fr, col0 = u.pn * BM + wc * 32 + 8 * fq;
#pragma unroll
        for (int ai = 0; ai < 2; ++ai)
#pragma unroll
            for (int m = 0; m < 4; ++m) { float* rowp = C + (size_t)(row0 + ai * HALF + m * 16) * ldc + col0;
#pragma unroll
                for (int bj = 0; bj < 2; ++bj) { *(GAS f32x4*)(rowp + bj * HALF) = acc[ai][bj][m][0]; *(GAS f32x4*)(rowp + bj * HALF + 4) = acc[ai][bj][m][1]; } }
        return false;
    }
};
__device__ __forceinline__ float fsig(float v) { return 1.f / (1.f + __expf(-v)); }
__device__ __forceinline__ void unpack8(const u32x4 w, float (&g)[8]) {
    g[0] = __uint_as_float(w.x << 16); g[1] = __uint_as_float(w.x & 0xFFFF0000u); g[2] = __uint_as_float(w.y << 16); g[3] = __uint_as_float(w.y & 0xFFFF0000u);
    g[4] = __uint_as_float(w.z << 16); g[5] = __uint_as_float(w.z & 0xFFFF0000u); g[6] = __uint_as_float(w.w << 16); g[7] = __uint_as_float(w.w & 0xFFFF0000u);
}
struct EpiY {
    const unsigned char* Gq; unsigned char* y;
    __device__ __forceinline__ bool operator()(Acc& acc, const Unit& u, int wr, int wc, int fr, int fq) const {
        const int row0 = u.pm * BM + wr * 64 + fr, col0 = u.pn * BM + wc * 32 + 8 * fq, br = u.aux;
        unsigned ga[2][4][2], gb[2][4][2];
#pragma unroll
        for (int ai = 0; ai < 2; ++ai)
#pragma unroll
            for (int m = 0; m < 4; ++m)
#pragma unroll
                for (int bj = 0; bj < 2; ++bj) { const unsigned char* gp = Gq + (size_t)(row0 + ai * HALF + m * 16) * 1536 + br * 512 + ((col0 + bj * HALF) >> 1);
                    ga[ai][m][bj] = *(const GAS unsigned*)gp; gb[ai][m][bj] = br < 2 ? *(const GAS unsigned*)(gp + 512) : ga[ai][m][bj]; }
#pragma unroll
        for (int ai = 0; ai < 2; ++ai)
#pragma unroll
            for (int m = 0; m < 4; ++m)
#pragma unroll
                for (int bj = 0; bj < 2; ++bj) {
#pragma unroll
                    for (int j = 0; j < 8; ++j) { const float a = (float)((ga[ai][m][bj] >> (4 * j)) & 15u) * (1.f / 16.f) + (1.f / 32.f), b = (float)((gb[ai][m][bj] >> (4 * j)) & 15u) * (1.f / 16.f) + (1.f / 32.f);
                        const float f = br < 2 ? a * __builtin_amdgcn_rcpf(b) : a;
                        if (j < 4) acc[ai][bj][m][0][j] *= f; else acc[ai][bj][m][1][j - 4] *= f; }
                    if (br == 2) *(GAS u32x2f*)(y + (size_t)(row0 + ai * HALF + m * 16) * DM + col0 + bj * HALF) = pack8_fp8(acc[ai][bj][m][0], acc[ai][bj][m][1], 16.f / 4096.f); }
        return br != 2;
    }
};
struct EpiZ {
    const float* hsrc_x; const float* hsrc_ctx; const bf16_t* hbuf; const float* mod2; bf16_t* z; int layer;
    __device__ __forceinline__ bool operator()(Acc& acc, const Unit& u, int wr, int wc, int fr, int fq) const {
        const int b = u.pm / 9, jt = u.pm - b * 9;
        const float* hbase = jt == 0 ? hsrc_ctx + (size_t)b * CTXL * DM : hsrc_x + ((size_t)b * SEQ + (jt - 1) * 256) * DM;
        const bf16_t* hb16 = hbuf + (size_t)u.pm * BM * DM;
        const float* m2 = mod2 + (size_t)(jt == 0 ? 8 : b) * 6144;
        int rl0 = wr * 64 + fr; asm volatile("" : "+v"(rl0));
        const int col0 = u.pn * BM + wc * 32 + 8 * fq;
#pragma unroll
        for (int bj = 0; bj < 2; ++bj) { const int c = col0 + bj * HALF; const f32x4 ma = *(const GAS f32x4*)(m2 + c) * (1.f / 8192.f), mb = *(const GAS f32x4*)(m2 + c + 4) * (1.f / 8192.f);
#pragma unroll
            for (int ai = 0; ai < 2; ++ai) {
                f32x4 h0[4], h1[4];
                if (layer == 0) {
#pragma unroll
                    for (int m = 0; m < 4; ++m) { const float* hp = hbase + (size_t)(rl0 + ai * HALF + m * 16) * DM + c; h0[m] = *(const GAS f32x4*)hp; h1[m] = *(const GAS f32x4*)(hp + 4); }
                } else {
                    u32x4 hr[4];
#pragma unroll
                    for (int m = 0; m < 4; ++m) hr[m] = *(const GAS u32x4*)(hb16 + (size_t)(rl0 + ai * HALF + m * 16) * DM + c);
#pragma unroll
                    for (int m = 0; m < 4; ++m) { float t[8]; unpack8(hr[m], t); h0[m] = (f32x4){t[0], t[1], t[2], t[3]}; h1[m] = (f32x4){t[4], t[5], t[6], t[7]}; }
                }
#pragma unroll
                for (int m = 0; m < 4; ++m) { bf16_t* zp = z + ((size_t)u.pm * BM + rl0 + ai * HALF + m * 16) * DM + c;
                    *(GAS u32x4*)zp = pack8(ALPHA * h0[m] + ma * acc[ai][bj][m][0], ALPHA * h1[m] + mb * acc[ai][bj][m][1]); } } }
        return false;
    }
};
struct EpiG {
    float* logits; bf16_t* shact;
    __device__ __forceinline__ bool operator()(Acc& acc, const Unit& u, int wr, int wc, int fr, int fq) const {
        const int row0 = u.pm * BM + wr * 64 + fr, cw = wc * 32 + 8 * fq;
#pragma unroll
        for (int ai = 0; ai < 2; ++ai)
#pragma unroll
            for (int m = 0; m < 4; ++m) { const size_t row = (size_t)(row0 + ai * HALF + m * 16);
                if (u.pn == 0) {
#pragma unroll
                    for (int bj = 0; bj < 2; ++bj) { float* lp = logits + row * 256 + bj * HALF + cw; *(f32x4*)lp = acc[ai][bj][m][0]; *(GAS f32x4*)(lp + 4) = acc[ai][bj][m][1]; }
                } else {
                    f32x4 v0, v1;
#pragma unroll
                    for (int j = 0; j < 4; ++j) { const float g0 = acc[ai][0][m][0][j], g1 = acc[ai][0][m][1][j];
                        v0[j] = g0 * fsig(g0) * acc[ai][1][m][0][j]; v1[j] = g1 * fsig(g1) * acc[ai][1][m][1][j]; }
                    *(GAS u32x4*)(shact + row * 256 + (u.pn - 1) * 128 + cw) = pack8(v0, v1);
                } }
        return false;
    }
};

struct ExpOrder {
    const PG8_LAS int* ustart; const int* eoff; const int* slot_tok; int nct, nun, G, c; bool gather;
    const char* A; const char* B; size_t b_exp, b_tile; unsigned lda_bytes;
    __device__ __forceinline__ bool next(int i, Unit& u) const {
        const int cv = ((c & 7) << 5) | (c >> 3);
        const int uid = i * G + cv; if (uid >= nun) return false;
        const int ub = uid / nct, ct = uid - ub * nct;
        int lo = 0, hi = 255; while (lo < hi) { const int mid = (lo + hi + 1) >> 1; if (ustart[mid] <= ub) lo = mid; else hi = mid - 1; }
        const int e = lo, s0 = ustart[320 + e] + (ub - ustart[e]) * 256;
        u.pm = s0; u.aux = ustart[320 + e + 1]; u.pn = ct;
        u.b = B + (size_t)e * b_exp + (size_t)ct * b_tile; u.a = gather ? A : A + (size_t)s0 * lda_bytes;
        return true;
    }
    __device__ __forceinline__ unsigned row_off(const Unit& u, int r) const { const int s = u.pm + r; const int t = s < u.aux ? ((const GAS int*)slot_tok)[s] : 0; return (unsigned)t * lda_bytes; }
};
struct EpiHs {
    unsigned char* Hs; const float* slot_w;
    __device__ __forceinline__ bool operator()(Acc& acc, const Unit& u, int wr, int wc, int fr, int fq) const {
        typedef unsigned u32x2e __attribute__((ext_vector_type(2)));
        const int cw = u.pn * 128 + wc * 32 + 8 * fq;
#pragma unroll
        for (int ai = 0; ai < 2; ++ai)
#pragma unroll
            for (int m = 0; m < 4; ++m) { const int s = u.pm + ai * HALF + wr * 64 + m * 16 + fr;
                const float ws = 4.f / 4096.f;
                f32x4 v0, v1;
#pragma unroll
                for (int j = 0; j < 4; ++j) { const float g0 = acc[ai][0][m][0][j] * (1.f / 4096.f), g1 = acc[ai][0][m][1][j] * (1.f / 4096.f);
                    v0[j] = fminf(fmaxf(g0 * fsig(g0) * acc[ai][1][m][0][j] * ws, -448.f), 448.f); v1[j] = fminf(fmaxf(g1 * fsig(g1) * acc[ai][1][m][1][j] * ws, -448.f), 448.f); }
                int q0 = 0, q1 = 0;
                q0 = __builtin_amdgcn_cvt_pk_fp8_f32(v0[0], v0[1], q0, false); q0 = __builtin_amdgcn_cvt_pk_fp8_f32(v0[2], v0[3], q0, true);
                q1 = __builtin_amdgcn_cvt_pk_fp8_f32(v1[0], v1[1], q1, false); q1 = __builtin_amdgcn_cvt_pk_fp8_f32(v1[2], v1[3], q1, true);
                if (s < u.aux) *(GAS u32x2e*)(Hs + (size_t)s * 256 + cw) = (u32x2e){(unsigned)q0, (unsigned)q1}; }
        return false;
    }
};
struct EpiYs {
    unsigned char* Ys;
    __device__ __forceinline__ bool operator()(Acc& acc, const Unit& u, int wr, int wc, int fr, int fq) const {
        typedef unsigned u32x2e __attribute__((ext_vector_type(2)));
        const int col0 = u.pn * BM + wc * 32 + 8 * fq;
#pragma unroll
        for (int ai = 0; ai < 2; ++ai)
#pragma unroll
            for (int m = 0; m < 4; ++m) { const int s = u.pm + ai * HALF + wr * 64 + m * 16 + fr;
                if (s < u.aux) {
#pragma unroll
                    for (int bj = 0; bj < 2; ++bj) { f32x4 a0 = acc[ai][bj][m][0] * (1.f / 64.f), a1 = acc[ai][bj][m][1] * (1.f / 64.f);
#pragma unroll
                        for (int j = 0; j < 4; ++j) { a0[j] = fminf(fmaxf(a0[j], -400.f), 400.f); a1[j] = fminf(fmaxf(a1[j], -400.f), 400.f); }
                        int q0 = 0, q1 = 0;
                        q0 = __builtin_amdgcn_cvt_pk_fp8_f32(a0[0], a0[1], q0, false); q0 = __builtin_amdgcn_cvt_pk_fp8_f32(a0[2], a0[3], q0, true);
                        q1 = __builtin_amdgcn_cvt_pk_fp8_f32(a1[0], a1[1], q1, false); q1 = __builtin_amdgcn_cvt_pk_fp8_f32(a1[2], a1[3], q1, true);
                        *(GAS u32x2e*)(Ys + (size_t)s * DM + col0 + bj * HALF) = (u32x2e){(unsigned)q0, (unsigned)q1}; } } }
        return false;
    }
};
}

__device__ __forceinline__ void xpose64(const float* src, size_t ldsrc, bf16_t* drow, size_t K) {
#pragma unroll 1
    for (int hh = 0; hh < 2; ++hh) {
        float4 v[32];
#pragma unroll
        for (int j = 0; j < 32; ++j) v[j] = *(const float4*)(src + (size_t)(hh * 32 + j) * ldsrc);
#pragma unroll
        for (int q = 0; q < 4; ++q) { pg8::u32x4 o;
            o.x = pg8::cvt_pk_bf16(v[8 * q + 0].x, v[8 * q + 1].x); o.y = pg8::cvt_pk_bf16(v[8 * q + 2].x, v[8 * q + 3].x); o.z = pg8::cvt_pk_bf16(v[8 * q + 4].x, v[8 * q + 5].x); o.w = pg8::cvt_pk_bf16(v[8 * q + 6].x, v[8 * q + 7].x);
            *(GAS pg8::u32x4*)(drow + hh * 32 + q * 8) = o; }
#pragma unroll
        for (int q = 0; q < 4; ++q) { pg8::u32x4 o;
            o.x = pg8::cvt_pk_bf16(v[8 * q + 0].y, v[8 * q + 1].y); o.y = pg8::cvt_pk_bf16(v[8 * q + 2].y, v[8 * q + 3].y); o.z = pg8::cvt_pk_bf16(v[8 * q + 4].y, v[8 * q + 5].y); o.w = pg8::cvt_pk_bf16(v[8 * q + 6].y, v[8 * q + 7].y);
            *(GAS pg8::u32x4*)(drow + K + hh * 32 + q * 8) = o; }
#pragma unroll
        for (int q = 0; q < 4; ++q) { pg8::u32x4 o;
            o.x = pg8::cvt_pk_bf16(v[8 * q + 0].z, v[8 * q + 1].z); o.y = pg8::cvt_pk_bf16(v[8 * q + 2].z, v[8 * q + 3].z); o.z = pg8::cvt_pk_bf16(v[8 * q + 4].z, v[8 * q + 5].z); o.w = pg8::cvt_pk_bf16(v[8 * q + 6].z, v[8 * q + 7].z);
            *(GAS pg8::u32x4*)(drow + 2 * K + hh * 32 + q * 8) = o; }
#pragma unroll
        for (int q = 0; q < 4; ++q) { pg8::u32x4 o;
            o.x = pg8::cvt_pk_bf16(v[8 * q + 0].w, v[8 * q + 1].w); o.y = pg8::cvt_pk_bf16(v[8 * q + 2].w, v[8 * q + 3].w); o.z = pg8::cvt_pk_bf16(v[8 * q + 4].w, v[8 * q + 5].w); o.w = pg8::cvt_pk_bf16(v[8 * q + 6].w, v[8 * q + 7].w);
            *(GAS pg8::u32x4*)(drow + 3 * K + hh * 32 + q * 8) = o; }
    }
}
__device__ __forceinline__ void phase_wprep(const Params& p, int part, float* lds) {
    int tid_ = threadIdx.x; asm volatile("" : "+v"(tid_));
    const int wid = tid_ >> 6, lane = tid_ & 63;
    const int gw = blockIdx.x * 8 + wid, ngw = gridDim.x * 8;
    {
        const int gtid = blockIdx.x * NTHR + tid_, gn = gridDim.x * NTHR;
        for (int i = gtid; i < 2 * 1024 * 2048 + 256 * 512; i += gn) {
            int ph; bool sn; bf16_t* dst;
            if (i < 2 * 1024 * 2048) { const int par = i >> 21, m = (i >> 11) & 1023, k = i & 2047, n = k & 1023; sn = k >= 1024; ph = ((2 * m + par) * n) & 2047; dst = (par ? p.Do : p.De) + (size_t)m * 2048 + k; }
            else { const int q = i - 2 * 1024 * 2048, kk = q >> 9, k = q & 511, n = k & 255; sn = k >= 256; ph = (8 * kk * n) & 2047; dst = p.Dc + q; }
            const float a = (float)ph * (1.f / 1024.f);
            *dst = f2bf(sn ? -sinpif(a) : cospif(a));
        }
    }
}

#define LDS_U(lds) ((PG8_LAS unsigned char*)(unsigned)__builtin_amdgcn_readfirstlane((unsigned)(unsigned long long)(PG8_LAS unsigned char*)(lds)))
__device__ __forceinline__ void phase_inproj_f(const Params& p, int l_, float* lds, bool deferred) {
    const int l = uni(l_);
    const int NC = l == 1 ? 23 : 24;
    pg8::EpiInproj E; E.O = uni(p.P); E.Gq = uni(p.Gq); E.PF = uni(p.PF);
    {
        pg8::TileOrder S;
        if (!deferred) S.init(l == 1 ? 64 * 256 : T_ALL, NC * 256, gridDim.x, blockIdx.x, 1);
        else { S.init(l == 1 ? 64 * 256 : T_ALL, (25 - NC) * 256, gridDim.x, (blockIdx.x + 128) & 255, 1); S.pn_off = NC; }
        S.skipctx = (l == 1);
        S.A0 = (const char*)uni(p.u8); S.B0 = (const char*)uni(p.Wt_in) + (size_t)l * PW * 1024; S.a_tile = (size_t)256 * 1024; S.b_tile = (size_t)256 * 1024; S.a_sub = 0; S.b_sub = 0;
        pg8::gemm_phase<false, true>(LDS_U(lds), 512, 512, 512, S, E);
    }
    if (l == 1 && !deferred) {
        pg8::CtxKVOrder S; S.G = gridDim.x; S.c = (blockIdx.x + 64) & 255;
        S.A0 = (const char*)uni(p.u8); S.B0 = (const char*)uni(p.Wt_in) + (size_t)l * PW * 1024; S.a_tile = (size_t)256 * 1024; S.b_tile = (size_t)256 * 1024;
        pg8::gemm_phase<false, true>(LDS_U(lds), 512, 512, 512, S, E);
    }
}
__device__ __forceinline__ void phase_ygemm_f(const Params& p, int l_, float* lds) {
    const int l = uni(l_);
    pg8::TileOrder S; S.init(l == 1 ? 64 * 256 : T_ALL, DM, gridDim.x, blockIdx.x, 3); S.skipctx = (l == 1);
    S.A0 = (const char*)uni(p.oa); S.a_sub = (size_t)T_ALL * 512 * 2;
    S.B0 = (const char*)uni(p.Wt_br) + (size_t)l * 3 * 1024 * 512; S.b_sub = (size_t)1024 * 512;
    S.a_tile = (size_t)256 * 512; S.b_tile = (size_t)256 * 512;
    pg8::EpiY E; E.Gq = uni(p.Gq); E.y = (unsigned char*)uni(p.y);
    pg8::gemm_phase<false, true>(LDS_U(lds), 256, 256, 256, S, E);
}
__device__ __forceinline__ void phase_outproj_f(const Params& p, int l_, float* lds) {
    const int l = uni(l_);
    pg8::TileOrder S; S.init(l == 1 ? 64 * 256 : T_ALL, DM, gridDim.x, blockIdx.x, 1); S.skipctx = (l == 1);
    S.A0 = (const char*)uni(p.y); S.B0 = (const char*)uni(p.Wt_out) + (size_t)l * 1024 * 1024; S.a_tile = (size_t)256 * 1024; S.b_tile = (size_t)256 * 1024; S.a_sub = 0; S.b_sub = 0;
    pg8::EpiZ E; E.hsrc_x = uni(p.x); E.hsrc_ctx = uni(p.ctx); E.hbuf = (const bf16_t*)uni(p.hbuf); E.mod2 = uni(p.mod) + (size_t)l * 9 * 6144 + 2 * 1024; E.z = (bf16_t*)uni(p.z); E.layer = l;
    pg8::gemm_phase<false, true>(LDS_U(lds), 512, 512, 512, S, E);
}
__device__ __forceinline__ void phase_router_shared_f(const Params& p, int l_, float* lds) {
    const int l = uni(l_);
    pg8::TileOrder S; S.init(l == 1 ? 64 * 256 : T_ALL, 768, gridDim.x, blockIdx.x, 1); S.skipctx = (l == 1);
    S.A0 = (const char*)uni(p.u); S.B0 = (const char*)(uni(p.Wt_g) + (size_t)l * 768 * 1024); S.a_tile = (size_t)256 * 1024 * 2; S.b_tile = (size_t)256 * 1024 * 2; S.a_sub = 0; S.b_sub = 0;
    pg8::EpiG E; E.logits = uni(p.logits); E.shact = uni(p.shact);
    pg8::gemm_phase(LDS_U(lds), 1024, 1024, 1024, S, E);
}
__device__ __forceinline__ void phase_shdown_f(const Params& p, int l_, float* lds) {
    const int l = uni(l_);
    pg8::TileOrder S; S.init(l == 1 ? 64 * 256 : T_ALL, DM, gridDim.x, blockIdx.x, 1); S.skipctx = (l == 1);
    S.A0 = (const char*)uni(p.shact); S.B0 = (const char*)(uni(p.Wt_sd) + (size_t)l * 1024 * 256); S.a_tile = (size_t)256 * 256 * 2; S.b_tile = (size_t)256 * 256 * 2; S.a_sub = 0; S.b_sub = 0;
    pg8::EpiStoreFp8 E; E.O = (unsigned char*)uni(p.f); E.ldc = DM; E.scale = 32.f;
    pg8::gemm_phase(LDS_U(lds), 256, 256, 256, S, E);
}

__device__ __noinline__ void phase_normrope(const Params& p, int l) {
    const int wid = threadIdx.x >> 6, lane = threadIdx.x & 63, li = lane & 7;
    float qg[8], kg[8];
#pragma unroll
    for (int j = 0; j < 8; ++j) { qg[j] = p.qn[l * 64 + li * 8 + j]; kg[j] = p.kn[l * 64 + li * 8 + j]; }
    const int tio = (li >> 2) * 16 + (li & 1) * 8;
    pg8::u32x4 raw[4], rawn[4]; float4 tb[4], tbn[4];
    auto load = [&](int r, pg8::u32x4 (&rw)[4], float4 (&t)[4]) {
        const int b = r / LTOT, j0 = r - b * LTOT; const int s = j0 >= CTXL ? j0 - CTXL : 0;
        t[0] = *(const float4*)(p.ropec + s * 32 + tio); t[1] = *(const float4*)(p.ropec + s * 32 + tio + 4); t[2] = *(const float4*)(p.ropes + s * 32 + tio); t[3] = *(const float4*)(p.ropes + s * 32 + tio + 4);
        const bf16_t* row = p.P + (size_t)r * PW;
        rw[0] = *(const pg8::u32x4*)(row + C_QA + lane * 8);
        rw[1] = lane < 16 ? *(const pg8::u32x4*)(row + C_KA + lane * 8) : (pg8::u32x4){0u, 0u, 0u, 0u};
        rw[2] = *(const pg8::u32x4*)(row + C_QC + lane * 8);
        rw[3] = *(const pg8::u32x4*)(row + C_KC + lane * 8); };
    const int stride = gridDim.x * 8;
    int r = blockIdx.x * 8 + wid;
    if (r < T_ALL) load(r, raw, tb);
    for (; r < T_ALL; r += stride) {
        if (r + stride < T_ALL) load(r + stride, rawn, tbn);
        const int b = r / LTOT, j0 = r - b * LTOT; const bool lat = j0 >= CTXL;
        float cs[8], sn[8];
        cs[0] = tb[0].x; cs[1] = tb[0].y; cs[2] = tb[0].z; cs[3] = tb[0].w; cs[4] = tb[1].x; cs[5] = tb[1].y; cs[6] = tb[1].z; cs[7] = tb[1].w;
        sn[0] = tb[2].x; sn[1] = tb[2].y; sn[2] = tb[2].z; sn[3] = tb[2].w; sn[4] = tb[3].x; sn[5] = tb[3].y; sn[6] = tb[3].z; sn[7] = tb[3].w;
        if (!lat) {
#pragma unroll
            for (int j = 0; j < 8; ++j) { cs[j] = 1.f; sn[j] = 0.f; } }
        bf16_t* row = p.P + (size_t)r * PW;
#pragma unroll
        for (int i = 0; i < 4; ++i) {
            float x[8]; pg8::unpack8(raw[i], x);
            if (i < 2) {
                float ss = 0.f;
#pragma unroll
                for (int j = 0; j < 8; ++j) ss += x[j] * x[j];
                ss += __shfl_xor(ss, 1); ss += __shfl_xor(ss, 2); ss += __shfl_xor(ss, 4);
                const float sc = rsqrtf(ss * (1.f / 64.f) + 1e-6f);
#pragma unroll
                for (int j = 0; j < 8; ++j) x[j] *= sc * (i == 0 ? qg[j] : kg[j]);
            }
            float y[8];
#pragma unroll
            for (int j = 0; j < 8; ++j) { const float pr = __shfl_xor(x[j], 2); const float rot = (li & 2) ? pr : -pr; y[j] = x[j] * cs[j] + rot * sn[j]; }
            pg8::u32x4 o; o.x = pg8::cvt_pk_bf16(y[0], y[1]); o.y = pg8::cvt_pk_bf16(y[2], y[3]); o.z = pg8::cvt_pk_bf16(y[4], y[5]); o.w = pg8::cvt_pk_bf16(y[6], y[7]);
            const int col = i == 0 ? C_QA : i == 1 ? C_KA : i == 2 ? C_QC : C_KC;
            if (i != 1 || lane < 16) *(pg8::u32x4*)(row + col + lane * 8) = o;
        }
#pragma unroll
        for (int i = 0; i < 4; ++i) { raw[i] = rawn[i]; tb[i] = tbn[i]; }
    }
}
__device__ __noinline__ void phase_xt(const Params& p, bool do_ctx, float* lds) {
    const int wid = threadIdx.x >> 6, lane = threadIdx.x & 63;
    bf16_t* te = (bf16_t*)lds + wid * (2 * 64 * 72);
    bf16_t* to = te + 64 * 72;
    __syncthreads();
    const int gw = blockIdx.x * 8 + wid, ngw = gridDim.x * 8;
    const int nlat = 8 * 2 * 8 * 16, nctx = do_ctx ? 8 * 2 * 8 * 4 : 0;
    for (int it = gw; it < nlat + nctx; it += ngw) {
        const bool lat = it < nlat; const int q = lat ? it : it - nlat;
        int b, wh, cb, nb;
        if (lat) { b = q >> 8; wh = (q >> 7) & 1; cb = (q >> 4) & 7; nb = q & 15; } else { b = q >> 6; wh = (q >> 5) & 1; cb = (q >> 2) & 7; nb = q & 3; }
        const int r8 = lane >> 3, c8 = (lane & 7) * 8;
#pragma unroll
        for (int i = 0; i < 8; ++i) {
            const int n = nb * 64 + i * 8 + r8;
            const size_t row = (size_t)b * LTOT + (lat ? CTXL + n : n);
            const unsigned char* src = p.PF + row * 1024 + wh * 512 + cb * 64 + c8;
            float x0[8], x1[8];
            typedef float f32x2x __attribute__((ext_vector_type(2)));
            { const pg8::u32x2f w0 = *(const GAS pg8::u32x2f*)src, w1 = lat ? *(const GAS pg8::u32x2f*)(src + (size_t)1024 * 1024) : w0;
#pragma unroll
              for (int h = 0; h < 2; ++h) { const int a = (int)(h ? w0.y : w0.x), bq = (int)(h ? w1.y : w1.x);
                  const f32x2x a0 = __builtin_amdgcn_cvt_pk_f32_fp8(a, false), a1 = __builtin_amdgcn_cvt_pk_f32_fp8(a, true), b0 = __builtin_amdgcn_cvt_pk_f32_fp8(bq, false), b1 = __builtin_amdgcn_cvt_pk_f32_fp8(bq, true);
                  x0[4 * h] = a0[0] * 0.25f; x0[4 * h + 1] = a0[1] * 0.25f; x0[4 * h + 2] = a1[0] * 0.25f; x0[4 * h + 3] = a1[1] * 0.25f;
                  x1[4 * h] = b0[0] * 0.25f; x1[4 * h + 1] = b0[1] * 0.25f; x1[4 * h + 2] = b1[0] * 0.25f; x1[4 * h + 3] = b1[1] * 0.25f; } }
#pragma unroll
            for (int j = 0; j < 8; ++j) { te[(c8 + j) * 72 + i * 8 + r8] = f2bf(lat ? x0[j] + x1[j] : x0[j]); if (lat) to[(c8 + j) * 72 + i * 8 + r8] = f2bf(x0[j] - x1[j]); }
        }
        asm volatile("s_waitcnt lgkmcnt(0)" ::: "memory");
#pragma unroll
        for (int i = 0; i < 8; ++i) {
            const int cc = i * 8 + r8;
            const size_t xr = (size_t)b * 512 + cb * 64 + cc;
            if (lat) {
                *(GAS pg8::u32x4*)(p.XTe + xr * 2048 + wh * 1024 + nb * 64 + c8) = *(const pg8::u32x4*)(te + cc * 72 + c8);
                *(GAS pg8::u32x4*)(p.XTo + xr * 2048 + wh * 1024 + nb * 64 + c8) = *(const pg8::u32x4*)(to + cc * 72 + c8);
            } else *(GAS pg8::u32x4*)(p.XTc + xr * 512 + wh * 256 + nb * 64 + c8) = *(const pg8::u32x4*)(te + cc * 72 + c8);
        }
        asm volatile("s_waitcnt lgkmcnt(0)" ::: "memory");
    }
    for (int it = gw; it < 8 * 10 * 36; it += ngw) {
        const int b = it / 360, r = it - b * 360, cb = r / 36, kb = r - cb * 36;
        const int scol = cb < 2 ? C_VA + cb * 64 : C_VC + (cb - 2) * 64;
        bf16_t* dst = cb < 2 ? p.VTa + ((size_t)b * 128 + cb * 64) * LTOT : p.VTc + ((size_t)b * 512 + (cb - 2) * 64) * LTOT;
        const int r8 = lane >> 3, c8 = (lane & 7) * 8;
#pragma unroll
        for (int i = 0; i < 8; ++i) {
            const bf16_t* s = p.P + ((size_t)b * LTOT + kb * 64 + i * 8 + r8) * PW + scol + c8;
            const pg8::u32x4 w = *(const pg8::u32x4*)s;
            const unsigned ww[4] = {w.x, w.y, w.z, w.w};
#pragma unroll
            for (int j = 0; j < 8; ++j) te[(c8 + j) * 72 + i * 8 + r8] = (bf16_t)(ww[j >> 1] >> ((j & 1) * 16));
        }
        asm volatile("s_waitcnt lgkmcnt(0)" ::: "memory");
#pragma unroll
        for (int i = 0; i < 8; ++i) { const int cc = i * 8 + r8;
            *(GAS pg8::u32x4*)(dst + (size_t)cc * LTOT + kb * 64 + c8) = *(const pg8::u32x4*)(te + cc * 72 + c8); }
        asm volatile("s_waitcnt lgkmcnt(0)" ::: "memory");
    }
}
namespace pg8 {
struct FoOrder {
    const char *De, *Do, *XTe, *XTo; int nun, G, c; bool ctx;
    __device__ __forceinline__ unsigned row_off(const Unit&, int) const { return 0u; }
    __device__ __forceinline__ bool next(int i, Unit& u) const {
        const int uid = i * G + c; if (uid >= nun) return false;
        u.pm = ctx ? 0 : uid >> 4; u.pn = uid & 15; u.aux = 0;
        const size_t kb = ctx ? 512 * 2 : 2048 * 2;
        u.a = (u.pm < 4 ? De + (size_t)u.pm * 256 * kb : Do + (size_t)(u.pm - 4) * 256 * kb);
        u.b = (u.pm < 4 ? XTe : XTo) + (size_t)u.pn * 256 * kb;
        return true;
    }
};
struct EpiFo {
    unsigned char* ob; float scale; bool ctx;
    __device__ __forceinline__ bool operator()(Acc& acc, const Unit& u, int wr, int wc, int fr, int fq) const {
        const int b = u.pn >> 1, col0 = (u.pn & 1) * 256 + wc * 32 + 8 * fq;
        const int par = u.pm >> 2, m0 = (u.pm & 3) * 256;
#pragma unroll
        for (int ai = 0; ai < 2; ++ai)
#pragma unroll
            for (int m = 0; m < 4; ++m) { const int rl = ai * HALF + wr * 64 + m * 16 + fr;
                const size_t row = (size_t)b * LTOT + (ctx ? rl : CTXL + 2 * (m0 + rl) + par);
#pragma unroll
                for (int bj = 0; bj < 2; ++bj) *(GAS u32x2f*)(ob + row * 512 + col0 + bj * HALF) = pack8_fp8(acc[ai][bj][m][0], acc[ai][bj][m][1], scale * 16.f); }
        return false;
    }
};
}
__device__ __forceinline__ void phase_fourier_f(const Params& p, bool do_ctx, float* lds) {
    {
        pg8::FoOrder S; S.De = (const char*)uni(p.De); S.Do = (const char*)uni(p.Do); S.XTe = (const char*)uni(p.XTe); S.XTo = (const char*)uni(p.XTo); S.nun = 128; S.G = gridDim.x; S.c = blockIdx.x; S.ctx = false;
        pg8::EpiFo E; E.ob = (unsigned char*)uni(p.ob); E.scale = 1.f / 512.f; E.ctx = false;
        pg8::gemm_phase<false>(LDS_U(lds), 2048, 2048, 2048, S, E);
    }
    if (do_ctx) {
        pg8::FoOrder S; S.De = (const char*)uni(p.Dc); S.Do = S.De; S.XTe = (const char*)uni(p.XTc); S.XTo = S.XTe; S.nun = 16; S.G = gridDim.x; S.c = (blockIdx.x + 56) & 255; S.ctx = true;
        pg8::EpiFo E; E.ob = (unsigned char*)uni(p.ob); E.scale = 0.00552427172802f; E.ctx = true;
        pg8::gemm_phase<false>(LDS_U(lds), 512, 512, 512, S, E);
    }
}

namespace fa {
typedef short bf16x8 __attribute__((ext_vector_type(8)));
typedef short bf16x4 __attribute__((ext_vector_type(4)));
typedef float f32x16 __attribute__((ext_vector_type(16)));
typedef unsigned u32x2 __attribute__((ext_vector_type(2)));
typedef float f32x2 __attribute__((ext_vector_type(2)));
#define FA_KROW 144
#define FA_VROW 136
#define FA_C 0.18033688011f
template <int DV>
__device__ __forceinline__ void attn_unit_f(const Params& p, const int l, const int b, const int head, const int qblk, const bool ctxq, LAS unsigned char* lds, int tid) {
    constexpr int NK = DV == 64 ? 1 : 2, NDT = DV / 32, BUFSZ = NK * 64 * FA_KROW + DV * FA_VROW, NCH = DV == 64 ? 1 : 2;
    const int wid = __builtin_amdgcn_readfirstlane(tid >> 6), lane = tid & 63, lq = lane & 31, lh = lane >> 5;
    const int nt = ctxq ? 4 : 36;
    const bf16_t* P = uni(p.P);
    const size_t rowb = (size_t)b * LTOT;
    int tok0, qcol, kmap;
    if (DV == 64) { tok0 = qblk * 64 + (wid & 1) * 32; qcol = C_QA + (head * 4 + (wid >> 1)) * 64; kmap = 0; }
    else { tok0 = qblk * 128 + (wid & 3) * 32; qcol = C_QC + head * 128 + (wid >> 2) * 64; kmap = wid >> 2; }
    const size_t qrow = rowb + (ctxq ? 0 : CTXL) + tok0 + lq;
    bf16x8 Q[4];
#pragma unroll
    for (int ks = 0; ks < 4; ++ks) Q[ks] = *(const GAS bf16x8*)(P + qrow * PW + qcol + ks * 16 + 8 * lh);
    const bf16_t* ksrc[NCH]; const bf16_t* vsrc[NCH]; int kdst[NCH], vdst[NCH];
#pragma unroll
    for (int i = 0; i < NCH; ++i) {
        const int c = tid + i * NTHR, mm = c >> 9, key = (c >> 3) & 63, piece = c & 7;
        ksrc[i] = P + (rowb + key) * PW + (DV == 64 ? C_KA + head * 64 : C_KC + head * 128 + mm * 64) + piece * 8;
        kdst[i] = mm * 64 * FA_KROW + key * FA_KROW + piece * 16;
        const int d = c >> 3;
        vsrc[i] = (DV == 64 ? uni(p.VTa) + ((size_t)(b * 2 + head) * 64 + d) * LTOT : uni(p.VTc) + ((size_t)(b * 4 + head) * 128 + d) * LTOT) + piece * 8;
        vdst[i] = NK * 64 * FA_KROW + d * FA_VROW + piece * 16;
    }
    pg8::u32x4 kreg[NCH], vreg[NCH];
#define FA_LOAD(t) do { _Pragma("unroll") for (int _i = 0; _i < NCH; ++_i) { kreg[_i] = *(const GAS pg8::u32x4*)(ksrc[_i] + (size_t)(t) * 64 * PW); vreg[_i] = *(const GAS pg8::u32x4*)(vsrc[_i] + (t) * 64); } } while (0)
#define FA_WRITE(bufo) do { _Pragma("unroll") for (int _i = 0; _i < NCH; ++_i) { *(LAS pg8::u32x4*)(lds + (bufo) + kdst[_i]) = kreg[_i]; \
        *(LAS u32x2*)(lds + (bufo) + vdst[_i]) = (u32x2){vreg[_i].x, vreg[_i].y}; *(LAS u32x2*)(lds + (bufo) + vdst[_i] + 8) = (u32x2){vreg[_i].z, vreg[_i].w}; } } while (0)
    f32x16 O[NDT];
#pragma unroll
    for (int dt = 0; dt < NDT; ++dt)
#pragma unroll
        for (int i = 0; i < 16; ++i) O[dt][i] = 0.f;
    float mrow = -1.0e30f, lrow = 0.f;
    __syncthreads();
    FA_LOAD(0); FA_WRITE(0); FA_LOAD(1); FA_WRITE(BUFSZ); FA_LOAD(2);
    const int koff = kmap * 64 * FA_KROW + lq * FA_KROW + 16 * lh;
    const int voff = NK * 64 * FA_KROW + lq * FA_VROW + 8 * lh;
    f32x16 S0, S1;
    constexpr bool HOISTK = (DV == 64);
    bf16x8 kf[8];
#define FA_KREAD(bufo) do { _Pragma("unroll") for (int ks = 0; ks < 4; ++ks) { kf[2 * ks] = *(const LAS bf16x8*)(lds + (bufo) + koff + ks * 32); kf[2 * ks + 1] = *(const LAS bf16x8*)(lds + (bufo) + koff + ks * 32 + 32 * FA_KROW); } } while (0)
#define FA_QK(A0, A1) do { _Pragma("unroll") for (int i = 0; i < 16; ++i) { A0[i] = 0.f; A1[i] = 0.f; } __builtin_amdgcn_s_setprio(1); \
        _Pragma("unroll") for (int ks = 0; ks < 4; ++ks) { \
            A0 = __builtin_amdgcn_mfma_f32_32x32x16_bf16(kf[2 * ks], Q[ks], A0, 0, 0, 0); \
            A1 = __builtin_amdgcn_mfma_f32_32x32x16_bf16(kf[2 * ks + 1], Q[ks], A1, 0, 0, 0); } __builtin_amdgcn_s_setprio(0); } while (0)
    __syncthreads();
    FA_KREAD(0); FA_QK(S0, S1);
    int bcur = 0, bnx1 = BUFSZ, bnx2 = 2 * BUFSZ;
#pragma unroll 1
    for (int t = 0; t < nt; ++t) {
        __syncthreads();
        if (t + 2 < nt) FA_WRITE(bnx2);
        if (t + 3 < nt) FA_LOAD(t + 3);
        if (HOISTK && t + 1 < nt) FA_KREAD(bnx1);
        constexpr int NVF = DV == 64 ? 4 : 0;
        pg8::u32x4 vf[NVF > 0 ? NVF : 1][2];
#pragma unroll
        for (int q4 = 0; q4 < NVF; ++q4)
#pragma unroll
            for (int dt = 0; dt < 2; ++dt) { const int a = bcur + voff + dt * 32 * FA_VROW + q4 * 32;
                const u32x2 lo = *(const LAS u32x2*)(lds + a), hi = *(const LAS u32x2*)(lds + a + 16); vf[q4][dt] = (pg8::u32x4){lo.x, lo.y, hi.x, hi.y}; }
        f32x16 N0, N1;
        if (t + 1 < nt) { if (!HOISTK) FA_KREAD(bnx1); FA_QK(N0, N1); }
        float mx;
        { float m8[8];
#pragma unroll
          for (int i = 0; i < 8; ++i) asm("v_max3_f32 %0, %1, %2, %3" : "=v"(m8[i]) : "v"(S0[2 * i]), "v"(S0[2 * i + 1]), "v"(S1[2 * i]));
#pragma unroll
          for (int i = 0; i < 4; ++i) asm("v_max3_f32 %0, %1, %2, %3" : "=v"(m8[i]) : "v"(m8[i]), "v"(S1[4 * i + 1]), "v"(S1[4 * i + 3]));
          float a, b, c, d;
          asm("v_max3_f32 %0, %1, %2, %3" : "=v"(a) : "v"(m8[0]), "v"(m8[1]), "v"(m8[2]));
          asm("v_max3_f32 %0, %1, %2, %3" : "=v"(b) : "v"(m8[3]), "v"(m8[4]), "v"(m8[5]));
          asm("v_max3_f32 %0, %1, %2, %3" : "=v"(c) : "v"(m8[6]), "v"(m8[7]), "v"(a));
          asm("v_max3_f32 %0, %1, %2, %3" : "=v"(d) : "v"(b), "v"(c), "v"(mrow));
          mx = d; }
        float mnew; { const auto sw = __builtin_amdgcn_permlane32_swap(__float_as_uint(mx), __float_as_uint(mx), false, false); mnew = fmaxf(__uint_as_float(sw[0]), __uint_as_float(sw[1])); }
        if (__builtin_amdgcn_ballot_w64(mnew > mrow) != 0ull) {
            const float alpha = __builtin_amdgcn_exp2f((mrow - mnew) * FA_C);
            lrow *= alpha;
#pragma unroll
            for (int dt = 0; dt < NDT; ++dt)
#pragma unroll
                for (int i = 0; i < 16; ++i) O[dt][i] *= alpha;
            mrow = mnew;
        }
        const float mc = mrow * FA_C;
        f32x2 rs2 = {0.f, 0.f};
#pragma unroll
        for (int i = 0; i < 8; ++i) {
            f32x2 e0 = {S0[2 * i], S0[2 * i + 1]}, e1 = {S1[2 * i], S1[2 * i + 1]};
            e0 = e0 * FA_C - mc; e1 = e1 * FA_C - mc;
            e0.x = __builtin_amdgcn_exp2f(e0.x); e0.y = __builtin_amdgcn_exp2f(e0.y); e1.x = __builtin_amdgcn_exp2f(e1.x); e1.y = __builtin_amdgcn_exp2f(e1.y);
            S0[2 * i] = e0.x; S0[2 * i + 1] = e0.y; S1[2 * i] = e1.x; S1[2 * i + 1] = e1.y;
            rs2 += e0 + e1;
        }
        lrow += rs2.x + rs2.y;
#pragma unroll
        for (int kh = 0; kh < 2; ++kh)
#pragma unroll
            for (int s2 = 0; s2 < 2; ++s2) {
                pg8::u32x4 pw;
                if (kh == 0) { pw.x = pg8::cvt_pk_bf16(S0[8 * s2], S0[8 * s2 + 1]); pw.y = pg8::cvt_pk_bf16(S0[8 * s2 + 2], S0[8 * s2 + 3]); pw.z = pg8::cvt_pk_bf16(S0[8 * s2 + 4], S0[8 * s2 + 5]); pw.w = pg8::cvt_pk_bf16(S0[8 * s2 + 6], S0[8 * s2 + 7]); }
                else { pw.x = pg8::cvt_pk_bf16(S1[8 * s2], S1[8 * s2 + 1]); pw.y = pg8::cvt_pk_bf16(S1[8 * s2 + 2], S1[8 * s2 + 3]); pw.z = pg8::cvt_pk_bf16(S1[8 * s2 + 4], S1[8 * s2 + 5]); pw.w = pg8::cvt_pk_bf16(S1[8 * s2 + 6], S1[8 * s2 + 7]); }
                const bf16x8 pf = __builtin_bit_cast(bf16x8, pw);
#pragma unroll
                for (int dt = 0; dt < NDT; ++dt) {
                    pg8::u32x4 vw;
                    if (dt < 2 && kh * 2 + s2 < NVF) vw = vf[kh * 2 + s2 < NVF ? kh * 2 + s2 : 0][dt];
                    else { const int a = bcur + voff + dt * 32 * FA_VROW + (kh * 32 + 16 * s2) * 2;
                        const u32x2 lo = *(const LAS u32x2*)(lds + a), hi = *(const LAS u32x2*)(lds + a + 16); vw = (pg8::u32x4){lo.x, lo.y, hi.x, hi.y}; }
                    O[dt] = __builtin_amdgcn_mfma_f32_32x32x16_bf16(__builtin_bit_cast(bf16x8, vw), pf, O[dt], 0, 0, 0);
                }
            }
        S0 = N0; S1 = N1;
        { const int tmp = bcur; bcur = bnx1; bnx1 = bnx2; bnx2 = tmp; }
    }
#undef FA_QK
#undef FA_KREAD
    { const auto sw = __builtin_amdgcn_permlane32_swap(__float_as_uint(lrow), __float_as_uint(lrow), false, false); lrow = __uint_as_float(sw[0]) + __uint_as_float(sw[1]); }
    const float inv = 1.f / lrow;
    const size_t orow = rowb + (ctxq ? 0 : CTXL) + tok0 + lq;
    if (DV == 64) {
        unsigned char* o = (unsigned char*)uni(p.oa) + orow * 512 + (head * 4 + (wid >> 1)) * 64 + 4 * lh;
        const float i16 = inv * 16.f;
#pragma unroll
        for (int dt = 0; dt < NDT; ++dt)
#pragma unroll
            for (int g4 = 0; g4 < 4; ++g4) { int q = 0;
                q = __builtin_amdgcn_cvt_pk_fp8_f32(fminf(fmaxf(O[dt][4 * g4] * i16, -448.f), 448.f), fminf(fmaxf(O[dt][4 * g4 + 1] * i16, -448.f), 448.f), q, false);
                q = __builtin_amdgcn_cvt_pk_fp8_f32(fminf(fmaxf(O[dt][4 * g4 + 2] * i16, -448.f), 448.f), fminf(fmaxf(O[dt][4 * g4 + 3] * i16, -448.f), 448.f), q, true);
                *(GAS int*)(o + dt * 32 + 8 * g4) = q; }
    } else {
        __syncthreads();
        LAS float* xch = (LAS float*)lds + (wid & 3) * (64 * 64) + lane;
        if (wid >= 4) {
#pragma unroll
            for (int dt = 0; dt < NDT; ++dt)
#pragma unroll
                for (int i = 0; i < 16; ++i) xch[(dt * 16 + i) * 64] = O[dt][i] * inv;
        }
        __syncthreads();
        if (wid < 4) {
            const float lam = uni(p.lam)[l];
            float ss = 0.f;
#pragma unroll
            for (int dt = 0; dt < NDT; ++dt)
#pragma unroll
                for (int i = 0; i < 16; ++i) { const float v = O[dt][i] * inv - lam * xch[(dt * 16 + i) * 64]; O[dt][i] = v; ss += v * v; }
            { const auto sw = __builtin_amdgcn_permlane32_swap(__float_as_uint(ss), __float_as_uint(ss), false, false); ss = __uint_as_float(sw[0]) + __uint_as_float(sw[1]); }
            const float sc = rsqrtf(ss * (1.f / 128.f) + 1e-6f) * (1.f - lam_init_of(l)) * 16.f;
            const float* gsub = uni(p.subln) + l * 128 + 4 * lh;
            unsigned char* o = (unsigned char*)uni(p.oc) + orow * 512 + head * 128 + 4 * lh;
#pragma unroll
            for (int dt = 0; dt < NDT; ++dt)
#pragma unroll
                for (int g4 = 0; g4 < 4; ++g4) { const pg8::f32x4 g = *(const GAS pg8::f32x4*)(gsub + dt * 32 + 8 * g4);
                    int q = 0;
                    q = __builtin_amdgcn_cvt_pk_fp8_f32(fminf(fmaxf(O[dt][4 * g4] * sc * g.x, -448.f), 448.f), fminf(fmaxf(O[dt][4 * g4 + 1] * sc * g.y, -448.f), 448.f), q, false);
                    q = __builtin_amdgcn_cvt_pk_fp8_f32(fminf(fmaxf(O[dt][4 * g4 + 2] * sc * g.z, -448.f), 448.f), fminf(fmaxf(O[dt][4 * g4 + 3] * sc * g.w, -448.f), 448.f), q, true);
                    *(GAS int*)(o + dt * 32 + 8 * g4) = q; }
        }
    }
#undef FA_LOAD
#undef FA_WRITE
}
}
__device__ __noinline__ void phase_conv_dma(const Params& p, int mode, int l, int t_begin, int ntiles, int t_step, float* ldsf);
__device__ __noinline__ void phase_conv_ring(const Params& p, int l, int chunk, float* ldsf, unsigned* ctr);
__device__ __forceinline__ void phase_attn_f(const Params& p, int l_, bool do_ctx, unsigned char* smem, float* ldsf) {
    const int l = uni(l_);
    LAS unsigned char* lds = LDS_U(ldsf);
    unsigned* ctr = uni(p.actr) + l * 32 + (blockIdx.x & 7);
    volatile LAS unsigned* slot = (volatile LAS unsigned*)smem + 8;
    const int NA = do_ctx ? 144 : 128;
    const int LIM = l == 0 ? CONV_LIM0 : 384;
    bool have_next = false;
    for (;;) {
        int tid = threadIdx.x; asm volatile("" : "+v"(tid));
        __syncthreads();
        if (tid == 0) { const unsigned k = have_next ? *(volatile LAS unsigned*)36 : atomicAdd(ctr, 1u), q = blockIdx.x & 7; unsigned item;
            int a = -1, j = -1;
            const int G2 = NA < LIM / 2 ? NA : LIM / 2;
            if (k < 3u * G2) { const int g = (int)(k / 3u), r = (int)(k - 3u * (unsigned)g); if (r == 0) a = g; else j = 2 * g + (r - 1); }
            else { const int k2 = (int)(k - 3u * G2); if (k2 < NA - G2) a = G2 + k2; else j = 2 * G2 + (k2 - (NA - G2)); }
            if (a >= 0) item = a < 64 ? q * 64 + a : a < 128 ? 512 + q * 64 + (a - 64) : a < 136 ? 1024 + q * 8 + (a - 128) : 1088 + q * 8 + (a - 136);
            else item = j < LIM ? (0x10000u | (q * 384 + (unsigned)j)) : 0xFFFFFFFFu;
            *slot = item; }
        __syncthreads();
        const unsigned us = (unsigned)__builtin_amdgcn_readfirstlane((int)*slot);
        if (us == 0xFFFFFFFFu) break;
        if (us & 0x10000u) { const int ch = (int)(us & 0xFFFFu); phase_conv_ring(p, l, ch, ldsf, ctr); have_next = true; continue; }
        have_next = false;
        const int u = (int)us;
        if (u < 512) fa::attn_unit_f<128>(p, l, u >> 6, (u >> 4) & 3, u & 15, false, lds, tid);
        else if (u < 1024) { const int v = u - 512; fa::attn_unit_f<64>(p, l, v >> 6, (v >> 5) & 1, v & 31, false, lds, tid); }
        else if (u < 1088) { const int v = u - 1024; fa::attn_unit_f<128>(p, l, v >> 3, (v >> 1) & 3, v & 1, true, lds, tid); }
        else { const int v = u - 1088; fa::attn_unit_f<64>(p, l, v >> 3, (v >> 2) & 1, v & 3, true, lds, tid); }
    }
}

__device__ __forceinline__ void conv_fill(const Params& p, int l, int lim, int maxchunks, float* ldsf) {
    unsigned* ctr2 = uni(p.actr) + l * 32 + 8 + (blockIdx.x & 7);
    volatile LAS unsigned* slot = (volatile LAS unsigned*)32;
    for (int c = 0; c < maxchunks; ++c) {
        int tid = threadIdx.x; asm volatile("" : "+v"(tid));
        __syncthreads();
        if (tid == 0) *slot = atomicAdd(ctr2, 1u);
        __syncthreads();
        const int j = lim + __builtin_amdgcn_readfirstlane((int)*slot);
        if (j >= 384) break;
        const int ch = (blockIdx.x & 7) * 384 + j;
        phase_conv_ring(p, l, ch, ldsf, nullptr);
    }
}
__device__ __forceinline__ void xpose64x2(const float* src, size_t ldsrc, bf16_t* drow, size_t K) {
    typedef float f2v __attribute__((ext_vector_type(2)));
    f2v v[64];
#pragma unroll
    for (int j = 0; j < 64; ++j) v[j] = __builtin_nontemporal_load((const f2v*)(src + (size_t)j * ldsrc));
#pragma unroll
    for (int q = 0; q < 8; ++q) { pg8::u32x4 o;
        o.x = pg8::cvt_pk_bf16(v[8 * q + 0].x, v[8 * q + 1].x); o.y = pg8::cvt_pk_bf16(v[8 * q + 2].x, v[8 * q + 3].x); o.z = pg8::cvt_pk_bf16(v[8 * q + 4].x, v[8 * q + 5].x); o.w = pg8::cvt_pk_bf16(v[8 * q + 6].x, v[8 * q + 7].x);
        *(pg8::u32x4*)(drow + q * 8) = o; }
#pragma unroll
    for (int q = 0; q < 8; ++q) { pg8::u32x4 o;
        o.x = pg8::cvt_pk_bf16(v[8 * q + 0].y, v[8 * q + 1].y); o.y = pg8::cvt_pk_bf16(v[8 * q + 2].y, v[8 * q + 3].y); o.z = pg8::cvt_pk_bf16(v[8 * q + 4].y, v[8 * q + 5].y); o.w = pg8::cvt_pk_bf16(v[8 * q + 6].y, v[8 * q + 7].y);
        *(pg8::u32x4*)(drow + K + q * 8) = o; }
}
__device__ __forceinline__ void phase_econv(const Params& p, int l, float* lds) {
    int tid_ = threadIdx.x; asm volatile("" : "+v"(tid_));
    const int wid = tid_ >> 6, lane = tid_ & 63;
    const int gw = blockIdx.x * 8 + wid, ngw = gridDim.x * 8;
    for (int it = gw; it < 256 * 96; it += ngw) {
        const int e = it / 96, r = it - e * 96;
        if (r < 64) { const int m = r >> 5, nb = (r >> 4) & 1, kb = r & 15, n = nb * 128 + lane * 2;
            const float* w = (m ? p.eu : p.eg) + ((size_t)l * 256 + e) * 1024 * 256;
            const int row = nb * 256 + m * 128 + lane * 2;
            xpose64x2(w + (size_t)kb * 64 * 256 + n, 256, p.Wt_e1 + (size_t)e * 512 * 1024 + (size_t)row * 1024 + kb * 64, 1024);
        } else { const int q = r - 64, nb = q >> 2, kb = q & 3, n = nb * 128 + lane * 2;
            xpose64x2(p.ed + ((size_t)l * 256 + e) * 256 * 1024 + (size_t)kb * 64 * 1024 + n, 1024, p.Wt_e2 + (size_t)e * 1024 * 256 + (size_t)n * 256 + kb * 64, 256); }
    }
}
struct ConvTile { const float* src; size_t rs; bf16_t* dst; bool skip; float f8; };
__device__ __forceinline__ ConvTile conv_tile(const Params& p, int mode, int l, int tile, int n) {
    ConvTile c; c.skip = false; c.f8 = 0.f;
    if (mode == 0) {
        const int e = tile / 48, r = tile - e * 48;
        if (r < 32) { const int m = r >> 4, kb = r & 15; c.src = (m ? p.eu : p.eg) + ((size_t)l * 256 + e) * 1024 * 256 + (size_t)kb * 64 * 256; c.rs = 256;
            c.dst = p.Wt_e1 + (size_t)e * 512 * 1024 + (size_t)((n >> 7) * 256 + m * 128 + (n & 127)) * 1024 + kb * 64; }
        else { const int q = r - 32, nb = q >> 2, kb = q & 3; c.src = p.ed + ((size_t)l * 256 + e) * 256 * 1024 + (size_t)kb * 64 * 1024 + nb * 256; c.rs = 1024;
            c.dst = p.Wt_e2 + (size_t)e * 1024 * 256 + (size_t)(nb * 256 + n) * 256 + kb * 64; }
    } else if (mode == 1) {
        const int ll = tile / 592; int r = tile - ll * 592;
        if (r < 368) { const int nb = r >> 4, kb = r & 15, ns = nb * 256 + n;
            c.skip = (nb == 3 || nb == 4);
            c.src = p.w_in + (size_t)ll * 1024 * IN_W + (size_t)kb * 64 * IN_W + nb * 256; c.rs = IN_W;
            c.dst = (bf16_t*)((unsigned char*)p.Wt_in + (size_t)ll * PW * 1024 + (size_t)(ns < 768 ? ns : ns + 512) * 1024 + kb * 64); c.f8 = 256.f; }
        else if (r < 368 + 96) { const int q = r - 368, br = q >> 5, nb = (q >> 3) & 3, kb = q & 7;
            c.src = (br == 0 ? p.wa : br == 1 ? p.wb : p.wc) + (size_t)ll * 512 * 1024 + (size_t)kb * 64 * 1024 + nb * 256; c.rs = 1024;
            c.dst = (bf16_t*)((unsigned char*)p.Wt_br + ((size_t)ll * 3 + br) * 1024 * 512 + (size_t)(nb * 256 + n) * 512 + kb * 64); c.f8 = 256.f; }
        else if (r < 368 + 96 + 64) { const int q = r - 464, nb = q >> 4, kb = q & 15;
            c.src = p.wout + (size_t)ll * 1024 * 1024 + (size_t)kb * 64 * 1024 + nb * 256; c.rs = 1024;
            c.dst = (bf16_t*)((unsigned char*)p.Wt_out + (size_t)ll * 1024 * 1024 + (size_t)(nb * 256 + n) * 1024 + kb * 64); c.f8 = 512.f; }
        else if (r < 368 + 96 + 64 + 48) { const int q = r - 528, m = q >> 4, kb = q & 15;
            c.src = (m == 0 ? p.wr : m == 1 ? p.sg : p.su) + (size_t)ll * 1024 * 256 + (size_t)kb * 64 * 256; c.rs = 256;
            c.dst = p.Wt_g + (size_t)ll * 768 * 1024 + (size_t)(m == 0 ? n : 256 + (n >> 7) * 256 + (m - 1) * 128 + (n & 127)) * 1024 + kb * 64; }
        else { const int q = r - 576, nb = q >> 2, kb = q & 3;
            c.src = p.sd + (size_t)ll * 256 * 1024 + (size_t)kb * 64 * 1024 + nb * 256; c.rs = 1024;
            c.dst = p.Wt_sd + (size_t)ll * 1024 * 256 + (size_t)(nb * 256 + n) * 256 + kb * 64; }
    } else {
        const int ll = tile >> 6, nb = (tile >> 4) & 3, kb = tile & 15;
        c.src = p.WF + (size_t)ll * 1024 * 1024 + (size_t)kb * 64 * 1024 + nb * 256; c.rs = 1024;
        c.dst = (bf16_t*)((unsigned char*)p.Wt_in + (size_t)ll * PW * 1024 + (size_t)(768 + nb * 256 + n) * 1024 + kb * 64); c.f8 = 64.f;
    }
    return c;
}
__device__ __noinline__ void phase_conv_dma(const Params& p, int mode, int l, int t_begin, int ntiles, int t_step, float* ldsf) {
    const int tid = threadIdx.x, wid = tid >> 6, lane = tid & 63;
    LAS unsigned char* lds = (LAS unsigned char*)ldsf;
    const int kc = lane & 7, nl = wid * 32 + (lane >> 3);
    constexpr int SLOT = 65536 + 128;
    __syncthreads();
    int t = t_begin;
    auto issue = [&](int tile, int slot) {
        const ConvTile c = conv_tile(p, mode, l, tile, 0);
#pragma unroll
        for (int j = 0; j < 8; ++j) { const int row = wid * 8 + j;
            __builtin_amdgcn_global_load_lds((const unsigned*)(c.src + (size_t)row * c.rs + lane * 4), (LAS unsigned*)(lds + slot * SLOT + row * 1024 + wid * 16), 16, 0, 2); }
    };
    if (t < ntiles) issue(t, 0);
    for (int i = 0; t < ntiles; t += t_step, ++i) {
        asm volatile("s_waitcnt vmcnt(0)" ::: "memory");
        __syncthreads();
        if (t + t_step < ntiles) issue(t + t_step, (i + 1) & 1);
        if (conv_tile(p, mode, l, t, 0).skip) continue;
        const LAS float* base = (const LAS float*)(lds + (i & 1) * SLOT) + (kc * 8) * 256 + kc * 4;
#pragma unroll
        for (int it = 0; it < 4; ++it) { const int n = nl + it * 8;
            const ConvTile c = conv_tile(p, mode, l, t, n);
            float x[8];
#pragma unroll
            for (int k = 0; k < 8; ++k) x[k] = base[k * 256 + n];
            if (c.f8 != 0.f) {
                typedef unsigned u32x2e __attribute__((ext_vector_type(2)));
#pragma unroll
                for (int k = 0; k < 8; ++k) x[k] = fminf(fmaxf(x[k] * c.f8, -448.f), 448.f);
                int q0 = 0, q1 = 0;
                q0 = __builtin_amdgcn_cvt_pk_fp8_f32(x[0], x[1], q0, false); q0 = __builtin_amdgcn_cvt_pk_fp8_f32(x[2], x[3], q0, true);
                q1 = __builtin_amdgcn_cvt_pk_fp8_f32(x[4], x[5], q1, false); q1 = __builtin_amdgcn_cvt_pk_fp8_f32(x[6], x[7], q1, true);
                *(GAS u32x2e*)((unsigned char*)c.dst + kc * 8) = (u32x2e){(unsigned)q0, (unsigned)q1};
            } else {
            pg8::u32x4 o;
            o.x = pg8::cvt_pk_bf16(x[0], x[1]); o.y = pg8::cvt_pk_bf16(x[2], x[3]); o.z = pg8::cvt_pk_bf16(x[4], x[5]); o.w = pg8::cvt_pk_bf16(x[6], x[7]);
            __builtin_nontemporal_store(o, (GAS pg8::u32x4*)(c.dst + kc * 8)); } }
    }
    asm volatile("s_waitcnt vmcnt(0)" ::: "memory");
    __syncthreads();
}
__device__ __noinline__ void phase_conv_ring(const Params& p, int l, int chunk, float* ldsf, unsigned* ctr) {
    const int tid = threadIdx.x, wid = tid >> 6, lane = tid & 63;
    LAS unsigned char* lds = (LAS unsigned char*)ldsf;
    const float* const eg_ = uni(p.eg); const float* const eu_ = uni(p.eu); const float* const ed_ = uni(p.ed);
    unsigned char* const w1_ = (unsigned char*)uni(p.Wt_e1); unsigned char* const w2_ = (unsigned char*)uni(p.Wt_e2);
    const int kc = lane & 7, n = wid * 8 + (lane >> 3);
    constexpr int SLOT = 32768 + 128;
    const int t0 = chunk * 8;
    auto issue = [&](int jt) {
        const int tile = t0 + jt, e = tile / 96, r = tile - e * 96;
        const float* src; int rs;
        if (r < 64) { const int m = r >> 5, kb = (r >> 2) & 7, nq = r & 3; src = (m ? eu_ : eg_) + ((size_t)l * 256 + e) * 1024 * 256 + (size_t)kb * 128 * 256 + nq * 64; rs = 256; }
        else { const int q = r - 64, nb = q >> 1, kb = q & 1; src = ed_ + ((size_t)l * 256 + e) * 256 * 1024 + (size_t)kb * 128 * 1024 + nb * 64; rs = 1024; }
#pragma unroll
        for (int q = 0; q < 4; ++q) { const int row = wid * 16 + q * 4 + (lane >> 4);
            __builtin_amdgcn_global_load_lds((const unsigned*)(src + (size_t)row * rs + (lane & 15) * 4), (LAS unsigned*)(lds + (jt & 3) * SLOT + (wid * 16 + q * 4) * 256 + wid * 16), 16, 0, 2); } };
    __syncthreads();
    unsigned kn; asm volatile("v_mov_b32 %0, 0" : "=v"(kn));
    issue(0); issue(1); issue(2);
#pragma unroll
    for (int jt = 0; jt < 8; ++jt) {
        if (jt < 6) asm volatile("s_waitcnt vmcnt(8)" ::: "memory");
        else if (jt == 6) asm volatile("s_waitcnt vmcnt(4)" ::: "memory");
        else asm volatile("s_waitcnt vmcnt(0)" ::: "memory");
        asm volatile("s_waitcnt lgkmcnt(0)" ::: "memory"); __builtin_amdgcn_s_barrier(); asm volatile("" ::: "memory");
        if (jt + 3 < 8) issue(jt + 3);
        if (jt == 5 && ctr != nullptr && tid == 0) kn = __hip_atomic_fetch_add((GAS unsigned*)ctr, 1u, __ATOMIC_RELAXED, __HIP_MEMORY_SCOPE_AGENT);
        const int tile = t0 + jt, e = tile / 96, r = tile - e * 96;
        const LAS float* base = (const LAS float*)(lds + (jt & 3) * SLOT) + (kc * 16) * 64 + kc * 4 + n;
        float x[16];
#pragma unroll
        for (int k = 0; k < 16; ++k) x[k] = fminf(fmaxf(base[k * 64] * 256.f, -448.f), 448.f);
        unsigned char* dst;
        if (r < 64) { const int m = r >> 5, kb = (r >> 2) & 7, nq = r & 3, nn = nq * 64 + n; dst = w1_ + (size_t)e * 512 * 1024 + (size_t)((nn >> 7) * 256 + m * 128 + (nn & 127)) * 1024 + kb * 128; }
        else { const int q = r - 64, nb = q >> 1, kb = q & 1; dst = w2_ + (size_t)e * 1024 * 256 + (size_t)(nb * 64 + n) * 256 + kb * 128; }
        pg8::i32x4 o;
#pragma unroll
        for (int q = 0; q < 4; ++q) { int w8 = 0; w8 = __builtin_amdgcn_cvt_pk_fp8_f32(x[4 * q], x[4 * q + 1], w8, false); w8 = __builtin_amdgcn_cvt_pk_fp8_f32(x[4 * q + 2], x[4 * q + 3], w8, true); o[q] = w8; }
        __builtin_nontemporal_store(o, (GAS pg8::i32x4*)(dst + kc * 16));
    }
    if (ctr != nullptr && tid == 0) *(volatile LAS unsigned*)36 = kn;
    asm volatile("s_waitcnt lgkmcnt(0)" ::: "memory"); __builtin_amdgcn_s_barrier(); asm volatile("" ::: "memory");
}
__device__ __forceinline__ int build_units256(const Params& p, int* ustart  ) {
    int tid_ = threadIdx.x; asm volatile("" : "+v"(tid_));
    __syncthreads();
    if (tid_ <= 256) ustart[320 + tid_] = p.eoff[tid_];
    __syncthreads();
    if (tid_ == 0) { int s = 0; for (int e = 0; e < 256; ++e) { ustart[e] = s; s += (ustart[320 + e + 1] - ustart[320 + e] + 255) >> 8; } ustart[256] = s; }
    __syncthreads();
    return ustart[256];
}
__device__ __forceinline__ void phase_exp_up_f(const Params& p, int* ustart, float* lds) {
    const int nub = uni(build_units256(p, ustart));
    pg8::ExpOrder S; S.ustart = (const PG8_LAS int*)ustart; S.eoff = uni(p.eoff); S.slot_tok = uni(p.slot_tok); S.nct = 2; S.nun = nub * 2; S.G = gridDim.x; S.c = blockIdx.x; S.gather = true;
    S.A = (const char*)uni(p.u8); S.B = (const char*)uni(p.Wt_e1); S.b_exp = (size_t)512 * 1024; S.b_tile = (size_t)256 * 1024; S.lda_bytes = 1024u;
    pg8::EpiHs E; E.Hs = (unsigned char*)uni(p.Hs); E.slot_w = uni(p.slot_w);
    pg8::gemm_phase<true, true>(LDS_U(lds), 512, 512, 512, S, E);
}
__device__ __forceinline__ void phase_exp_down_f(const Params& p, int* ustart, float* lds) {
    const int nub = uni(build_units256(p, ustart));
    pg8::ExpOrder S; S.ustart = (const PG8_LAS int*)ustart; S.eoff = uni(p.eoff); S.slot_tok = uni(p.slot_tok); S.nct = 4; S.nun = nub * 4; S.G = gridDim.x; S.c = blockIdx.x; S.gather = false;
    S.A = (const char*)uni(p.Hs); S.B = (const char*)uni(p.Wt_e2); S.b_exp = (size_t)1024 * 256; S.b_tile = (size_t)256 * 256; S.lda_bytes = 256u;
    pg8::EpiYs E; E.Ys = (unsigned char*)uni(p.Ys);
    pg8::gemm_phase<false, true>(LDS_U(lds), 128, 128, 128, S, E);
}

__global__ void __launch_bounds__(NTHR, 2) fwd(Params pk) {
    extern __shared__ __attribute__((aligned(16))) unsigned char smem[];
    if (threadIdx.x == 0) *(uint4*)smem = make_uint4(0u, 0u, 0u, 0u);
    Params* ps = (Params*)(smem + 64);
    if (threadIdx.x < sizeof(Params) / 8) ((unsigned long long*)ps)[threadIdx.x] = ((const unsigned long long*)&pk)[threadIdx.x];
    __syncthreads();
    const Params& p = *ps;
    (void)xcd_barrier_post(pk.bar, (volatile LAS unsigned*)smem);
#define GRID_BARRIER() do { XcdBarrier _b; _b.bar = uni(ps->bar); _b.x = xb_xcc_id(); _b.st = (volatile LAS unsigned*)smem; xcd_barrier(_b); } while (0)
    int* ustart = (int*)(smem + 1024);
    float* lds = (float*)(smem + 4096);
    phase_pro(p, lds);
    phase_wprep(p, 0, lds);
    phase_conv_dma(p, 1, 0, blockIdx.x, 2 * 592, gridDim.x, lds);
    GRID_BARRIER();
    phase_conv_dma(p, 2, 0, blockIdx.x, 128, gridDim.x, lds);
    phase_lnmod0(p);
    GRID_BARRIER();
#pragma unroll 1
    for (int l = 0; l < 2; ++l) {
        phase_inproj_f(p, l, lds, false);
        GRID_BARRIER();
        phase_normrope(p, l);
        phase_xt(p, l == 0, lds);
        GRID_BARRIER();
        phase_inproj_f(p, l, lds, true);
        phase_fourier_f(p, l == 0, lds);
        phase_attn_f(p, l, l == 0, smem, lds);
        GRID_BARRIER();
        phase_ygemm_f(p, l, lds);
        if (l == 0 && blockIdx.x >= 32) conv_fill(p, 0, CONV_LIM0, 3, lds);
        GRID_BARRIER();
        phase_outproj_f(p, l, lds);
        if (l == 0 && blockIdx.x >= 32) conv_fill(p, 0, CONV_LIM0, 2, lds);
        GRID_BARRIER();
        phase_ln1(p, l);
        GRID_BARRIER();
        phase_router_shared_f(p, l, lds);
        GRID_BARRIER();
        phase_route(p, l, lds);
        phase_shdown_f(p, l, lds);
        GRID_BARRIER();
        phase_slots(p, l == 1, lds);
        conv_fill(p, l, l == 0 ? CONV_LIM0 : 384, 1 << 20, lds);
        GRID_BARRIER();
        phase_exp_up_f(p, ustart, lds);
        GRID_BARRIER();
        phase_exp_down_f(p, ustart, lds);
        GRID_BARRIER();
        phase_ln2(p, l);
        GRID_BARRIER();
    }
}

static inline size_t bump(size_t& off, size_t bytes) { const size_t o = off; off = (off + bytes + 255) & ~(size_t)255; return o; }

extern "C" void kernel_launch(void* const* d_in, const int* in_sizes, int n_in, void* d_out, int out_size, void* d_ws, size_t ws_size, hipStream_t stream) {
    static int grid = 0;
    if (grid == 0) {
        int dev = 0, cus = 0, per_cu = 0;
        hipGetDevice(&dev);
        hipDeviceGetAttribute(&cus, hipDeviceAttributeMultiprocessorCount, dev);
        hipFuncSetAttribute((const void*)fwd, hipFuncAttributeMaxDynamicSharedMemorySize, LDS_BYTES);
        hipOccupancyMaxActiveBlocksPerMultiprocessor(&per_cu, (const void*)fwd, NTHR, LDS_BYTES);
        (void)hipGetLastError();
        grid = 256;
        if (cus < 256 || per_cu < 1) fprintf(stderr, "kernel_launch: needs 256 CUs with one resident workgroup each (cus %d, per_cu %d)\n", cus, per_cu);
    }
    Params p{};
    const float* const* in = (const float* const*)d_in;
    p.x = in[0]; p.c = in[1]; p.ctx = in[2]; p.c_ctx = in[3]; p.w_mod = in[4]; p.b_mod = in[5]; p.w_in = in[6]; p.qn = in[7]; p.kn = in[8];
    p.lq1 = in[9]; p.lk1 = in[10]; p.lq2 = in[11]; p.lk2 = in[12]; p.subln = in[13]; p.wa = in[14]; p.wb = in[15]; p.wc = in[16]; p.wout = in[17];
    p.ln1g = in[18]; p.ln1b = in[19]; p.wr = in[20]; p.br = in[21]; p.sg = in[22]; p.su = in[23]; p.sd = in[24]; p.eg = in[25]; p.eu = in[26]; p.ed = in[27];
    p.ln2g = in[28]; p.ln2b = in[29];
    p.out = (float*)d_out;
    char* ws = (char*)d_ws; size_t off = 0;
    p.bar = (unsigned*)(ws + bump(off, XCD_BAR_WORDS * 4));
    p.mod = (float*)(ws + bump(off, (size_t)2 * 9 * 6144 * 4));
    p.WF = (float*)(ws + bump(off, (size_t)2 * 1024 * 1024 * 4));
    p.ropec = (float*)(ws + bump(off, 2048 * 32 * 4)); p.ropes = (float*)(ws + bump(off, 2048 * 32 * 4));
    p.tc = (float*)(ws + bump(off, 2048 * 4)); p.ts = (float*)(ws + bump(off, 2048 * 4));
    p.lam = (float*)(ws + bump(off, 256));
    p.hbuf = (float*)(ws + bump(off, (size_t)T_ALL * DM * 4));
    p.z = (float*)(ws + bump(off, (size_t)T_ALL * DM * 4));
    p.logits = (float*)(ws + bump(off, (size_t)T_ALL * 256 * 4));
    p.f = (float*)(ws + bump(off, (size_t)T_ALL * DM * 4));
    p.slot_w = (float*)(ws + bump(off, (size_t)NSLOT * 4));
    p.rw = (float*)(ws + bump(off, (size_t)T_ALL * 8 * 4));
    p.ridx = (int*)(ws + bump(off, (size_t)T_ALL * 8 * 4));
    p.lrank = (int*)(ws + bump(off, (size_t)256 * 576 * 4));
    p.cntWG = (int*)(ws + bump(off, (size_t)256 * 256 * 4));
    p.slot_tok = (int*)(ws + bump(off, (size_t)NSLOT * 4));
    p.tok_slot = (int*)(ws + bump(off, (size_t)T_ALL * 8 * 4));
    p.eoff = (int*)(ws + bump(off, 257 * 4));
    p.u = (act_t*)(ws + bump(off, (size_t)T_ALL * DM * sizeof(act_t)));
    p.u8 = (unsigned char*)(ws + bump(off, (size_t)T_ALL * DM));
    p.PF = (unsigned char*)(ws + bump(off, (size_t)T_ALL * 1024));
    p.oa = (act_t*)(ws + bump(off, (size_t)T_ALL * 512 * sizeof(act_t)));
    p.ob = (act_t*)(ws + bump(off, (size_t)T_ALL * 512 * sizeof(act_t)));
    p.oc = (act_t*)(ws + bump(off, (size_t)T_ALL * 512 * sizeof(act_t)));
    p.y = (act_t*)(ws + bump(off, (size_t)T_ALL * DM * sizeof(act_t)));
    p.shact = (act_t*)(ws + bump(off, (size_t)T_ALL * 256 * sizeof(act_t)));
    p.Hs = (act_t*)(ws + bump(off, (size_t)(NSLOT + 256) * 256 * sizeof(act_t)));
    p.Wt_e1 = (bf16_t*)(ws + bump(off, (size_t)256 * 512 * 1024 * 2));
    p.Wt_e2 = (bf16_t*)(ws + bump(off, (size_t)256 * 1024 * 256 * 2));
    p.Wt_in = (bf16_t*)(ws + bump(off, (size_t)2 * PW * 1024 * 2));
    p.Wt_br = (bf16_t*)(ws + bump(off, (size_t)2 * 3 * 1024 * 512 * 2));
    p.Wt_out = (bf16_t*)(ws + bump(off, (size_t)2 * 1024 * 1024 * 2));
    p.Wt_g = (bf16_t*)(ws + bump(off, (size_t)2 * 768 * 1024 * 2));
    p.Wt_sd = (bf16_t*)(ws + bump(off, (size_t)2 * 1024 * 256 * 2));
    p.ytmp = (float*)(ws + bump(off, (size_t)T_ALL * DM * 4));
    p.Gq = (unsigned char*)(ws + bump(off, (size_t)T_ALL * 3072));
    p.VTa = (bf16_t*)(ws + bump(off, (size_t)8 * 128 * LTOT * 2)); p.VTc = (bf16_t*)(ws + bump(off, (size_t)8 * 512 * LTOT * 2));
    p.actr = (unsigned*)(ws + bump(off, 256));
    p.De = (bf16_t*)(ws + bump(off, (size_t)1024 * 2048 * 2)); p.Do = (bf16_t*)(ws + bump(off, (size_t)1024 * 2048 * 2)); p.Dc = (bf16_t*)(ws + bump(off, (size_t)256 * 512 * 2));
    p.XTe = (bf16_t*)(ws + bump(off, (size_t)4096 * 2048 * 2)); p.XTo = (bf16_t*)(ws + bump(off, (size_t)4096 * 2048 * 2)); p.XTc = (bf16_t*)(ws + bump(off, (size_t)4096 * 512 * 2));
    const size_t psz = (size_t)T_ALL * PW * sizeof(act_t), ysz = (size_t)NSLOT * DM * sizeof(act_t);
    const size_t shared = bump(off, psz > ysz ? psz : ysz);
    p.P = (act_t*)(ws + shared); p.Ys = (act_t*)(ws + shared);
    if (off > ws_size) { fprintf(stderr, "kernel_launch: workspace too small: need %zu, have %zu\n", off, ws_size); return; }
    hipMemsetAsync(p.bar, 0, XCD_BAR_WORDS * 4, stream);
    hipLaunchKernelGGL(fwd, dim3(grid), dim3(NTHR), LDS_BYTES, stream, p);
}
```

```cpp
#include <hip/hip_runtime.h>
#include <stdint.h>
#include <stdio.h>

#define DM 1024
#define NBATCH 8
#define SEQ 2048
#define CTXL 256
#define LTOT 2304
#define T_ALL 18432
#define IN_W 5888
#define PW 6400
#define C_QA 0
#define C_KA 512
#define C_VA 640
#define C_FA 768
#define C_QC 1792
#define C_KC 2304
#define C_VC 2816
#define C_G 3328
#define NEXP 256
#define NSLOT (T_ALL * 8)
#define NTHR 512
#define LDS_BYTES 163840
#define ALPHA 1.41421356237f

typedef unsigned short bf16_t;
#define ACT_BF16 1
#ifdef ACT_BF16
typedef bf16_t act_t;
#else
typedef float act_t;
#endif

__device__ __forceinline__ float bf2f(bf16_t v) { return __uint_as_float(((unsigned)v) << 16); }
__device__ __forceinline__ bf16_t f2bf(float f) { unsigned u = __float_as_uint(f); u += 0x7FFFu + ((u >> 16) & 1u); return (bf16_t)(u >> 16); }
__device__ __forceinline__ float ldv(const float* p, size_t i) { return p[i]; }
__device__ __forceinline__ float ldv(const bf16_t* p, size_t i) { return bf2f(p[i]); }
__device__ __forceinline__ void stv(float* p, size_t i, float v) { p[i] = v; }
__device__ __forceinline__ void stv(bf16_t* p, size_t i, float v) { p[i] = f2bf(v); }
__device__ __forceinline__ float4 ld4(const float* p, size_t i) { return *(const float4*)(p + i); }
__device__ __forceinline__ float4 ld4(const bf16_t* p, size_t i) { uint2 r = *(const uint2*)(p + i); float4 o; o.x = __uint_as_float(r.x << 16); o.y = __uint_as_float(r.x & 0xFFFF0000u); o.z = __uint_as_float(r.y << 16); o.w = __uint_as_float(r.y & 0xFFFF0000u); return o; }
__device__ __forceinline__ void st4(float* p, size_t i, float4 v) { *(float4*)(p + i) = v; }
__device__ __forceinline__ void st4(bf16_t* p, size_t i, float4 v) { uint2 r; r.x = (unsigned)f2bf(v.x) | ((unsigned)f2bf(v.y) << 16); r.y = (unsigned)f2bf(v.z) | ((unsigned)f2bf(v.w) << 16); *(uint2*)(p + i) = r; }

#define XB_TMO      128
#define XB_XCNT(j)  (256  + 64 * (j))
#define XB_XSUB(j)  (1280 + 64 * (j))
#define XB_XGEN(j)  (2304 + 64 * (j))
#define XB_TOP      3328
#define XB_TOPGEN   3392
#define XCD_BAR_WORDS 3456
#define XB_SPIN_CAP (1u << 27)
#define LAS __attribute__((address_space(3)))

__device__ __forceinline__ unsigned xb_ld(unsigned* p)              { return __hip_atomic_load(p, __ATOMIC_RELAXED, __HIP_MEMORY_SCOPE_AGENT); }
__device__ __forceinline__ unsigned xb_add(unsigned* p, unsigned v) { return __hip_atomic_fetch_add(p, v, __ATOMIC_RELAXED, __HIP_MEMORY_SCOPE_AGENT); }
__device__ __forceinline__ unsigned xb_xcc_id() { return (unsigned)__builtin_amdgcn_s_getreg((3 << 11) | 20) & 0xFu; }
#define XB_SPIN(cond, bar) do { unsigned _sp = 0; while (cond) { __builtin_amdgcn_s_sleep(1); \
    if ((++_sp & 255u) == 0u) { if (xb_ld(&(bar)[XB_TMO])) break; if (_sp > XB_SPIN_CAP) { atomicAdd(&(bar)[XB_TMO], 1u); break; } } } } while (0)

struct XcdBarrier { unsigned* bar; unsigned x; volatile LAS unsigned* st; };

__device__ __forceinline__ XcdBarrier xcd_barrier_post(unsigned* bar, volatile LAS unsigned* st) {
    XcdBarrier b; b.bar = bar; b.x = xb_xcc_id(); b.st = st;
    if (threadIdx.x == 0) (void)xb_add(&bar[XB_XCNT(b.x)], 1u);
    return b;
}
__device__ __forceinline__ void xcd_barrier_complete(unsigned* bar, unsigned x, unsigned& nloc, unsigned& nx) {
    const unsigned G = gridDim.x * gridDim.y * gridDim.z;
    unsigned sum, cnt, mine, sp = 0u;
    for (;;) {
        sum = 0u; cnt = 0u; mine = 0u;
#pragma unroll
        for (unsigned j = 0; j < 16; ++j) { const unsigned c = xb_ld(&bar[XB_XCNT(j)]); sum += c; cnt += (c > 0u) ? 1u : 0u; mine = (j == x) ? c : mine; }
        if (sum == G) break;
        __builtin_amdgcn_s_sleep(1);
        if ((++sp & 255u) == 0u) { if (xb_ld(&bar[XB_TMO])) break; if (sp > XB_SPIN_CAP) { atomicAdd(&bar[XB_TMO], 1u); break; } }
    }
    nloc = mine > 0u ? mine : 1u; nx = cnt > 0u ? cnt : 1u;
}
__device__ __forceinline__ void xcd_barrier(const XcdBarrier& b) {
    asm volatile("s_waitcnt vmcnt(0)" ::: "memory");
    __syncthreads();
    if (threadIdx.x == 0) {
        unsigned* bar = b.bar;
        __builtin_amdgcn_s_waitcnt(0);
        unsigned nloc = b.st[0], nx = b.st[1];
        if (nloc == 0u) { xcd_barrier_complete(bar, b.x, nloc, nx); b.st[0] = nloc; b.st[1] = nx; }
        const unsigned old = xb_add(&bar[XB_XSUB(b.x)], 1u);
        const unsigned gen = old / nloc;
        if (old + 1u == (gen + 1u) * nloc) {
            __builtin_amdgcn_fence(__ATOMIC_RELEASE, "agent");
            asm volatile("s_waitcnt vmcnt(0)" ::: "memory");
            const unsigned og = xb_add(&bar[XB_TOP], 1u);
            const unsigned tg = og / nx;
            if (og + 1u == (tg + 1u) * nx) xb_add(&bar[XB_TOPGEN], 1u);
            else XB_SPIN(xb_ld(&bar[XB_TOPGEN]) == tg, bar);
            __builtin_amdgcn_fence(__ATOMIC_ACQUIRE, "agent");
            xb_add(&bar[XB_XGEN(b.x)], 1u);
            asm volatile("s_waitcnt vmcnt(0)" ::: "memory");
        } else {
            XB_SPIN(xb_ld(&bar[XB_XGEN(b.x)]) == gen, bar);
            __builtin_amdgcn_fence(__ATOMIC_ACQUIRE, "agent");
            asm volatile("s_waitcnt vmcnt(0)" ::: "memory");
        }
    }
    __syncthreads();
}

#define CONV_LIM0 244
struct Params {
    const float *x, *c, *ctx, *c_ctx, *w_mod, *b_mod, *w_in, *qn, *kn, *lq1, *lk1, *lq2, *lk2, *subln,
                *wa, *wb, *wc, *wout, *ln1g, *ln1b, *wr, *br, *sg, *su, *sd, *eg, *eu, *ed, *ln2g, *ln2b;
    float* out;
    unsigned* bar;
    float *mod, *WF, *ropec, *ropes, *tc, *ts, *lam, *hbuf, *z, *logits, *f, *slot_w, *rw;
    act_t *u, *P, *oa, *ob, *oc, *y, *shact, *Hs, *Ys;
    int *ridx, *lrank, *cntWG, *slot_tok, *tok_slot, *eoff;
    bf16_t *Wt_in, *Wt_br, *Wt_out, *Wt_g, *Wt_sd;
    float* ytmp;
    bf16_t *Wt_e1, *Wt_e2;
    unsigned char* PF;
    unsigned char* u8;
    unsigned char* Gq;
    bf16_t *VTa, *VTc;
    unsigned* actr;
    bf16_t *De, *Do, *Dc, *XTe, *XTo, *XTc;
};

__device__ __forceinline__ float wave_sum(float v) {
#pragma unroll
    for (int o = 32; o > 0; o >>= 1) v += __shfl_xor(v, o);
    return v;
}
__device__ __forceinline__ float wave_max(float v) {
#pragma unroll
    for (int o = 32; o > 0; o >>= 1) v = fmaxf(v, __shfl_xor(v, o));
    return v;
}
__device__ __forceinline__ float sigmoidf_(float v) { return 1.f / (1.f + expf(-v)); }
__device__ __forceinline__ float siluf_(float v) { return v / (1.f + expf(-v)); }
__device__ __forceinline__ float lam_init_of(int l) { return l == 0 ? 0.2f : 0.35550906759f; }

__device__ __forceinline__ const float* in_row(const Params& p, int r) {
    const int b = r / LTOT, j = r - b * LTOT;
    return j < CTXL ? p.ctx + ((size_t)b * CTXL + j) * DM : p.x + ((size_t)b * SEQ + (j - CTXL)) * DM;
}
__device__ __forceinline__ int mod_idx(int r) { const int b = r / LTOT, j = r - b * LTOT; return j < CTXL ? 8 : b; }
__device__ __forceinline__ const float* modv(const Params& p, int l, int mi, int i) { return p.mod + ((size_t)(l * 9 + mi) * 6 + i) * DM; }

__device__ __forceinline__ void ln_stats(const float (&v)[16], float& mu, float& rstd) {
    float s = 0.f;
#pragma unroll
    for (int i = 0; i < 16; ++i) s += v[i];
    mu = wave_sum(s) * (1.f / DM);
    float q = 0.f;
#pragma unroll
    for (int i = 0; i < 16; ++i) { const float d = v[i] - mu; q += d * d; }
    rstd = rsqrtf(wave_sum(q) * (1.f / DM) + 1e-5f);
}
__device__ __forceinline__ void load_row16(const float* src, int lane, float (&v)[16]) {
#pragma unroll
    for (int i = 0; i < 4; ++i) { const float4 t = *(const float4*)(src + i * 256 + lane * 4); v[i * 4 + 0] = t.x; v[i * 4 + 1] = t.y; v[i * 4 + 2] = t.z; v[i * 4 + 3] = t.w; }
}

template <class FA, class FB>
__device__ __forceinline__ void sgemm_tile(float (&acc)[4][4], int K, FA fa, FB fb, float* lds) {
    float* As = lds;
    float* Bs = lds + 16 * 64;
    const int tid = threadIdx.x, ty = tid >> 5, tx = tid & 31;
#pragma unroll
    for (int i = 0; i < 4; ++i)
#pragma unroll
        for (int j = 0; j < 4; ++j) acc[i][j] = 0.f;
#pragma unroll 1
    for (int k0 = 0; k0 < K; k0 += 16) {
        __syncthreads();
#pragma unroll
        for (int i = 0; i < 2; ++i) { const int e = tid + i * NTHR; const int r = e >> 4, kk = e & 15; As[kk * 64 + r] = fa(r, k0 + kk); }
#pragma unroll
        for (int i = 0; i < 4; ++i) { const int e = tid + i * NTHR; const int kk = e >> 7, c = e & 127; Bs[kk * 128 + c] = fb(k0 + kk, c); }
        __syncthreads();
#pragma unroll 4
        for (int kk = 0; kk < 16; ++kk) {
            const float4 a = *(const float4*)&As[kk * 64 + ty * 4];
            const float4 b = *(const float4*)&Bs[kk * 128 + tx * 4];
            const float av[4] = {a.x, a.y, a.z, a.w}, bv[4] = {b.x, b.y, b.z, b.w};
#pragma unroll
            for (int i = 0; i < 4; ++i)
#pragma unroll
                for (int j = 0; j < 4; ++j) acc[i][j] += av[i] * bv[j];
        }
    }
}

__device__ __noinline__ void phase_pro(const Params& p, float* lds) {
    const int tid = threadIdx.x, bid = blockIdx.x, nb = gridDim.x;
    const int gtid = bid * NTHR + tid, gn = nb * NTHR;
    for (int i = tid; i < 9 * 1024; i += NTHR) { const int r = i >> 10, k = i & 1023; const float v = r < 8 ? p.c[r * 1024 + k] : p.c_ctx[k]; lds[i] = siluf_(v); }
    __syncthreads();
    float* red = lds + 9 * 1024;
    for (int g = bid; g < 192; g += nb) {
        const int l = g / 96, col0 = (g % 96) * 64, c4 = tid & 15, kc = tid >> 4;
        float acc[9][4];
#pragma unroll
        for (int i = 0; i < 9; ++i) { acc[i][0] = 0.f; acc[i][1] = 0.f; acc[i][2] = 0.f; acc[i][3] = 0.f; }
        const float* w = p.w_mod + (size_t)l * 1024 * 6144 + col0 + c4 * 4;
#pragma unroll 8
        for (int k = kc * 32; k < kc * 32 + 32; ++k) {
            const float4 wv = *(const float4*)(w + (size_t)k * 6144);
#pragma unroll
            for (int i = 0; i < 9; ++i) { const float s = lds[i * 1024 + k]; acc[i][0] += s * wv.x; acc[i][1] += s * wv.y; acc[i][2] += s * wv.z; acc[i][3] += s * wv.w; }
        }
#pragma unroll
        for (int i = 0; i < 9; ++i) *(float4*)&red[(kc * 9 + i) * 64 + c4 * 4] = make_float4(acc[i][0], acc[i][1], acc[i][2], acc[i][3]);
        __syncthreads();
        for (int o = tid; o < 9 * 64; o += NTHR) { const int i = o >> 6, c = o & 63;
            float s = p.b_mod[l * 6144 + col0 + c];
#pragma unroll 8
            for (int k2 = 0; k2 < 32; ++k2) s += red[(k2 * 9 + i) * 64 + c];
            p.mod[(size_t)(l * 9 + i) * 6144 + col0 + c] = s; }
        __syncthreads();
    }
    for (int i = gtid; i < 2048 * 32; i += gn) {
        const int s = i >> 5, j = i & 31, axis = j >> 4, fi = j & 15;
        const double pos = axis ? (double)(s & 63) : (double)(s >> 6);
        const double inv = pow(10000.0, -(double)fi / 16.0);
        const double ang = (double)(float)((float)pos * (float)inv);
        p.ropec[i] = (float)cos(ang); p.ropes[i] = (float)sin(ang);
    }
    for (int i = gtid; i < 2048; i += gn) { p.tc[i] = (float)cospi((double)i / 1024.0); p.ts[i] = (float)sinpi((double)i / 1024.0); }
    if (bid == 0 && tid < 128) {
        const int l = tid >> 6, lane = tid & 63;
        const float d1 = wave_sum(p.lq1[l * 64 + lane] * p.lk1[l * 64 + lane]);
        const float d2 = wave_sum(p.lq2[l * 64 + lane] * p.lk2[l * 64 + lane]);
        if (lane == 0) { p.lam[l] = expf(d1) - expf(d2) + lam_init_of(l); }
        if (lane < 16) p.actr[l * 32 + lane] = 0u;
    }
    __syncthreads();
    float* t128 = lds;
    if (tid < 128) { t128[tid] = (float)cospi((double)tid / 64.0); t128[128 + tid] = (float)sinpi((double)tid / 64.0); }
    __syncthreads();
    typedef const __attribute__((address_space(4))) float* cfp;
    const int lane = tid & 63;
    for (int it_ = bid * 8 + (tid >> 6); it_ < 2 * 1024 * 4; it_ += nb * 8) {
        const int it = __builtin_amdgcn_readfirstlane(it_), l = it >> 12, k = (it >> 2) & 1023, g = it & 3;
        const unsigned long long wa = (unsigned long long)(p.w_in + ((size_t)l * 1024 + k) * IN_W + 768 + g * 128);
        cfp w = (cfp)(((unsigned long long)(unsigned)__builtin_amdgcn_readfirstlane((int)(wa >> 32)) << 32) | (unsigned)__builtin_amdgcn_readfirstlane((int)wa));
        float c0 = 0.f, s0 = 0.f, c1 = 0.f, s1 = 0.f;
#pragma unroll 8
        for (int c = 0; c < 128; ++c) {
            const float wv = w[c];
            const int i0 = (c * lane) & 127, i1 = i0 ^ ((c & 1) << 6);
            c0 += wv * t128[i0]; s0 += wv * t128[128 + i0]; c1 += wv * t128[i1]; s1 += wv * t128[128 + i1];
        }
        float* o = p.WF + ((size_t)l * 1024 + k) * 1024 + g * 128;
        o[lane] = c0; o[lane + 64] = c1; o[512 + lane] = s0; o[512 + lane + 64] = s1;
    }
}

__device__ __forceinline__ void st_fp8x4(unsigned char* p8, size_t i, float4 o) {
    int q8 = 0;
    q8 = __builtin_amdgcn_cvt_pk_fp8_f32(fminf(fmaxf(o.x * 16.f, -448.f), 448.f), fminf(fmaxf(o.y * 16.f, -448.f), 448.f), q8, false);
    q8 = __builtin_amdgcn_cvt_pk_fp8_f32(fminf(fmaxf(o.z * 16.f, -448.f), 448.f), fminf(fmaxf(o.w * 16.f, -448.f), 448.f), q8, true);
    *(int*)(p8 + i) = q8;
}
__device__ __noinline__ void phase_lnmod0(const Params& p) {
    const int wid = threadIdx.x >> 6, lane = threadIdx.x & 63;
    const int stride = gridDim.x * 8;
    auto proc = [&](int r, float (&v)[16]) {
        float mu, rstd; ln_stats(v, mu, rstd);
        const int mi = mod_idx(r);
        const float* sh = modv(p, 0, mi, 0); const float* sc = modv(p, 0, mi, 1);
#pragma unroll
        for (int i = 0; i < 4; ++i) {
            const int c = i * 256 + lane * 4;
            const float4 s4 = *(const float4*)(sh + c), c4 = *(const float4*)(sc + c);
            float4 o; o.x = (v[i * 4 + 0] - mu) * rstd * (1.f + c4.x) + s4.x; o.y = (v[i * 4 + 1] - mu) * rstd * (1.f + c4.y) + s4.y;
            o.z = (v[i * 4 + 2] - mu) * rstd * (1.f + c4.z) + s4.z; o.w = (v[i * 4 + 3] - mu) * rstd * (1.f + c4.w) + s4.w;
            st_fp8x4(p.u8, (size_t)r * DM + c, o);
        } };
    for (int r = blockIdx.x * 8 + wid; r < T_ALL; r += 2 * stride) {
        const int r2 = r + stride;
        float va[16], vb[16];
        load_row16(in_row(p, r), lane, va);
        if (r2 < T_ALL) load_row16(in_row(p, r2), lane, vb);
        proc(r, va);
        if (r2 < T_ALL) proc(r2, vb);
    }
}

__device__ __noinline__ void phase_inproj(const Params& p, int l, float* lds) {
    const int tid = threadIdx.x, ty = tid >> 5, tx = tid & 31;
    const float* win = p.w_in + (size_t)l * 1024 * IN_W;
    const float* wf = p.WF + (size_t)l * 1024 * 1024;
    for (int t = blockIdx.x; t < 288 * 50; t += gridDim.x) {
        const int rt = t / 50, ct = t % 50, col0 = ct * 128;
        float acc[4][4];
        sgemm_tile(acc, 1024,
            [&](int r, int k) { return ldv(p.u, (size_t)(rt * 64 + r) * DM + k); },
            [&](int k, int c) { const int col = col0 + c;
                if (col < 768) return win[(size_t)k * IN_W + col];
                if (col < 1792) return wf[(size_t)k * 1024 + (col - 768)];
                return win[(size_t)k * IN_W + (col - 512)]; }, lds);
#pragma unroll
        for (int i = 0; i < 4; ++i) { const size_t row = rt * 64 + ty * 4 + i;
            st4(p.P, row * PW + col0 + tx * 4, make_float4(acc[i][0], acc[i][1], acc[i][2], acc[i][3])); }
    }
}

__device__ __forceinline__ void load64(const float* p, float (&kr)[64]) {
#pragma unroll
    for (int i = 0; i < 16; ++i) { const float4 t = *(const float4*)(p + i * 4); kr[i * 4] = t.x; kr[i * 4 + 1] = t.y; kr[i * 4 + 2] = t.z; kr[i * 4 + 3] = t.w; }
}
__device__ __forceinline__ void load64(const bf16_t* p, float (&kr)[64]) {
#pragma unroll
    for (int i = 0; i < 16; ++i) { const float4 t = ld4(p, i * 4); kr[i * 4] = t.x; kr[i * 4 + 1] = t.y; kr[i * 4 + 2] = t.z; kr[i * 4 + 3] = t.w; }
}
template <int QB, int NMAP, int VD>
__device__ __noinline__ void attn_unit(const Params& p, int l, int b, int head, int qblk, bool ctxq, float* lds) {
    const int L = ctxq ? CTXL : LTOT;
    float* S = lds;
    float* Q = lds + 36864;
    const int tid = threadIdx.x, wid = tid >> 6, lane = tid & 63;
    const size_t rowbase = (size_t)b * LTOT;
    const int jq0 = (ctxq ? 0 : CTXL) + qblk * QB;
    const bool gqa = (NMAP == 1);
    const int qcol = gqa ? C_QA + head * 64 : C_QC + head * 128;
    const int kcol = gqa ? C_KA + (head >> 2) * 64 : C_KC + head * 128;
    const int vcol = gqa ? C_VA + (head >> 2) * 64 : C_VC + head * 128;
    __syncthreads();
    for (int i = tid; i < NMAP * QB * 64; i += NTHR) { const int m = i / (QB * 64), q = (i >> 6) % QB, d = i & 63;
        Q[i] = ldv(p.P, (rowbase + jq0 + q) * PW + qcol + m * 64 + d) * 0.125f; }
    __syncthreads();
    for (int j = tid; j < L; j += NTHR) {
#pragma unroll 1
        for (int m = 0; m < NMAP; ++m) {
            float kr[64]; load64(p.P + (rowbase + j) * PW + kcol + m * 64, kr);
#pragma unroll 1
            for (int q = 0; q < QB; ++q) {
                const float* qp = Q + (m * QB + q) * 64; float d = 0.f;
#pragma unroll
                for (int e = 0; e < 64; ++e) d += qp[e] * kr[e];
                S[(m * QB + q) * L + j] = d;
            }
        }
    }
    __syncthreads();
#pragma unroll
    for (int rr = 0; rr < 2; ++rr) {
        float* sr = S + (wid * 2 + rr) * L;
        float mx = -3.0e38f;
        for (int j = lane; j < L; j += 64) mx = fmaxf(mx, sr[j]);
        mx = wave_max(mx);
        float sum = 0.f;
        for (int j = lane; j < L; j += 64) { const float e = expf(sr[j] - mx); sr[j] = e; sum += e; }
        sum = wave_sum(sum);
        const float inv = 1.f / sum;
        for (int j = lane; j < L; j += 64) sr[j] *= inv;
    }
    __syncthreads();
    if (NMAP == 2) {
        const float lam = p.lam[l];
        for (int i = tid; i < QB * L; i += NTHR) S[i] -= lam * S[QB * L + i];
        __syncthreads();
    }
    const int q = tid / (VD / 2), e = (tid % (VD / 2)) * 2;
    float o0 = 0.f, o1 = 0.f;
    const float* sq = S + q * L;
    const act_t* vp = p.P + rowbase * PW + vcol + e;
#pragma unroll 4
    for (int j = 0; j < L; ++j) { const float pj = sq[j]; o0 += pj * ldv(vp, (size_t)j * PW); o1 += pj * ldv(vp, (size_t)j * PW + 1); }
    const size_t orow = rowbase + jq0 + q;
    if (gqa) { stv(p.oa, orow * 512 + head * 64 + e, o0); stv(p.oa, orow * 512 + head * 64 + e + 1, o1); }
    else {
        const float ss = wave_sum(o0 * o0 + o1 * o1);
        const float sc = rsqrtf(ss * (1.f / 128.f) + 1e-6f) * (1.f - lam_init_of(l));
        stv(p.oc, orow * 512 + head * 128 + e, o0 * sc * p.subln[l * 128 + e]); stv(p.oc, orow * 512 + head * 128 + e + 1, o1 * sc * p.subln[l * 128 + e + 1]);
    }
}
__device__ __forceinline__ void phase_attn(const Params& p, int l, bool do_ctx, float* lds) {
    for (int t = blockIdx.x; t < 8192; t += gridDim.x) attn_unit<16, 1, 64>(p, l, t >> 10, (t >> 7) & 7, t & 127, false, lds);
    for (int t = blockIdx.x; t < 8192; t += gridDim.x) attn_unit<8, 2, 128>(p, l, t >> 10, (t >> 8) & 3, t & 255, false, lds);
    if (do_ctx) {
        for (int t = blockIdx.x; t < 1024; t += gridDim.x) attn_unit<16, 1, 64>(p, l, t >> 7, (t >> 4) & 7, t & 15, true, lds);
        for (int t = blockIdx.x; t < 1024; t += gridDim.x) attn_unit<8, 2, 128>(p, l, t >> 7, (t >> 5) & 3, t & 31, true, lds);
    }
}

__device__ __noinline__ void phase_fourier(const Params& p, bool do_ctx, float* lds) {
    const int tid = threadIdx.x, ty = tid >> 5, tx = tid & 31;
    for (int t = blockIdx.x; t < 8 * 32 * 4; t += gridDim.x) {
        const int b = t >> 7, rt = (t >> 2) & 31, ct = t & 3;
        float acc[4][4];
        sgemm_tile(acc, 4096,
            [&](int r, int k) { const int kk = rt * 64 + r, n = k & 2047, m = (kk * n) & 2047; return k < 2048 ? p.tc[m] : -p.ts[m]; },
            [&](int k, int c) { const int n = k & 2047, wh = k >> 11; return ldv(p.P, ((size_t)b * LTOT + CTXL + n) * PW + C_FA + wh * 512 + ct * 128 + c); }, lds);
#pragma unroll
        for (int i = 0; i < 4; ++i) { const size_t row = (size_t)b * LTOT + CTXL + rt * 64 + ty * 4 + i; const float s = 1.f / 512.f;
            st4(p.ob, row * 512 + ct * 128 + tx * 4, make_float4(acc[i][0] * s, acc[i][1] * s, acc[i][2] * s, acc[i][3] * s)); }
    }
    if (do_ctx) {
        for (int t = blockIdx.x; t < 8 * 4 * 4; t += gridDim.x) {
            const int b = t >> 4, rt = (t >> 2) & 3, ct = t & 3;
            float acc[4][4];
            sgemm_tile(acc, 512,
                [&](int r, int k) { const int kk = rt * 64 + r, n = k & 255, m = (kk * n * 8) & 2047; return k < 256 ? p.tc[m] : -p.ts[m]; },
                [&](int k, int c) { const int n = k & 255, wh = k >> 8; return ldv(p.P, ((size_t)b * LTOT + n) * PW + C_FA + wh * 512 + ct * 128 + c); }, lds);
#pragma unroll
            for (int i = 0; i < 4; ++i) { const size_t row = (size_t)b * LTOT + rt * 64 + ty * 4 + i; const float s = 0.00552427172802f;
                st4(p.ob, row * 512 + ct * 128 + tx * 4, make_float4(acc[i][0] * s, acc[i][1] * s, acc[i][2] * s, acc[i][3] * s)); }
        }
    }
}

__device__ __noinline__ void phase_ygemm(const Params& p, int l, float* lds) {
    const int tid = threadIdx.x, ty = tid >> 5, tx = tid & 31;
    for (int t = blockIdx.x; t < 288 * 8; t += gridDim.x) {
        const int rt = t >> 3, ct = t & 7, col0 = ct * 128;
        float tot[4][4];
#pragma unroll
        for (int i = 0; i < 4; ++i)
#pragma unroll
            for (int j = 0; j < 4; ++j) tot[i][j] = 0.f;
#pragma unroll 1
        for (int br = 0; br < 3; ++br) {
            const act_t* o = br == 0 ? p.oa : br == 1 ? p.ob : p.oc;
            const float* w = (br == 0 ? p.wa : br == 1 ? p.wb : p.wc) + (size_t)l * 512 * 1024;
            float acc[4][4];
            sgemm_tile(acc, 512,
                [&](int r, int k) { return ldv(o, (size_t)(rt * 64 + r) * 512 + k); },
                [&](int k, int c) { return w[(size_t)k * 1024 + col0 + c]; }, lds);
#pragma unroll
            for (int i = 0; i < 4; ++i) { const size_t row = rt * 64 + ty * 4 + i;
                const float4 g = ld4(p.P, row * PW + C_G + br * 1024 + col0 + tx * 4);
                tot[i][0] += sigmoidf_(g.x) * acc[i][0]; tot[i][1] += sigmoidf_(g.y) * acc[i][1]; tot[i][2] += sigmoidf_(g.z) * acc[i][2]; tot[i][3] += sigmoidf_(g.w) * acc[i][3]; }
        }
#pragma unroll
        for (int i = 0; i < 4; ++i) { const size_t row = rt * 64 + ty * 4 + i; st4(p.y, row * DM + col0 + tx * 4, make_float4(tot[i][0], tot[i][1], tot[i][2], tot[i][3])); }
    }
}

__device__ __noinline__ void phase_outproj(const Params& p, int l, float* lds) {
    const int tid = threadIdx.x, ty = tid >> 5, tx = tid & 31;
    const float* w = p.wout + (size_t)l * 1024 * 1024;
    for (int t = blockIdx.x; t < 288 * 8; t += gridDim.x) {
        const int rt = t >> 3, ct = t & 7, col0 = ct * 128;
        float acc[4][4];
        sgemm_tile(acc, 1024,
            [&](int r, int k) { return ldv(p.y, (size_t)(rt * 64 + r) * DM + k); },
            [&](int k, int c) { return w[(size_t)k * 1024 + col0 + c]; }, lds);
#pragma unroll
        for (int i = 0; i < 4; ++i) { const int row = rt * 64 + ty * 4 + i; const int c = col0 + tx * 4;
            const float* hrow = l == 0 ? in_row(p, row) : p.hbuf + (size_t)row * DM;
            const float4 h4 = *(const float4*)(hrow + c); const float4 m4 = *(const float4*)(modv(p, l, mod_idx(row), 2) + c);
            float4 o; o.x = ALPHA * h4.x + m4.x * acc[i][0]; o.y = ALPHA * h4.y + m4.y * acc[i][1]; o.z = ALPHA * h4.z + m4.z * acc[i][2]; o.w = ALPHA * h4.w + m4.w * acc[i][3];
            *(float4*)(p.z + (size_t)row * DM + c) = o; }
    }
}

__device__ __noinline__ void phase_ln1(const Params& p, int l) {
    const int wid = threadIdx.x >> 6, lane = threadIdx.x & 63;
    const int stride = gridDim.x * 8;
    const float* g = p.ln1g + l * DM; const float* bb = p.ln1b + l * DM;
    auto load = [&](int r, float (&v)[16]) {
#pragma unroll
        for (int i = 0; i < 4; ++i) { const float4 t = ld4((const bf16_t*)p.z, (size_t)r * DM + i * 256 + lane * 4); v[i * 4] = t.x; v[i * 4 + 1] = t.y; v[i * 4 + 2] = t.z; v[i * 4 + 3] = t.w; } };
    auto proc = [&](int r, float (&v)[16]) {
        float mu, rstd; ln_stats(v, mu, rstd);
#pragma unroll
        for (int i = 0; i < 4; ++i) { const int c = i * 256 + lane * 4; const float4 g4 = *(const float4*)(g + c), b4 = *(const float4*)(bb + c);
            v[i * 4 + 0] = (v[i * 4 + 0] - mu) * rstd * g4.x + b4.x; v[i * 4 + 1] = (v[i * 4 + 1] - mu) * rstd * g4.y + b4.y;
            v[i * 4 + 2] = (v[i * 4 + 2] - mu) * rstd * g4.z + b4.z; v[i * 4 + 3] = (v[i * 4 + 3] - mu) * rstd * g4.w + b4.w;
            st4((bf16_t*)p.hbuf, (size_t)r * DM + c, make_float4(v[i * 4], v[i * 4 + 1], v[i * 4 + 2], v[i * 4 + 3])); }
        ln_stats(v, mu, rstd);
        const int mi = mod_idx(r);
        const float* sh = modv(p, l, mi, 3); const float* sc = modv(p, l, mi, 4);
#pragma unroll
        for (int i = 0; i < 4; ++i) { const int c = i * 256 + lane * 4; const float4 s4 = *(const float4*)(sh + c), c4 = *(const float4*)(sc + c);
            float4 o; o.x = (v[i * 4 + 0] - mu) * rstd * (1.f + c4.x) + s4.x; o.y = (v[i * 4 + 1] - mu) * rstd * (1.f + c4.y) + s4.y;
            o.z = (v[i * 4 + 2] - mu) * rstd * (1.f + c4.z) + s4.z; o.w = (v[i * 4 + 3] - mu) * rstd * (1.f + c4.w) + s4.w;
            st4(p.u, (size_t)r * DM + c, o);
            { int q8 = 0;
              q8 = __builtin_amdgcn_cvt_pk_fp8_f32(fminf(fmaxf(o.x * 16.f, -448.f), 448.f), fminf(fmaxf(o.y * 16.f, -448.f), 448.f), q8, false);
              q8 = __builtin_amdgcn_cvt_pk_fp8_f32(fminf(fmaxf(o.z * 16.f, -448.f), 448.f), fminf(fmaxf(o.w * 16.f, -448.f), 448.f), q8, true);
              *(int*)(p.u8 + (size_t)r * DM + c) = q8; } } };
    for (int r = blockIdx.x * 8 + wid; r < T_ALL; r += 2 * stride) {
        const int r2 = r + stride;
        const bool okA = !(l == 1 && (r % LTOT) < CTXL), okB = r2 < T_ALL && !(l == 1 && (r2 % LTOT) < CTXL);
        float va[16], vb[16];
        if (okA) load(r, va);
        if (okB) load(r2, vb);
        if (okA) proc(r, va);
        if (okB) proc(r2, vb);
    }
}

__device__ __noinline__ void phase_router_shared(const Params& p, int l, float* lds) {
    const int tid = threadIdx.x, ty = tid >> 5, tx = tid & 31;
    const float* wr = p.wr + (size_t)l * 1024 * 256; const float* sg = p.sg + (size_t)l * 1024 * 256; const float* su = p.su + (size_t)l * 1024 * 256;
    for (int t = blockIdx.x; t < 288 * 4; t += gridDim.x) {
        const int rt = t >> 2, kind = (t >> 1) & 1, ct = t & 1, col0 = ct * 128;
        auto fa = [&](int r, int k) { return ldv(p.u, (size_t)(rt * 64 + r) * DM + k); };
        if (kind == 0) {
            float acc[4][4];
            sgemm_tile(acc, 1024, fa, [&](int k, int c) { return wr[(size_t)k * 256 + col0 + c]; }, lds);
#pragma unroll
            for (int i = 0; i < 4; ++i) { const size_t row = rt * 64 + ty * 4 + i; *(float4*)(p.logits + row * 256 + col0 + tx * 4) = make_float4(acc[i][0], acc[i][1], acc[i][2], acc[i][3]); }
        } else {
            float ag[4][4], au[4][4];
            sgemm_tile(ag, 1024, fa, [&](int k, int c) { return sg[(size_t)k * 256 + col0 + c]; }, lds);
            sgemm_tile(au, 1024, fa, [&](int k, int c) { return su[(size_t)k * 256 + col0 + c]; }, lds);
#pragma unroll
            for (int i = 0; i < 4; ++i) { const size_t row = rt * 64 + ty * 4 + i;
                st4(p.shact, row * 256 + col0 + tx * 4, make_float4(siluf_(ag[i][0]) * au[i][0], siluf_(ag[i][1]) * au[i][1], siluf_(ag[i][2]) * au[i][2], siluf_(ag[i][3]) * au[i][3])); }
        }
    }
}

__device__ __noinline__ void phase_route(const Params& p, int l, float* lds) {
    const int tid = threadIdx.x, wid = tid >> 6, lane = tid & 63, bid = blockIdx.x;
    int* asg = (int*)lds;
    unsigned* bm = (unsigned*)lds + 640;
    for (int i = tid; i < 768; i += NTHR) bm[i] = 0u;
    __syncthreads();
    const float4 b4 = *(const float4*)(p.br + l * 256 + lane * 4);
    const float bz_[4] = {b4.x, b4.y, b4.z, b4.w};
    float4 l4n = *(const float4*)(p.logits + (size_t)(bid * 72 + wid) * 256 + lane * 4);
    for (int tl = wid; tl < 72; tl += 8) {
        const int t = bid * 72 + tl;
        const float4 l4 = l4n;
        if (tl + 8 < 72) l4n = *(const float4*)(p.logits + (size_t)(t + 8) * 256 + lane * 4);
        if (l == 1 && (t % LTOT) < CTXL) { if (lane < 8) asg[tl * 8 + lane] = -1; continue; }
        const float lg[4] = {l4.x, l4.y, l4.z, l4.w};
        float s[4], bz[4];
#pragma unroll
        for (int i = 0; i < 4; ++i) { s[i] = sigmoidf_(lg[i]); bz[i] = s[i] + bz_[i]; }
        float m1 = -3.0e38f, m2 = -3.0e38f;
#pragma unroll
        for (int i = 0; i < 4; ++i) { const float v = bz[i]; if (v > m1) { m2 = m1; m1 = v; } else if (v > m2) m2 = v; }
#pragma unroll
        for (int o = 1; o < 8; o <<= 1) { const float o1 = __shfl_xor(m1, o), o2 = __shfl_xor(m2, o); const float n1 = fmaxf(m1, o1), n2 = fmaxf(fminf(m1, o1), fmaxf(m2, o2)); m1 = n1; m2 = n2; }
        const float gs = m1 + m2; const int g = lane >> 3; int rank = 0;
#pragma unroll
        for (int j = 0; j < 8; ++j) { const float o = __int_as_float(__builtin_amdgcn_readlane(__float_as_int(gs), j * 8)); rank += ((o > gs) || (o == gs && j < g)) ? 1 : 0; }
        const bool gsel = rank < 4;
        unsigned key[4];
#pragma unroll
        for (int i = 0; i < 4; ++i) { const unsigned bits = __float_as_uint(bz[i]); const unsigned k = (bits & 0x80000000u) ? ~bits : (bits | 0x80000000u); key[i] = gsel ? k : 0u; }
        unsigned T = 0u;
#pragma unroll 1
        for (int bit = 31; bit >= 0; --bit) {
            const unsigned Tt = T | (1u << bit);
            const int cnt = __builtin_popcountll(__builtin_amdgcn_ballot_w64(key[0] >= Tt)) + __builtin_popcountll(__builtin_amdgcn_ballot_w64(key[1] >= Tt))
                          + __builtin_popcountll(__builtin_amdgcn_ballot_w64(key[2] >= Tt)) + __builtin_popcountll(__builtin_amdgcn_ballot_w64(key[3] >= Tt));
            if (cnt >= 8) T = Tt;
        }
        unsigned long long mg[4], me[4];
        int n_gt = 0;
#pragma unroll
        for (int i = 0; i < 4; ++i) { mg[i] = __builtin_amdgcn_ballot_w64(key[i] > T); me[i] = __builtin_amdgcn_ballot_w64(key[i] == T); n_gt += __builtin_popcountll(mg[i]); }
        const int need_eq = 8 - n_gt;
        const unsigned long long below = (lane == 0) ? 0ull : (~0ull >> (64 - lane));
        int eq_lower = 0;
#pragma unroll
        for (int i = 0; i < 4; ++i) eq_lower += __builtin_popcountll(me[i] & below);
        bool selm[4]; int eqrun = 0;
#pragma unroll
        for (int i = 0; i < 4; ++i) { const bool isgt = key[i] > T, iseq = key[i] == T; selm[i] = isgt || (iseq && (eq_lower + eqrun) < need_eq); eqrun += iseq ? 1 : 0; }
        unsigned long long ms[4]; int pos = 0;
#pragma unroll
        for (int i = 0; i < 4; ++i) { ms[i] = __builtin_amdgcn_ballot_w64(selm[i]); pos += __builtin_popcountll(ms[i] & below); }
        float mysum = 0.f;
#pragma unroll
        for (int i = 0; i < 4; ++i) mysum += selm[i] ? s[i] : 0.f;
        const float inv = 2.5f / wave_sum(mysum);
#pragma unroll
        for (int i = 0; i < 4; ++i) { if (selm[i]) { p.ridx[(size_t)t * 8 + pos] = lane * 4 + i; p.rw[(size_t)t * 8 + pos] = s[i] * inv; asg[tl * 8 + pos] = lane * 4 + i; ++pos;
                atomicOr(&bm[(lane * 4 + i) * 3 + (tl >> 5)], 1u << (tl & 31)); } }
    }
    __syncthreads();
    if (tid < 256) p.cntWG[bid * 256 + tid] = __builtin_popcount(bm[tid * 3]) + __builtin_popcount(bm[tid * 3 + 1]) + __builtin_popcount(bm[tid * 3 + 2]);
    for (int a = tid; a < 576; a += NTHR) { const int e = asg[a];
        if (e >= 0) { const int tl = a >> 3, w = tl >> 5, bit = tl & 31;
            int rk = __builtin_popcount(bm[e * 3 + w] & ((1u << bit) - 1u));
            if (w > 0) rk += __builtin_popcount(bm[e * 3]);
            if (w > 1) rk += __builtin_popcount(bm[e * 3 + 1]);
            p.lrank[(size_t)bid * 576 + a] = rk; } }
    __syncthreads();
}

__device__ __noinline__ void phase_slots(const Params& p, bool skip_ctx, float* lds) {
    const int tid = threadIdx.x, bid = blockIdx.x;
    int* tot = (int*)lds; int* pre = tot + 256; int* off = pre + 256;
    int* part = off + 320;
    {
        const int e = tid & 255, h = tid >> 8;
        int s = 0, mine = 0;
#pragma unroll 8
        for (int w = h * 128; w < h * 128 + 128; ++w) { const int c = p.cntWG[w * 256 + e]; s += c; mine += (w < bid) ? c : 0; }
        part[(h * 2 + 0) * 256 + e] = s; part[(h * 2 + 1) * 256 + e] = mine;
    }
    __syncthreads();
    if (tid < 256) { tot[tid] = part[tid] + part[512 + tid]; pre[tid] = part[256 + tid] + part[768 + tid]; }
    __syncthreads();
    if (tid < 64) {
        const int a0 = tot[tid * 4], a1 = tot[tid * 4 + 1], a2 = tot[tid * 4 + 2], a3 = tot[tid * 4 + 3];
        const int ls = a0 + a1 + a2 + a3; int inc = ls;
#pragma unroll
        for (int o = 1; o < 64; o <<= 1) { const int t2 = __shfl_up(inc, o); if (tid >= o) inc += t2; }
        const int ex = inc - ls;
        off[tid * 4] = ex; off[tid * 4 + 1] = ex + a0; off[tid * 4 + 2] = ex + a0 + a1; off[tid * 4 + 3] = ex + a0 + a1 + a2;
        if (tid == 63) off[256] = inc;
    }
    __syncthreads();
    if (bid == 0 && tid <= 256) p.eoff[tid] = off[tid];
    for (int a = tid; a < 576; a += NTHR) {
        const int t = bid * 72 + (a >> 3);
        if (skip_ctx && (t % LTOT) < CTXL) continue;
        const int e = p.ridx[(size_t)t * 8 + (a & 7)];
        const int slot = off[e] + pre[e] + p.lrank[(size_t)bid * 576 + a];
        p.slot_tok[slot] = t; p.tok_slot[(size_t)t * 8 + (a & 7)] = slot;
    }
}

__device__ __forceinline__ int build_units(const Params& p, int* ustart  ) {
    __syncthreads();
    if (threadIdx.x == 0) { int s = 0; for (int e = 0; e < 256; ++e) { ustart[e] = s; s += (p.eoff[e + 1] - p.eoff[e] + 63) >> 6; } ustart[256] = s; }
    __syncthreads();
    return ustart[256];
}
__device__ __forceinline__ int find_expert(const int* ustart, int ub) { int lo = 0, hi = 255; while (lo < hi) { const int mid = (lo + hi + 1) >> 1; if (ustart[mid] <= ub) lo = mid; else hi = mid - 1; } return lo; }
__device__ __noinline__ void phase_exp_up(const Params& p, int l, float* lds) {
    const int tid = threadIdx.x, ty = tid >> 5, tx = tid & 31;
    int* ustart = (int*)(lds + 4096);
    const int nub = build_units(p, ustart);
    for (int t = blockIdx.x; t < nub * 2; t += gridDim.x) {
        const int ub = t >> 1, ct = t & 1, col0 = ct * 128;
        const int e = find_expert(ustart, ub);
        const int s0 = p.eoff[e] + (ub - ustart[e]) * 64, s1 = p.eoff[e + 1];
        const float* wg = p.eg + ((size_t)l * 256 + e) * 1024 * 256; const float* wu = p.eu + ((size_t)l * 256 + e) * 1024 * 256;
        auto fa = [&](int r, int k) { const int s = s0 + r; return s < s1 ? ldv(p.u, (size_t)p.slot_tok[s] * DM + k) : 0.f; };
        float ag[4][4], au[4][4];
        sgemm_tile(ag, 1024, fa, [&](int k, int c) { return wg[(size_t)k * 256 + col0 + c]; }, lds);
        sgemm_tile(au, 1024, fa, [&](int k, int c) { return wu[(size_t)k * 256 + col0 + c]; }, lds);
#pragma unroll
        for (int i = 0; i < 4; ++i) { const int s = s0 + ty * 4 + i;
            if (s < s1) st4(p.Hs, (size_t)s * 256 + col0 + tx * 4, make_float4(siluf_(ag[i][0]) * au[i][0], siluf_(ag[i][1]) * au[i][1], siluf_(ag[i][2]) * au[i][2], siluf_(ag[i][3]) * au[i][3])); }
    }
}
__device__ __noinline__ void phase_exp_down(const Params& p, int l, float* lds) {
    const int tid = threadIdx.x, ty = tid >> 5, tx = tid & 31;
    int* ustart = (int*)(lds + 4096);
    const int nub = build_units(p, ustart);
    for (int t = blockIdx.x; t < nub * 8; t += gridDim.x) {
        const int ub = t >> 3, ct = t & 7, col0 = ct * 128;
        const int e = find_expert(ustart, ub);
        const int s0 = p.eoff[e] + (ub - ustart[e]) * 64, s1 = p.eoff[e + 1];
        const float* wd = p.ed + ((size_t)l * 256 + e) * 256 * 1024;
        float acc[4][4];
        sgemm_tile(acc, 256,
            [&](int r, int k) { const int s = s0 + r; return s < s1 ? ldv(p.Hs, (size_t)s * 256 + k) : 0.f; },
            [&](int k, int c) { return wd[(size_t)k * 1024 + col0 + c]; }, lds);
#pragma unroll
        for (int i = 0; i < 4; ++i) { const int s = s0 + ty * 4 + i;
            if (s < s1) { const float w = p.slot_w[s]; st4(p.Ys, (size_t)s * DM + col0 + tx * 4, make_float4(acc[i][0] * w, acc[i][1] * w, acc[i][2] * w, acc[i][3] * w)); } }
    }
}

__device__ __noinline__ void phase_ln2(const Params& p, int l) {
    const int wid = threadIdx.x >> 6, lane = threadIdx.x & 63;
    const int stride = gridDim.x * 8;
    int r = blockIdx.x * 8 + wid;
    int4 sa = make_int4(0, 0, 0, 0), sb = sa;
    if (r < T_ALL && !(l == 1 && (r % LTOT) < CTXL)) { sa = *(const int4*)(p.tok_slot + (size_t)r * 8); sb = *(const int4*)(p.tok_slot + (size_t)r * 8 + 4); }
    for (; r < T_ALL; r += stride) {
        const int rn = r + stride;
        int4 na = make_int4(0, 0, 0, 0), nb = na;
        if (rn < T_ALL && !(l == 1 && (rn % LTOT) < CTXL)) { na = *(const int4*)(p.tok_slot + (size_t)rn * 8); nb = *(const int4*)(p.tok_slot + (size_t)rn * 8 + 4); }
        const int sl[8] = {sa.x, sa.y, sa.z, sa.w, sb.x, sb.y, sb.z, sb.w};
        sa = na; sb = nb;
        if (l == 1 && (r % LTOT) < CTXL) continue;
        const float4 wa = *(const float4*)(p.rw + (size_t)r * 8), wb = *(const float4*)(p.rw + (size_t)r * 8 + 4);
        const float wk[8] = {wa.x, wa.y, wa.z, wa.w, wb.x, wb.y, wb.z, wb.w};
        unsigned yraw[8][4];
        const unsigned char* ys8 = (const unsigned char*)p.Ys;
#pragma unroll
        for (int k = 0; k < 8; ++k)
#pragma unroll
            for (int i = 0; i < 4; ++i) yraw[k][i] = *(const unsigned*)(ys8 + (size_t)sl[k] * DM + i * 256 + lane * 4);
        float ft[16];
#pragma unroll
        for (int i = 0; i < 4; ++i) { const int q = *(const int*)((const unsigned char*)p.f + (size_t)r * DM + i * 256 + lane * 4);
            ft[i * 4] = __builtin_amdgcn_cvt_f32_fp8(q, 0) * (1.f / 32.f); ft[i * 4 + 1] = __builtin_amdgcn_cvt_f32_fp8(q, 1) * (1.f / 32.f); ft[i * 4 + 2] = __builtin_amdgcn_cvt_f32_fp8(q, 2) * (1.f / 32.f); ft[i * 4 + 3] = __builtin_amdgcn_cvt_f32_fp8(q, 3) * (1.f / 32.f); }
        float fr8[16];
#pragma unroll
        for (int i = 0; i < 16; ++i) fr8[i] = 0.f;
#pragma unroll
        for (int k = 0; k < 8; ++k)
#pragma unroll
            for (int i = 0; i < 4; ++i) { const int q = (int)yraw[k][i];
                fr8[i * 4] += wk[k] * __builtin_amdgcn_cvt_f32_fp8(q, 0); fr8[i * 4 + 1] += wk[k] * __builtin_amdgcn_cvt_f32_fp8(q, 1); fr8[i * 4 + 2] += wk[k] * __builtin_amdgcn_cvt_f32_fp8(q, 2); fr8[i * 4 + 3] += wk[k] * __builtin_amdgcn_cvt_f32_fp8(q, 3); }
#pragma unroll
        for (int i = 0; i < 16; ++i) ft[i] += fr8[i] * (1.f / 16.f);
        float v[16];
#pragma unroll
        for (int i = 0; i < 4; ++i) { const float4 t = ld4((const bf16_t*)p.hbuf, (size_t)r * DM + i * 256 + lane * 4); v[i * 4] = t.x; v[i * 4 + 1] = t.y; v[i * 4 + 2] = t.z; v[i * 4 + 3] = t.w; }
        const int mi = mod_idx(r);
        const float* m5 = modv(p, l, mi, 5);
#pragma unroll
        for (int i = 0; i < 4; ++i) { const float4 m4 = *(const float4*)(m5 + i * 256 + lane * 4);
            v[i * 4] = ALPHA * v[i * 4] + m4.x * ft[i * 4]; v[i * 4 + 1] = ALPHA * v[i * 4 + 1] + m4.y * ft[i * 4 + 1]; v[i * 4 + 2] = ALPHA * v[i * 4 + 2] + m4.z * ft[i * 4 + 2]; v[i * 4 + 3] = ALPHA * v[i * 4 + 3] + m4.w * ft[i * 4 + 3]; }
        float mu, rstd; ln_stats(v, mu, rstd);
        const float* g = p.ln2g + l * DM; const float* bb = p.ln2b + l * DM;
        const int b = r / LTOT, j = r - b * LTOT;
#pragma unroll
        for (int i = 0; i < 4; ++i) { const int c = i * 256 + lane * 4; const float4 g4 = *(const float4*)(g + c), b4 = *(const float4*)(bb + c);
            v[i * 4 + 0] = (v[i * 4 + 0] - mu) * rstd * g4.x + b4.x; v[i * 4 + 1] = (v[i * 4 + 1] - mu) * rstd * g4.y + b4.y;
            v[i * 4 + 2] = (v[i * 4 + 2] - mu) * rstd * g4.z + b4.z; v[i * 4 + 3] = (v[i * 4 + 3] - mu) * rstd * g4.w + b4.w;
            const float4 o = make_float4(v[i * 4], v[i * 4 + 1], v[i * 4 + 2], v[i * 4 + 3]);
            if (l == 1) { if (j >= CTXL) *(float4*)(p.out + ((size_t)b * SEQ + (j - CTXL)) * DM + c) = o; }
            else st4((bf16_t*)p.hbuf, (size_t)r * DM + c, o); }
        if (l == 0) {
            ln_stats(v, mu, rstd);
            const float* sh = modv(p, 1, mi, 0); const float* sc = modv(p, 1, mi, 1);
#pragma unroll
            for (int i = 0; i < 4; ++i) { const int c = i * 256 + lane * 4; const float4 s4 = *(const float4*)(sh + c), c4 = *(const float4*)(sc + c);
                float4 o; o.x = (v[i * 4 + 0] - mu) * rstd * (1.f + c4.x) + s4.x; o.y = (v[i * 4 + 1] - mu) * rstd * (1.f + c4.y) + s4.y;
                o.z = (v[i * 4 + 2] - mu) * rstd * (1.f + c4.z) + s4.z; o.w = (v[i * 4 + 3] - mu) * rstd * (1.f + c4.w) + s4.w;
                st_fp8x4(p.u8, (size_t)r * DM + c, o); }
        }
    }
}

template <class T> __device__ __forceinline__ T* uni(T* p) { const unsigned long long v = (unsigned long long)p; const unsigned lo = __builtin_amdgcn_readfirstlane((unsigned)v), hi = __builtin_amdgcn_readfirstlane((unsigned)(v >> 32)); return (T*)(((unsigned long long)hi << 32) | lo); }
__device__ __forceinline__ int uni(int v) { return __builtin_amdgcn_readfirstlane(v); }
namespace pg8 {
#define PG8_LAS __attribute__((address_space(3)))
#define GAS __attribute__((address_space(1)))
typedef short bf16x8 __attribute__((ext_vector_type(8)));
typedef float f32x4 __attribute__((ext_vector_type(4)));
typedef unsigned u32x4 __attribute__((ext_vector_type(4)));
constexpr int BM = 256, BK = 64, HALF = 128, HTB = HALF * BK * 2, STAGE_BYTES = 8 * HTB, NXCD = 8, WGM = 8;
__host__ __device__ __forceinline__ int lds_byte(int r, int c) { const int st = (r >> 4) * 2 + (c >> 5), rr = r & 15, cc = c & 31, ob = rr * 64 + cc * 2; return st * 1024 + (ob ^ (((ob >> 9) & 1) << 5)); }
__host__ __device__ __forceinline__ void stage_rc(int b, int& R, int& C) { const int st = b / 1024, sb = b % 1024, swz = sb ^ (((sb >> 9) & 1) << 5); R = (st >> 1) * 16 + swz / 64; C = (st & 1) * 32 + (swz % 64) / 2; }
__host__ __device__ __forceinline__ int perm32(int rho) { const int n = rho >> 4, i = rho & 15; return 8 * (i >> 2) + 4 * n + (i & 3); }
struct Unit { const char* a; const char* b; int pm, pn, aux; };
typedef __bf16 bf16n2 __attribute__((ext_vector_type(2)));
typedef float f32n2 __attribute__((ext_vector_type(2)));
__device__ __forceinline__ unsigned cvt_pk_bf16(float lo, float hi) { return __builtin_bit_cast(unsigned, __builtin_convertvector((f32n2){lo, hi}, bf16n2)); }
__device__ __forceinline__ u32x4 pack8(const f32x4 v0, const f32x4 v1) { u32x4 w; w.x = cvt_pk_bf16(v0[0], v0[1]); w.y = cvt_pk_bf16(v0[2], v0[3]); w.z = cvt_pk_bf16(v1[0], v1[1]); w.w = cvt_pk_bf16(v1[2], v1[3]); return w; }

typedef int i32x8 __attribute__((ext_vector_type(8)));
typedef int i32x4 __attribute__((ext_vector_type(4)));
__device__ __forceinline__ f32x4 mfma_fp8(const bf16x8 (&b)[2], const bf16x8 (&a)[2], f32x4 c) {
    const i32x8 bv = __builtin_shufflevector(__builtin_bit_cast(i32x4, b[0]), __builtin_bit_cast(i32x4, b[1]), 0, 1, 2, 3, 4, 5, 6, 7);
    const i32x8 av = __builtin_shufflevector(__builtin_bit_cast(i32x4, a[0]), __builtin_bit_cast(i32x4, a[1]), 0, 1, 2, 3, 4, 5, 6, 7);
    asm volatile("v_mfma_f32_16x16x128_f8f6f4 %0, %1, %2, %0" : "+v"(c) : "v"(bv), "v"(av));
    return c;
}
typedef unsigned u32x2f __attribute__((ext_vector_type(2)));
__device__ __forceinline__ u32x2f pack8_fp8(const f32x4 v0, const f32x4 v1, const float s) {
    f32x4 a = v0 * s, b = v1 * s;
#pragma unroll
    for (int j = 0; j < 4; ++j) { a[j] = fminf(fmaxf(a[j], -448.f), 448.f); b[j] = fminf(fmaxf(b[j], -448.f), 448.f); }
    int q0 = 0, q1 = 0;
    q0 = __builtin_amdgcn_cvt_pk_fp8_f32(a[0], a[1], q0, false); q0 = __builtin_amdgcn_cvt_pk_fp8_f32(a[2], a[3], q0, true);
    q1 = __builtin_amdgcn_cvt_pk_fp8_f32(b[0], b[1], q1, false); q1 = __builtin_amdgcn_cvt_pk_fp8_f32(b[2], b[3], q1, true);
    return (u32x2f){(unsigned)q0, (unsigned)q1};
}
struct TileOrder {
    int nM, nN, nwg, G, c, sub, pn_off; bool skipctx;
    const char *A0, *B0; size_t a_tile, b_tile, a_sub, b_sub;
    __device__ __forceinline__ unsigned row_off(const Unit&, int) const { return 0u; }
    __device__ void init(int M, int N, int G_, int c_, int sub_) { nM = M / BM; nN = N / BM; nwg = nM * nN; G = G_; c = c_; sub = sub_; skipctx = false; pn_off = 0; }
    __device__ bool next(int i, Unit& u) const {
        const int ti = i / sub, s = i - ti * sub;
        const long L = (long)ti * G + c; if (L >= nwg) return false;
        int wgid = (int)L; { const int q = nwg / NXCD, r = nwg % NXCD, xcd = wgid % NXCD, off = wgid / NXCD; wgid = (xcd < r ? xcd * (q + 1) : r * (q + 1) + (xcd - r) * q) + off; }
        const int nig = WGM * nN, gid = wgid / nig, fm = gid * WGM, gsz = (nM - fm) < WGM ? (nM - fm) : WGM;
        u.pm = fm + ((wgid % nig) % gsz); u.pn = (wgid % nig) / gsz + pn_off; u.aux = s;
        if (skipctx) u.pm = (u.pm >> 3) * 9 + 1 + (u.pm & 7);
        u.a = A0 + (size_t)s * a_sub + (size_t)u.pm * a_tile; u.b = B0 + (size_t)s * b_sub + (size_t)u.pn * b_tile;
        return true;
    }
};

struct CtxKVOrder {
    int G, c; const char *A0, *B0; size_t a_tile, b_tile;
    __device__ __forceinline__ unsigned row_off(const Unit&, int) const { return 0u; }
    __device__ __forceinline__ bool next(int i, Unit& u) const {
        const int uid = i * G + c; if (uid >= 40) return false;
        const int b = uid / 5, k = uid - b * 5;
        u.pm = b * 9; u.pn = k == 0 ? 2 : 8 + k; u.aux = 0;
        u.a = A0 + (size_t)u.pm * a_tile; u.b = B0 + (size_t)u.pn * b_tile;
        return true;
    }
};
template <bool GATHER = false, bool FP8 = false, class Epi, class Sched>
__device__ __forceinline__ void gemm_phase(PG8_LAS unsigned char* lds, const int K, const int lda, const int ldb, const Sched& S, const Epi& E) {
    int tid = threadIdx.x; asm volatile("" : "+v"(tid));
    const int wid = __builtin_amdgcn_readfirstlane(tid >> 6), lane = tid & 63, wr = wid >> 2, wc = wid & 3, fr = lane & 15, fq = lane >> 4;
    const int nt = K / BK;
    unsigned voffA[2], voffB[2];
#pragma unroll
    for (int i = 0; i < 2; ++i) { int R, C; stage_rc(tid * 16 + i * 8192, R, C); const int Rb = (R & ~31) + perm32(R & 31);
        voffA[i] = (unsigned)(R * lda + C) * 2u; voffB[i] = (unsigned)(Rb * ldb + C) * 2u; }
    unsigned gc[2][2], gn[2][2];
    const size_t kstep = (size_t)(BK * 2);
    const size_t hstepA = (size_t)HALF * lda * 2, hstepB = (size_t)HALF * ldb * 2;
    const unsigned ldsw = (unsigned)wid * 1024u;
    const int aoff = lds_byte(wr * 64 + fr, fq * 8), boff = lds_byte(wc * 32 + fr, fq * 8);
#define PG8_SA(b, h) (((b) * 2 + (h)) * HTB)
#define PG8_SB(b, h) ((4 + (b) * 2 + (h)) * HTB)
#define PG8_STAGE(bufoff, gbase, voff) do { _Pragma("unroll") for (int _i = 0; _i < 2; ++_i) \
        __builtin_amdgcn_global_load_lds((const unsigned*)((const char*)(gbase) + (voff)[_i]), (PG8_LAS unsigned*)(lds + (bufoff) + ldsw + _i * 8192), 16, 0, 0); } while (0)
#define PG8_STAGE_A(bufoff, gbase, h, late) do { _Pragma("unroll") for (int _i = 0; _i < 2; ++_i) { \
        const size_t _o = GATHER ? (size_t)(((late) && last) ? gn[h][_i] : gc[h][_i]) : (size_t)voffA[_i] + (size_t)(h) * hstepA; \
        __builtin_amdgcn_global_load_lds((const unsigned*)((const char*)(gbase) + _o), (PG8_LAS unsigned*)(lds + (bufoff) + ldsw + _i * 8192), 16, 0, 0); } } while (0)
#define PG8_GOFF(dst, un) do { if (GATHER) { _Pragma("unroll") for (int _h = 0; _h < 2; ++_h) _Pragma("unroll") for (int _i = 0; _i < 2; ++_i) { int _R, _C; stage_rc(tid * 16 + _i * 8192, _R, _C); dst[_h][_i] = S.row_off(un, _h * HALF + _R) + (unsigned)(_C * 2); } } } while (0)
#define PG8_LDA(dst, b, h) do { _Pragma("unroll") for (int m = 0; m < 4; ++m) _Pragma("unroll") for (int k = 0; k < 2; ++k) dst[m][k] = *(const PG8_LAS bf16x8*)(lds + PG8_SA(b, h) + aoff + m * 2048 + k * 1024); } while (0)
#define PG8_LDB(dst, b, h) do { _Pragma("unroll") for (int n = 0; n < 2; ++n) _Pragma("unroll") for (int k = 0; k < 2; ++k) dst[n][k] = *(const PG8_LAS bf16x8*)(lds + PG8_SB(b, h) + boff + n * 2048 + k * 1024); } while (0)
#define PG8_MMA(ai, bj, At, Bt) do { __builtin_amdgcn_s_setprio(1); _Pragma("unroll") for (int m = 0; m < 4; ++m) _Pragma("unroll") for (int n = 0; n < 2; ++n) { \
        if constexpr (FP8) acc[ai][bj][m][n] = mfma_fp8(Bt[n], At[m], acc[ai][bj][m][n]); \
        else { _Pragma("unroll") for (int k = 0; k < 2; ++k) acc[ai][bj][m][n] = __builtin_amdgcn_mfma_f32_16x16x32_bf16(Bt[n][k], At[m][k], acc[ai][bj][m][n], 0, 0, 0); } } \
        __builtin_amdgcn_s_setprio(0); } while (0)
#define PG8_WAIT_V(n) asm volatile("s_waitcnt vmcnt(" #n ")" ::: "memory")
#define PG8_WAIT_L(n) asm volatile("s_waitcnt lgkmcnt(" #n ")" ::: "memory")
#define PG8_BAR __builtin_amdgcn_s_barrier()
#define PG8_SCHED __builtin_amdgcn_sched_barrier(0)
    Unit cur, nxt; int ui = 0;
    if (!S.next(0, cur)) return;
    f32x4 acc[2][2][4][2];
#pragma unroll
    for (int a = 0; a < 2; ++a)
#pragma unroll
        for (int b = 0; b < 2; ++b)
#pragma unroll
            for (int m = 0; m < 4; ++m)
#pragma unroll
                for (int n = 0; n < 2; ++n) acc[a][b][m][n] = (f32x4){0.f, 0.f, 0.f, 0.f};
    bf16x8 At[4][2], B0[2][2], B1[2][2];
    const char* cA = cur.a; const char* cB = cur.b;
    PG8_GOFF(gc, cur); PG8_GOFF(gn, cur);
    { const bool last = false;
    PG8_STAGE(PG8_SB(0, 0), cB, voffB); PG8_STAGE_A(PG8_SA(0, 0), cA, 0, false); PG8_STAGE(PG8_SB(0, 1), cB + hstepB, voffB); PG8_STAGE_A(PG8_SA(0, 1), cA, 1, false);
    if (wr == 1) PG8_BAR;
    PG8_WAIT_V(4); PG8_BAR;
    PG8_STAGE(PG8_SB(1, 0), cB + kstep, voffB); PG8_STAGE_A(PG8_SA(1, 0), cA + kstep, 0, false); PG8_STAGE(PG8_SB(1, 1), cB + hstepB + kstep, voffB); }
    PG8_WAIT_V(6); PG8_BAR;
    for (;;) {
        const bool has_next = S.next(ui + 1, nxt);
        const char* nA = has_next ? nxt.a : cA; const char* nB = has_next ? nxt.b : cB;
        if (has_next) PG8_GOFF(gn, nxt);
#pragma unroll 1
        for (int t = 0; t < nt; t += 2) {
            const bool last = (t == nt - 2);
            const char* a1 = cA + (size_t)(t + 1) * kstep;
            const char* a2 = last ? nA : cA + (size_t)(t + 2) * kstep; const char* b2 = last ? nB : cB + (size_t)(t + 2) * kstep;
            const char* a3 = a2 + kstep; const char* b3 = b2 + kstep;
            PG8_LDB(B0, 0, 0); PG8_SCHED; PG8_LDA(At, 0, 0); PG8_STAGE_A(PG8_SA(1, 1), a1, 1, false);
            PG8_WAIT_L(8); PG8_BAR; PG8_WAIT_L(0); PG8_MMA(0, 0, At, B0); PG8_BAR; PG8_SCHED;
            PG8_LDB(B1, 0, 1); PG8_STAGE(PG8_SB(0, 0), b2, voffB);
            PG8_BAR; PG8_WAIT_L(0); PG8_MMA(0, 1, At, B1); PG8_BAR;
            PG8_LDA(At, 0, 1); PG8_STAGE_A(PG8_SA(0, 0), a2, 0, true);
            PG8_BAR; PG8_WAIT_L(0); PG8_MMA(1, 0, At, B0); PG8_BAR; PG8_SCHED;
            PG8_STAGE(PG8_SB(0, 1), b2 + hstepB, voffB);
            PG8_WAIT_V(6); PG8_BAR; PG8_MMA(1, 1, At, B1); PG8_BAR;
            PG8_LDB(B0, 1, 0); PG8_SCHED; PG8_LDA(At, 1, 0); PG8_STAGE_A(PG8_SA(0, 1), a2, 1, true);
            PG8_WAIT_L(8); PG8_BAR; PG8_WAIT_L(0); PG8_MMA(0, 0, At, B0); PG8_BAR; PG8_SCHED;
            PG8_LDB(B1, 1, 1); PG8_STAGE(PG8_SB(1, 0), b3, voffB);
            PG8_BAR; PG8_WAIT_L(0); PG8_MMA(0, 1, At, B1); PG8_BAR;
            PG8_LDA(At, 1, 1); PG8_STAGE_A(PG8_SA(1, 0), a3, 0, true);
            PG8_BAR; PG8_WAIT_L(0); PG8_MMA(1, 0, At, B0); PG8_BAR; PG8_SCHED;
            PG8_STAGE(PG8_SB(1, 1), b3 + hstepB, voffB);
            PG8_WAIT_V(6); PG8_BAR; PG8_MMA(1, 1, At, B1); PG8_BAR;
        }
        if constexpr (FP8) asm volatile("s_nop 7\n\ts_nop 7\n\ts_nop 7" ::: "memory");
        const bool keep = E(acc, cur, wr, wc, fr, fq);
        if (!has_next) break;
        if (!keep) {
#pragma unroll
        for (int a = 0; a < 2; ++a)
#pragma unroll
            for (int b = 0; b < 2; ++b)
#pragma unroll
                for (int m = 0; m < 4; ++m)
#pragma unroll
                    for (int n = 0; n < 2; ++n) acc[a][b][m][n] = (f32x4){0.f, 0.f, 0.f, 0.f}; }
        cur = nxt; cA = nA; cB = nB; ++ui;
        if (GATHER) {
#pragma unroll
            for (int _h = 0; _h < 2; ++_h)
#pragma unroll
                for (int _i = 0; _i < 2; ++_i) gc[_h][_i] = gn[_h][_i]; }
    }
    PG8_WAIT_V(0);
    if (wr == 0) PG8_BAR;
    PG8_BAR;
#undef PG8_SA
#undef PG8_SB
#undef PG8_STAGE
#undef PG8_STAGE_A
#undef PG8_GOFF
#undef PG8_LDA
#undef PG8_LDB
#undef PG8_MMA
#undef PG8_WAIT_V
#undef PG8_WAIT_L
#undef PG8_BAR
#undef PG8_SCHED
}
typedef f32x4 Acc[2][2][4][2];

struct EpiStoreBf16 {
    bf16_t* O; int ldc;
    __device__ __forceinline__ bool operator()(Acc& acc, const Unit& u, int wr, int wc, int fr, int fq) const {
        const int row0 = u.pm * BM + wr * 64 + fr, col0 = u.pn * BM + wc * 32 + 8 * fq;
#pragma unroll
        for (int ai = 0; ai < 2; ++ai)
#pragma unroll
            for (int m = 0; m < 4; ++m) { bf16_t* rowp = O + (size_t)(row0 + ai * HALF + m * 16) * ldc + col0;
#pragma unroll
                for (int bj = 0; bj < 2; ++bj) *(GAS u32x4*)(rowp + bj * HALF) = pack8(acc[ai][bj][m][0], acc[ai][bj][m][1]); }
        return false;
    }
};
struct EpiStoreFp8 {
    unsigned char* O; int ldc; float scale;
    __device__ __forceinline__ bool operator()(Acc& acc, const Unit& u, int wr, int wc, int fr, int fq) const {
        const int row0 = u.pm * BM + wr * 64 + fr, col0 = u.pn * BM + wc * 32 + 8 * fq;
#pragma unroll
        for (int ai = 0; ai < 2; ++ai)
#pragma unroll
            for (int m = 0; m < 4; ++m) { unsigned char* rowp = O + (size_t)(row0 + ai * HALF + m * 16) * ldc + col0;
#pragma unroll
                for (int bj = 0; bj < 2; ++bj) *(GAS u32x2f*)(rowp + bj * HALF) = pack8_fp8(acc[ai][bj][m][0], acc[ai][bj][m][1], scale); }
        return false;
    }
};
struct EpiInproj {
    bf16_t* O; unsigned char* Gq; unsigned char* PF;
    __device__ __forceinline__ bool operator()(Acc& acc, const Unit& u, int wr, int wc, int fr, int fq) const {
        const int row0 = u.pm * BM + wr * 64 + fr, cw = wc * 32 + 8 * fq;
        const float sc = (u.pn >= 3 && u.pn < 7) ? 1.f / (16.f * 64.f) : 1.f / (16.f * 256.f);
        if (u.pn >= 3 && u.pn < 7) {
#pragma unroll
            for (int ai = 0; ai < 2; ++ai)
#pragma unroll
                for (int m = 0; m < 4; ++m) { unsigned char* rowp = PF + (size_t)(row0 + ai * HALF + m * 16) * 1024 + (u.pn - 3) * BM + cw;
#pragma unroll
                    for (int bj = 0; bj < 2; ++bj) *(GAS u32x2f*)(rowp + bj * HALF) = pack8_fp8(acc[ai][bj][m][0], acc[ai][bj][m][1], sc * 4.f); }
        } else if (u.pn < 13) {
#pragma unroll
            for (int ai = 0; ai < 2; ++ai)
#pragma unroll
                for (int m = 0; m < 4; ++m) { bf16_t* rowp = O + (size_t)(row0 + ai * HALF + m * 16) * PW + u.pn * BM + cw;
#pragma unroll
                    for (int bj = 0; bj < 2; ++bj) *(GAS u32x4*)(rowp + bj * HALF) = pack8(acc[ai][bj][m][0] * sc, acc[ai][bj][m][1] * sc); }
        } else {
            typedef unsigned u32x2e __attribute__((ext_vector_type(2)));
#pragma unroll
            for (int ai = 0; ai < 2; ++ai)
#pragma unroll
                for (int m = 0; m < 4; ++m) { unsigned char* rowp = Gq + (size_t)(row0 + ai * HALF + m * 16) * 1536 + (((u.pn - 13) * BM + cw) >> 1);
#pragma unroll
                    for (int bj = 0; bj < 2; ++bj) { f32x4 a0 = acc[ai][bj][m][0] * sc, a1 = acc[ai][bj][m][1] * sc;
                        unsigned w4 = 0u;
#pragma unroll
                        for (int j = 0; j < 4; ++j) { const float g0 = __builtin_amdgcn_rcpf(1.f + __expf(-a0[j])), g1 = __builtin_amdgcn_rcpf(1.f + __expf(-a1[j]));
                            const unsigned n0 = (unsigned)fminf(g0 * 16.f, 15.f), n1 = (unsigned)fminf(g1 * 16.f, 15.f);
                            w4 |= (n0 << (4 * j)) | (n1 << (16 + 4 * j)); }
                        *(GAS unsigned*)(rowp + bj * (HALF / 2)) = w4; } }
        }
        return false;
    }
};
struct EpiF32 {
    float* C; int ldc;
    __device__ __forceinline__ bool operator()(Acc& acc, const Unit& u, int wr, int wc, int fr, int fq) const {
        const int row0 = u.pm * BM + wr * 64 + fr, col0 = u.pn * BM + wc * 32 + 8 * fq;
#pragma unroll
        for (int ai = 0; ai < 2; ++ai)
#pragma unroll
            for (int m = 0; m < 4; ++m) { float* rowp = C + (size_t)(row0 + ai * HALF + m * 16) * ldc + col0;
#pragma unroll
                for (int bj = 0; bj < 2; ++bj) { *(GAS f32x4*)(rowp + bj * HALF) = acc[ai][bj][m][0]; *(GAS f32x4*)(rowp + bj * HALF + 4) = acc[ai][bj][m][1]; } }
        return false;
    }
};
__device__ __forceinline__ float fsig(float v) { return 1.f / (1.f + __expf(-v)); }
__device__ __forceinline__ void unpack8(const u32x4 w, float (&g)[8]) {
    g[0] = __uint_as_float(w.x << 16); g[1] = __uint_as_float(w.x & 0xFFFF0000u); g[2] = __uint_as_float(w.y << 16); g[3] = __uint_as_float(w.y & 0xFFFF0000u);
    g[4] = __uint_as_float(w.z << 16); g[5] = __uint_as_float(w.z & 0xFFFF0000u); g[6] = __uint_as_float(w.w << 16); g[7] = __uint_as_float(w.w & 0xFFFF0000u);
}
struct EpiY {
    const unsigned char* Gq; unsigned char* y;
    __device__ __forceinline__ bool operator()(Acc& acc, const Unit& u, int wr, int wc, int fr, int fq) const {
        const int row0 = u.pm * BM + wr * 64 + fr, col0 = u.pn * BM + wc * 32 + 8 * fq, br = u.aux;
        unsigned ga[2][4][2], gb[2][4][2];
#pragma unroll
        for (int ai = 0; ai < 2; ++ai)
#pragma unroll
            for (int m = 0; m < 4; ++m)
#pragma unroll
                for (int bj = 0; bj < 2; ++bj) { const unsigned char* gp = Gq + (size_t)(row0 + ai * HALF + m * 16) * 1536 + br * 512 + ((col0 + bj * HALF) >> 1);
                    ga[ai][m][bj] = *(const GAS unsigned*)gp; gb[ai][m][bj] = br < 2 ? *(const GAS unsigned*)(gp + 512) : ga[ai][m][bj]; }
#pragma unroll
        for (int ai = 0; ai < 2; ++ai)
#pragma unroll
            for (int m = 0; m < 4; ++m)
#pragma unroll
                for (int bj = 0; bj < 2; ++bj) {
#pragma unroll
                    for (int j = 0; j < 8; ++j) { const float a = (float)((ga[ai][m][bj] >> (4 * j)) & 15u) * (1.f / 16.f) + (1.f / 32.f), b = (float)((gb[ai][m][bj] >> (4 * j)) & 15u) * (1.f / 16.f) + (1.f / 32.f);
                        const float f = br < 2 ? a * __builtin_amdgcn_rcpf(b) : a;
                        if (j < 4) acc[ai][bj][m][0][j] *= f; else acc[ai][bj][m][1][j - 4] *= f; }
                    if (br == 2) *(GAS u32x2f*)(y + (size_t)(row0 + ai * HALF + m * 16) * DM + col0 + bj * HALF) = pack8_fp8(acc[ai][bj][m][0], acc[ai][bj][m][1], 16.f / 4096.f); }
        return br != 2;
    }
};
struct EpiZ {
    const float* hsrc_x; const float* hsrc_ctx; const bf16_t* hbuf; const float* mod2; bf16_t* z; int layer;
    __device__ __forceinline__ bool operator()(Acc& acc, const Unit& u, int wr, int wc, int fr, int fq) const {
        const int b = u.pm / 9, jt = u.pm - b * 9;
        const float* hbase = jt == 0 ? hsrc_ctx + (size_t)b * CTXL * DM : hsrc_x + ((size_t)b * SEQ + (jt - 1) * 256) * DM;
        const bf16_t* hb16 = hbuf + (size_t)u.pm * BM * DM;
        const float* m2 = mod2 + (size_t)(jt == 0 ? 8 : b) * 6144;
        int rl0 = wr * 64 + fr; asm volatile("" : "+v"(rl0));
        const int col0 = u.pn * BM + wc * 32 + 8 * fq;
#pragma unroll
        for (int bj = 0; bj < 2; ++bj) { const int c = col0 + bj * HALF; const f32x4 ma = *(const GAS f32x4*)(m2 + c) * (1.f / 8192.f), mb = *(const GAS f32x4*)(m2 + c + 4) * (1.f / 8192.f);
#pragma unroll
            for (int ai = 0; ai < 2; ++ai) {
                f32x4 h0[4], h1[4];
                if (layer == 0) {
#pragma unroll
                    for (int m = 0; m < 4; ++m) { const float* hp = hbase + (size_t)(rl0 + ai * HALF + m * 16) * DM + c; h0[m] = *(const GAS f32x4*)hp; h1[m] = *(const GAS f32x4*)(hp + 4); }
                } else {
                    u32x4 hr[4];
#pragma unroll
                    for (int m = 0; m < 4; ++m) hr[m] = *(const GAS u32x4*)(hb16 + (size_t)(rl0 + ai * HALF + m * 16) * DM + c);
#pragma unroll
                    for (int m = 0; m < 4; ++m) { float t[8]; unpack8(hr[m], t); h0[m] = (f32x4){t[0], t[1], t[2], t[3]}; h1[m] = (f32x4){t[4], t[5], t[6], t[7]}; }
                }
#pragma unroll
                for (int m = 0; m < 4; ++m) { bf16_t* zp = z + ((size_t)u.pm * BM + rl0 + ai * HALF + m * 16) * DM + c;
                    *(GAS u32x4*)zp = pack8(ALPHA * h0[m] + ma * acc[ai][bj][m][0], ALPHA * h1[m] + mb * acc[ai][bj][m][1]); } } }
        return false;
    }
};
struct EpiG {
    float* logits; bf16_t* shact;
    __device__ __forceinline__ bool operator()(Acc& acc, const Unit& u, int wr, int wc, int fr, int fq) const {
        const int row0 = u.pm * BM + wr * 64 + fr, cw = wc * 32 + 8 * fq;
#pragma unroll
        for (int ai = 0; ai < 2; ++ai)
#pragma unroll
            for (int m = 0; m < 4; ++m) { const size_t row = (size_t)(row0 + ai * HALF + m * 16);
                if (u.pn == 0) {
#pragma unroll
                    for (int bj = 0; bj < 2; ++bj) { float* lp = logits + row * 256 + bj * HALF + cw; *(f32x4*)lp = acc[ai][bj][m][0]; *(GAS f32x4*)(lp + 4) = acc[ai][bj][m][1]; }
                } else {
                    f32x4 v0, v1;
#pragma unroll
                    for (int j = 0; j < 4; ++j) { const float g0 = acc[ai][0][m][0][j], g1 = acc[ai][0][m][1][j];
                        v0[j] = g0 * fsig(g0) * acc[ai][1][m][0][j]; v1[j] = g1 * fsig(g1) * acc[ai][1][m][1][j]; }
                    *(GAS u32x4*)(shact + row * 256 + (u.pn - 1) * 128 + cw) = pack8(v0, v1);
                } }
        return false;
    }
};

struct ExpOrder {
    const PG8_LAS int* ustart; const int* eoff; const int* slot_tok; int nct, nun, G, c; bool gather;
    const char* A; const char* B; size_t b_exp, b_tile; unsigned lda_bytes;
    __device__ __forceinline__ bool next(int i, Unit& u) const {
        const int cv = ((c & 7) << 5) | (c >> 3);
        const int uid = i * G + cv; if (uid >= nun) return false;
        const int ub = uid / nct, ct = uid - ub * nct;
        int lo = 0, hi = 255; while (lo < hi) { const int mid = (lo + hi + 1) >> 1; if (ustart[mid] <= ub) lo = mid; else hi = mid - 1; }
        const int e = lo, s0 = ustart[320 + e] + (ub - ustart[e]) * 256;
        u.pm = s0; u.aux = ustart[320 + e + 1]; u.pn = ct;
        u.b = B + (size_t)e * b_exp + (size_t)ct * b_tile; u.a = gather ? A : A + (size_t)s0 * lda_bytes;
        return true;
    }
    __device__ __forceinline__ unsigned row_off(const Unit& u, int r) const { const int s = u.pm + r; const int t = s < u.aux ? ((const GAS int*)slot_tok)[s] : 0; return (unsigned)t * lda_bytes; }
};
__device__ __forceinline__ u32x4 widen16(const unsigned ax, const unsigned ay, const unsigned bx, const unsigned by) {
    const auto rx = __builtin_amdgcn_permlane16_swap(ax, bx, false, false);
    const auto ry = __builtin_amdgcn_permlane16_swap(ay, by, false, false);
    return (u32x4){rx[0], ry[0], rx[1], ry[1]};
}
struct EpiHs {
    unsigned char* Hs; const float* slot_w;
    __device__ __forceinline__ bool operator()(Acc& acc, const Unit& u, int wr, int wc, int fr, int fq) const {
        const int cw = u.pn * 128 + wc * 32 + 8 * (fq & ~1);
#pragma unroll
        for (int ai = 0; ai < 2; ++ai)
#pragma unroll
            for (int mp = 0; mp < 4; mp += 2) {
                unsigned q[2][2];
#pragma unroll
                for (int d = 0; d < 2; ++d) { const int m = mp + d; const float ws = 4.f / 4096.f;
                    f32x4 v0, v1;
#pragma unroll
                    for (int j = 0; j < 4; ++j) { const float g0 = acc[ai][0][m][0][j] * (1.f / 4096.f), g1 = acc[ai][0][m][1][j] * (1.f / 4096.f);
                        v0[j] = fminf(fmaxf(g0 * fsig(g0) * acc[ai][1][m][0][j] * ws, -448.f), 448.f); v1[j] = fminf(fmaxf(g1 * fsig(g1) * acc[ai][1][m][1][j] * ws, -448.f), 448.f); }
                    int q0 = 0, q1 = 0;
                    q0 = __builtin_amdgcn_cvt_pk_fp8_f32(v0[0], v0[1], q0, false); q0 = __builtin_amdgcn_cvt_pk_fp8_f32(v0[2], v0[3], q0, true);
                    q1 = __builtin_amdgcn_cvt_pk_fp8_f32(v1[0], v1[1], q1, false); q1 = __builtin_amdgcn_cvt_pk_fp8_f32(v1[2], v1[3], q1, true);
                    q[d][0] = (unsigned)q0; q[d][1] = (unsigned)q1; }
                const u32x4 w = widen16(q[0][0], q[0][1], q[1][0], q[1][1]);
                const int s = u.pm + ai * HALF + wr * 64 + (mp + (fq & 1)) * 16 + fr;
                if (s < u.aux) *(GAS u32x4*)(Hs + (size_t)s * 256 + cw) = w; }
        return false;
    }
};
struct EpiYs {
    unsigned char* Ys;
    __device__ __forceinline__ bool operator()(Acc& acc, const Unit& u, int wr, int wc, int fr, int fq) const {
        const int col0 = u.pn * BM + wc * 32 + 8 * (fq & ~1);
#pragma unroll
        for (int ai = 0; ai < 2; ++ai)
#pragma unroll
            for (int mp = 0; mp < 4; mp += 2) { const int s = u.pm + ai * HALF + wr * 64 + (mp + (fq & 1)) * 16 + fr;
#pragma unroll
                for (int bj = 0; bj < 2; ++bj) {
                    unsigned q[2][2];
#pragma unroll
                    for (int d = 0; d < 2; ++d) { f32x4 a0 = acc[ai][bj][mp + d][0] * (1.f / 64.f), a1 = acc[ai][bj][mp + d][1] * (1.f / 64.f);
#pragma unroll
                        for (int j = 0; j < 4; ++j) { a0[j] = fminf(fmaxf(a0[j], -400.f), 400.f); a1[j] = fminf(fmaxf(a1[j], -400.f), 400.f); }
                        int q0 = 0, q1 = 0;
                        q0 = __builtin_amdgcn_cvt_pk_fp8_f32(a0[0], a0[1], q0, false); q0 = __builtin_amdgcn_cvt_pk_fp8_f32(a0[2], a0[3], q0, true);
                        q1 = __builtin_amdgcn_cvt_pk_fp8_f32(a1[0], a1[1], q1, false); q1 = __builtin_amdgcn_cvt_pk_fp8_f32(a1[2], a1[3], q1, true);
                        q[d][0] = (unsigned)q0; q[d][1] = (unsigned)q1; }
                    const u32x4 w = widen16(q[0][0], q[0][1], q[1][0], q[1][1]);
                    if (s < u.aux) *(GAS u32x4*)(Ys + (size_t)s * DM + col0 + bj * HALF) = w; } }
        return false;
    }
};
}

__device__ __forceinline__ void xpose64(const float* src, size_t ldsrc, bf16_t* drow, size_t K) {
#pragma unroll 1
    for (int hh = 0; hh < 2; ++hh) {
        float4 v[32];
#pragma unroll
        for (int j = 0; j < 32; ++j) v[j] = *(const float4*)(src + (size_t)(hh * 32 + j) * ldsrc);
#pragma unroll
        for (int q = 0; q < 4; ++q) { pg8::u32x4 o;
            o.x = pg8::cvt_pk_bf16(v[8 * q + 0].x, v[8 * q + 1].x); o.y = pg8::cvt_pk_bf16(v[8 * q + 2].x, v[8 * q + 3].x); o.z = pg8::cvt_pk_bf16(v[8 * q + 4].x, v[8 * q + 5].x); o.w = pg8::cvt_pk_bf16(v[8 * q + 6].x, v[8 * q + 7].x);
            *(GAS pg8::u32x4*)(drow + hh * 32 + q * 8) = o; }
#pragma unroll
        for (int q = 0; q < 4; ++q) { pg8::u32x4 o;
            o.x = pg8::cvt_pk_bf16(v[8 * q + 0].y, v[8 * q + 1].y); o.y = pg8::cvt_pk_bf16(v[8 * q + 2].y, v[8 * q + 3].y); o.z = pg8::cvt_pk_bf16(v[8 * q + 4].y, v[8 * q + 5].y); o.w = pg8::cvt_pk_bf16(v[8 * q + 6].y, v[8 * q + 7].y);
            *(GAS pg8::u32x4*)(drow + K + hh * 32 + q * 8) = o; }
#pragma unroll
        for (int q = 0; q < 4; ++q) { pg8::u32x4 o;
            o.x = pg8::cvt_pk_bf16(v[8 * q + 0].z, v[8 * q + 1].z); o.y = pg8::cvt_pk_bf16(v[8 * q + 2].z, v[8 * q + 3].z); o.z = pg8::cvt_pk_bf16(v[8 * q + 4].z, v[8 * q + 5].z); o.w = pg8::cvt_pk_bf16(v[8 * q + 6].z, v[8 * q + 7].z);
            *(GAS pg8::u32x4*)(drow + 2 * K + hh * 32 + q * 8) = o; }
#pragma unroll
        for (int q = 0; q < 4; ++q) { pg8::u32x4 o;
            o.x = pg8::cvt_pk_bf16(v[8 * q + 0].w, v[8 * q + 1].w); o.y = pg8::cvt_pk_bf16(v[8 * q + 2].w, v[8 * q + 3].w); o.z = pg8::cvt_pk_bf16(v[8 * q + 4].w, v[8 * q + 5].w); o.w = pg8::cvt_pk_bf16(v[8 * q + 6].w, v[8 * q + 7].w);
            *(GAS pg8::u32x4*)(drow + 3 * K + hh * 32 + q * 8) = o; }
    }
}
__device__ __forceinline__ void phase_wprep(const Params& p, int part, float* lds) {
    int tid_ = threadIdx.x; asm volatile("" : "+v"(tid_));
    const int wid = tid_ >> 6, lane = tid_ & 63;
    const int gw = blockIdx.x * 8 + wid, ngw = gridDim.x * 8;
    {
        const int gtid = blockIdx.x * NTHR + tid_, gn = gridDim.x * NTHR;
        for (int i = gtid; i < 2 * 1024 * 2048 + 256 * 512; i += gn) {
            int ph; bool sn; bf16_t* dst;
            if (i < 2 * 1024 * 2048) { const int par = i >> 21, m = (i >> 11) & 1023, k = i & 2047, n = k & 1023; sn = k >= 1024; ph = ((2 * m + par) * n) & 2047; dst = (par ? p.Do : p.De) + (size_t)m * 2048 + k; }
            else { const int q = i - 2 * 1024 * 2048, kk = q >> 9, k = q & 511, n = k & 255; sn = k >= 256; ph = (8 * kk * n) & 2047; dst = p.Dc + q; }
            const float a = (float)ph * (1.f / 1024.f);
            *dst = f2bf(sn ? -sinpif(a) : cospif(a));
        }
    }
}

#define LDS_U(lds) ((PG8_LAS unsigned char*)(unsigned)__builtin_amdgcn_readfirstlane((unsigned)(unsigned long long)(PG8_LAS unsigned char*)(lds)))
__device__ __forceinline__ void phase_inproj_f(const Params& p, int l_, float* lds, bool deferred) {
    const int l = uni(l_);
    const int NC = l == 1 ? 23 : 24;
    pg8::EpiInproj E; E.O = uni(p.P); E.Gq = uni(p.Gq); E.PF = uni(p.PF);
    {
        pg8::TileOrder S;
        if (!deferred) S.init(l == 1 ? 64 * 256 : T_ALL, NC * 256, gridDim.x, blockIdx.x, 1);
        else { S.init(l == 1 ? 64 * 256 : T_ALL, (25 - NC) * 256, gridDim.x, (blockIdx.x + 128) & 255, 1); S.pn_off = NC; }
        S.skipctx = (l == 1);
        S.A0 = (const char*)uni(p.u8); S.B0 = (const char*)uni(p.Wt_in) + (size_t)l * PW * 1024; S.a_tile = (size_t)256 * 1024; S.b_tile = (size_t)256 * 1024; S.a_sub = 0; S.b_sub = 0;
        pg8::gemm_phase<false, true>(LDS_U(lds), 512, 512, 512, S, E);
    }
    if (l == 1 && !deferred) {
        pg8::CtxKVOrder S; S.G = gridDim.x; S.c = (blockIdx.x + 64) & 255;
        S.A0 = (const char*)uni(p.u8); S.B0 = (const char*)uni(p.Wt_in) + (size_t)l * PW * 1024; S.a_tile = (size_t)256 * 1024; S.b_tile = (size_t)256 * 1024;
        pg8::gemm_phase<false, true>(LDS_U(lds), 512, 512, 512, S, E);
    }
}
__device__ __forceinline__ void phase_ygemm_f(const Params& p, int l_, float* lds) {
    const int l = uni(l_);
    pg8::TileOrder S; S.init(l == 1 ? 64 * 256 : T_ALL, DM, gridDim.x, blockIdx.x, 3); S.skipctx = (l == 1);
    S.A0 = (const char*)uni(p.oa); S.a_sub = (size_t)T_ALL * 512 * 2;
    S.B0 = (const char*)uni(p.Wt_br) + (size_t)l * 3 * 1024 * 512; S.b_sub = (size_t)1024 * 512;
    S.a_tile = (size_t)256 * 512; S.b_tile = (size_t)256 * 512;
    pg8::EpiY E; E.Gq = uni(p.Gq); E.y = (unsigned char*)uni(p.y);
    pg8::gemm_phase<false, true>(LDS_U(lds), 256, 256, 256, S, E);
}
__device__ __forceinline__ void phase_outproj_f(const Params& p, int l_, float* lds) {
    const int l = uni(l_);
    pg8::TileOrder S; S.init(l == 1 ? 64 * 256 : T_ALL, DM, gridDim.x, blockIdx.x, 1); S.skipctx = (l == 1);
    S.A0 = (const char*)uni(p.y); S.B0 = (const char*)uni(p.Wt_out) + (size_t)l * 1024 * 1024; S.a_tile = (size_t)256 * 1024; S.b_tile = (size_t)256 * 1024; S.a_sub = 0; S.b_sub = 0;
    pg8::EpiZ E; E.hsrc_x = uni(p.x); E.hsrc_ctx = uni(p.ctx); E.hbuf = (const bf16_t*)uni(p.hbuf); E.mod2 = uni(p.mod) + (size_t)l * 9 * 6144 + 2 * 1024; E.z = (bf16_t*)uni(p.z); E.layer = l;
    pg8::gemm_phase<false, true>(LDS_U(lds), 512, 512, 512, S, E);
}
__device__ __forceinline__ void phase_router_shared_f(const Params& p, int l_, float* lds) {
    const int l = uni(l_);
    pg8::TileOrder S; S.init(l == 1 ? 64 * 256 : T_ALL, 768, gridDim.x, blockIdx.x, 1); S.skipctx = (l == 1);
    S.A0 = (const char*)uni(p.u); S.B0 = (const char*)(uni(p.Wt_g) + (size_t)l * 768 * 1024); S.a_tile = (size_t)256 * 1024 * 2; S.b_tile = (size_t)256 * 1024 * 2; S.a_sub = 0; S.b_sub = 0;
    pg8::EpiG E; E.logits = uni(p.logits); E.shact = uni(p.shact);
    pg8::gemm_phase(LDS_U(lds), 1024, 1024, 1024, S, E);
}
__device__ __forceinline__ void phase_shdown_f(const Params& p, int l_, float* lds) {
    const int l = uni(l_);
    pg8::TileOrder S; S.init(l == 1 ? 64 * 256 : T_ALL, DM, gridDim.x, blockIdx.x, 1); S.skipctx = (l == 1);
    S.A0 = (const char*)uni(p.shact); S.B0 = (const char*)(uni(p.Wt_sd) + (size_t)l * 1024 * 256); S.a_tile = (size_t)256 * 256 * 2; S.b_tile = (size_t)256 * 256 * 2; S.a_sub = 0; S.b_sub = 0;
    pg8::EpiStoreFp8 E; E.O = (unsigned char*)uni(p.f); E.ldc = DM; E.scale = 32.f;
    pg8::gemm_phase(LDS_U(lds), 256, 256, 256, S, E);
}

__device__ __noinline__ void phase_normrope(const Params& p, int l) {
    const int wid = threadIdx.x >> 6, lane = threadIdx.x & 63, li = lane & 7;
    float qg[8], kg[8];
#pragma unroll
    for (int j = 0; j < 8; ++j) { qg[j] = p.qn[l * 64 + li * 8 + j]; kg[j] = p.kn[l * 64 + li * 8 + j]; }
    const int tio = (li >> 2) * 16 + (li & 1) * 8;
    pg8::u32x4 raw[4], rawn[4]; float4 tb[4], tbn[4];
    auto load = [&](int r, pg8::u32x4 (&rw)[4], float4 (&t)[4]) {
        const int b = r / LTOT, j0 = r - b * LTOT; const int s = j0 >= CTXL ? j0 - CTXL : 0;
        t[0] = *(const float4*)(p.ropec + s * 32 + tio); t[1] = *(const float4*)(p.ropec + s * 32 + tio + 4); t[2] = *(const float4*)(p.ropes + s * 32 + tio); t[3] = *(const float4*)(p.ropes + s * 32 + tio + 4);
        const bf16_t* row = p.P + (size_t)r * PW;
        rw[0] = *(const pg8::u32x4*)(row + C_QA + lane * 8);
        rw[1] = lane < 16 ? *(const pg8::u32x4*)(row + C_KA + lane * 8) : (pg8::u32x4){0u, 0u, 0u, 0u};
        rw[2] = *(const pg8::u32x4*)(row + C_QC + lane * 8);
        rw[3] = *(const pg8::u32x4*)(row + C_KC + lane * 8); };
    const int stride = gridDim.x * 8;
    int r = blockIdx.x * 8 + wid;
    if (r < T_ALL) load(r, raw, tb);
    for (; r < T_ALL; r += stride) {
        if (r + stride < T_ALL) load(r + stride, rawn, tbn);
        const int b = r / LTOT, j0 = r - b * LTOT; const bool lat = j0 >= CTXL;
        float cs[8], sn[8];
        cs[0] = tb[0].x; cs[1] = tb[0].y; cs[2] = tb[0].z; cs[3] = tb[0].w; cs[4] = tb[1].x; cs[5] = tb[1].y; cs[6] = tb[1].z; cs[7] = tb[1].w;
        sn[0] = tb[2].x; sn[1] = tb[2].y; sn[2] = tb[2].z; sn[3] = tb[2].w; sn[4] = tb[3].x; sn[5] = tb[3].y; sn[6] = tb[3].z; sn[7] = tb[3].w;
        if (!lat) {
#pragma unroll
            for (int j = 0; j < 8; ++j) { cs[j] = 1.f; sn[j] = 0.f; } }
        bf16_t* row = p.P + (size_t)r * PW;
#pragma unroll
        for (int i = 0; i < 4; ++i) {
            float x[8]; pg8::unpack8(raw[i], x);
            if (i < 2) {
                float ss = 0.f;
#pragma unroll
                for (int j = 0; j < 8; ++j) ss += x[j] * x[j];
                ss += __shfl_xor(ss, 1); ss += __shfl_xor(ss, 2); ss += __shfl_xor(ss, 4);
                const float sc = rsqrtf(ss * (1.f / 64.f) + 1e-6f);
#pragma unroll
                for (int j = 0; j < 8; ++j) x[j] *= sc * (i == 0 ? qg[j] : kg[j]);
            }
            float y[8];
#pragma unroll
            for (int j = 0; j < 8; ++j) { const float pr = __shfl_xor(x[j], 2); const float rot = (li & 2) ? pr : -pr; y[j] = x[j] * cs[j] + rot * sn[j]; }
            pg8::u32x4 o; o.x = pg8::cvt_pk_bf16(y[0], y[1]); o.y = pg8::cvt_pk_bf16(y[2], y[3]); o.z = pg8::cvt_pk_bf16(y[4], y[5]); o.w = pg8::cvt_pk_bf16(y[6], y[7]);
            const int col = i == 0 ? C_QA : i == 1 ? C_KA : i == 2 ? C_QC : C_KC;
            if (i != 1 || lane < 16) *(pg8::u32x4*)(row + col + lane * 8) = o;
        }
#pragma unroll
        for (int i = 0; i < 4; ++i) { raw[i] = rawn[i]; tb[i] = tbn[i]; }
    }
}
__device__ __noinline__ void phase_xt(const Params& p, bool do_ctx, float* lds) {
    const int wid = threadIdx.x >> 6, lane = threadIdx.x & 63;
    bf16_t* te = (bf16_t*)lds + wid * (2 * 64 * 72);
    bf16_t* to = te + 64 * 72;
    __syncthreads();
    const int gw = blockIdx.x * 8 + wid, ngw = gridDim.x * 8;
    const int nlat = 8 * 2 * 8 * 16, nctx = do_ctx ? 8 * 2 * 8 * 4 : 0;
    for (int it = gw; it < nlat + nctx; it += ngw) {
        const bool lat = it < nlat; const int q = lat ? it : it - nlat;
        int b, wh, cb, nb;
        if (lat) { b = q >> 8; wh = (q >> 7) & 1; cb = (q >> 4) & 7; nb = q & 15; } else { b = q >> 6; wh = (q >> 5) & 1; cb = (q >> 2) & 7; nb = q & 3; }
        const int r8 = lane >> 3, c8 = (lane & 7) * 8;
#pragma unroll
        for (int i = 0; i < 8; ++i) {
            const int n = nb * 64 + i * 8 + r8;
            const size_t row = (size_t)b * LTOT + (lat ? CTXL + n : n);
            const unsigned char* src = p.PF + row * 1024 + wh * 512 + cb * 64 + c8;
            float x0[8], x1[8];
            typedef float f32x2x __attribute__((ext_vector_type(2)));
            { const pg8::u32x2f w0 = *(const GAS pg8::u32x2f*)src, w1 = lat ? *(const GAS pg8::u32x2f*)(src + (size_t)1024 * 1024) : w0;
#pragma unroll
              for (int h = 0; h < 2; ++h) { const int a = (int)(h ? w0.y : w0.x), bq = (int)(h ? w1.y : w1.x);
                  const f32x2x a0 = __builtin_amdgcn_cvt_pk_f32_fp8(a, false), a1 = __builtin_amdgcn_cvt_pk_f32_fp8(a, true), b0 = __builtin_amdgcn_cvt_pk_f32_fp8(bq, false), b1 = __builtin_amdgcn_cvt_pk_f32_fp8(bq, true);
                  x0[4 * h] = a0[0] * 0.25f; x0[4 * h + 1] = a0[1] * 0.25f; x0[4 * h + 2] = a1[0] * 0.25f; x0[4 * h + 3] = a1[1] * 0.25f;
                  x1[4 * h] = b0[0] * 0.25f; x1[4 * h + 1] = b0[1] * 0.25f; x1[4 * h + 2] = b1[0] * 0.25f; x1[4 * h + 3] = b1[1] * 0.25f; } }
#pragma unroll
            for (int j = 0; j < 8; ++j) { te[(c8 + j) * 72 + i * 8 + r8] = f2bf(lat ? x0[j] + x1[j] : x0[j]); if (lat) to[(c8 + j) * 72 + i * 8 + r8] = f2bf(x0[j] - x1[j]); }
        }
        asm volatile("s_waitcnt lgkmcnt(0)" ::: "memory");
#pragma unroll
        for (int i = 0; i < 8; ++i) {
            const int cc = i * 8 + r8;
            const size_t xr = (size_t)b * 512 + cb * 64 + cc;
            if (lat) {
                *(GAS pg8::u32x4*)(p.XTe + xr * 2048 + wh * 1024 + nb * 64 + c8) = *(const pg8::u32x4*)(te + cc * 72 + c8);
                *(GAS pg8::u32x4*)(p.XTo + xr * 2048 + wh * 1024 + nb * 64 + c8) = *(const pg8::u32x4*)(to + cc * 72 + c8);
            } else *(GAS pg8::u32x4*)(p.XTc + xr * 512 + wh * 256 + nb * 64 + c8) = *(const pg8::u32x4*)(te + cc * 72 + c8);
        }
        asm volatile("s_waitcnt lgkmcnt(0)" ::: "memory");
    }
    for (int it = gw; it < 8 * 10 * 36; it += ngw) {
        const int b = it / 360, r = it - b * 360, cb = r / 36, kb = r - cb * 36;
        const int scol = cb < 2 ? C_VA + cb * 64 : C_VC + (cb - 2) * 64;
        bf16_t* dst = cb < 2 ? p.VTa + ((size_t)b * 128 + cb * 64) * LTOT : p.VTc + ((size_t)b * 512 + (cb - 2) * 64) * LTOT;
        const int r8 = lane >> 3, c8 = (lane & 7) * 8;
#pragma unroll
        for (int i = 0; i < 8; ++i) {
            const bf16_t* s = p.P + ((size_t)b * LTOT + kb * 64 + i * 8 + r8) * PW + scol + c8;
            const pg8::u32x4 w = *(const pg8::u32x4*)s;
            const unsigned ww[4] = {w.x, w.y, w.z, w.w};
#pragma unroll
            for (int j = 0; j < 8; ++j) te[(c8 + j) * 72 + i * 8 + r8] = (bf16_t)(ww[j >> 1] >> ((j & 1) * 16));
        }
        asm volatile("s_waitcnt lgkmcnt(0)" ::: "memory");
#pragma unroll
        for (int i = 0; i < 8; ++i) { const int cc = i * 8 + r8;
            *(GAS pg8::u32x4*)(dst + (size_t)cc * LTOT + kb * 64 + c8) = *(const pg8::u32x4*)(te + cc * 72 + c8); }
        asm volatile("s_waitcnt lgkmcnt(0)" ::: "memory");
    }
}
namespace pg8 {
struct FoOrder {
    const char *De, *Do, *XTe, *XTo; int nun, G, c; bool ctx;
    __device__ __forceinline__ unsigned row_off(const Unit&, int) const { return 0u; }
    __device__ __forceinline__ bool next(int i, Unit& u) const {
        const int uid = i * G + c; if (uid >= nun) return false;
        u.pm = ctx ? 0 : uid >> 4; u.pn = uid & 15; u.aux = 0;
        const size_t kb = ctx ? 512 * 2 : 2048 * 2;
        u.a = (u.pm < 4 ? De + (size_t)u.pm * 256 * kb : Do + (size_t)(u.pm - 4) * 256 * kb);
        u.b = (u.pm < 4 ? XTe : XTo) + (size_t)u.pn * 256 * kb;
        return true;
    }
};
struct EpiFo {
    unsigned char* ob; float scale; bool ctx;
    __device__ __forceinline__ bool operator()(Acc& acc, const Unit& u, int wr, int wc, int fr, int fq) const {
        const int b = u.pn >> 1, col0 = (u.pn & 1) * 256 + wc * 32 + 8 * fq;
        const int par = u.pm >> 2, m0 = (u.pm & 3) * 256;
#pragma unroll
        for (int ai = 0; ai < 2; ++ai)
#pragma unroll
            for (int m = 0; m < 4; ++m) { const int rl = ai * HALF + wr * 64 + m * 16 + fr;
                const size_t row = (size_t)b * LTOT + (ctx ? rl : CTXL + 2 * (m0 + rl) + par);
#pragma unroll
                for (int bj = 0; bj < 2; ++bj) *(GAS u32x2f*)(ob + row * 512 + col0 + bj * HALF) = pack8_fp8(acc[ai][bj][m][0], acc[ai][bj][m][1], scale * 16.f); }
        return false;
    }
};
}
__device__ __forceinline__ void phase_fourier_f(const Params& p, bool do_ctx, float* lds) {
    {
        pg8::FoOrder S; S.De = (const char*)uni(p.De); S.Do = (const char*)uni(p.Do); S.XTe = (const char*)uni(p.XTe); S.XTo = (const char*)uni(p.XTo); S.nun = 128; S.G = gridDim.x; S.c = blockIdx.x; S.ctx = false;
        pg8::EpiFo E; E.ob = (unsigned char*)uni(p.ob); E.scale = 1.f / 512.f; E.ctx = false;
        pg8::gemm_phase<false>(LDS_U(lds), 2048, 2048, 2048, S, E);
    }
    if (do_ctx) {
        pg8::FoOrder S; S.De = (const char*)uni(p.Dc); S.Do = S.De; S.XTe = (const char*)uni(p.XTc); S.XTo = S.XTe; S.nun = 16; S.G = gridDim.x; S.c = (blockIdx.x + 56) & 255; S.ctx = true;
        pg8::EpiFo E; E.ob = (unsigned char*)uni(p.ob); E.scale = 0.00552427172802f; E.ctx = true;
        pg8::gemm_phase<false>(LDS_U(lds), 512, 512, 512, S, E);
    }
}

namespace fa {
typedef short bf16x8 __attribute__((ext_vector_type(8)));
typedef short bf16x4 __attribute__((ext_vector_type(4)));
typedef float f32x16 __attribute__((ext_vector_type(16)));
typedef unsigned u32x2 __attribute__((ext_vector_type(2)));
typedef float f32x2 __attribute__((ext_vector_type(2)));
#define FA_KROW 144
#define FA_VROW 136
#define FA_C 0.18033688011f
template <int DV>
__device__ __forceinline__ void attn_unit_f(const Params& p, const int l, const int b, const int head, const int qblk, const bool ctxq, LAS unsigned char* lds, int tid) {
    constexpr int NK = DV == 64 ? 1 : 2, NDT = DV / 32, BUFSZ = NK * 64 * FA_KROW + DV * FA_VROW, NCH = DV == 64 ? 1 : 2;
    const int wid = __builtin_amdgcn_readfirstlane(tid >> 6), lane = tid & 63, lq = lane & 31, lh = lane >> 5;
    const int nt = ctxq ? 4 : 36;
    const bf16_t* P = uni(p.P);
    const size_t rowb = (size_t)b * LTOT;
    int tok0, qcol, kmap;
    if (DV == 64) { tok0 = qblk * 64 + (wid & 1) * 32; qcol = C_QA + (head * 4 + (wid >> 1)) * 64; kmap = 0; }
    else { tok0 = qblk * 128 + (wid & 3) * 32; qcol = C_QC + head * 128 + (wid >> 2) * 64; kmap = wid >> 2; }
    const size_t qrow = rowb + (ctxq ? 0 : CTXL) + tok0 + lq;
    bf16x8 Q[4];
#pragma unroll
    for (int ks = 0; ks < 4; ++ks) Q[ks] = *(const GAS bf16x8*)(P + qrow * PW + qcol + ks * 16 + 8 * lh);
    const bf16_t* ksrc[NCH]; const bf16_t* vsrc[NCH]; int kdst[NCH], vdst[NCH];
#pragma unroll
    for (int i = 0; i < NCH; ++i) {
        const int c = tid + i * NTHR, mm = c >> 9, key = (c >> 3) & 63, piece = c & 7;
        ksrc[i] = P + (rowb + key) * PW + (DV == 64 ? C_KA + head * 64 : C_KC + head * 128 + mm * 64) + piece * 8;
        kdst[i] = mm * 64 * FA_KROW + key * FA_KROW + piece * 16;
        const int d = c >> 3;
        vsrc[i] = (DV == 64 ? uni(p.VTa) + ((size_t)(b * 2 + head) * 64 + d) * LTOT : uni(p.VTc) + ((size_t)(b * 4 + head) * 128 + d) * LTOT) + piece * 8;
        vdst[i] = NK * 64 * FA_KROW + d * FA_VROW + piece * 16;
    }
    pg8::u32x4 kreg[NCH], vreg[NCH];
#define FA_LOAD(t) do { _Pragma("unroll") for (int _i = 0; _i < NCH; ++_i) { kreg[_i] = *(const GAS pg8::u32x4*)(ksrc[_i] + (size_t)(t) * 64 * PW); vreg[_i] = *(const GAS pg8::u32x4*)(vsrc[_i] + (t) * 64); } } while (0)
#define FA_WRITE(bufo) do { _Pragma("unroll") for (int _i = 0; _i < NCH; ++_i) { *(LAS pg8::u32x4*)(lds + (bufo) + kdst[_i]) = kreg[_i]; \
        *(LAS u32x2*)(lds + (bufo) + vdst[_i]) = (u32x2){vreg[_i].x, vreg[_i].y}; *(LAS u32x2*)(lds + (bufo) + vdst[_i] + 8) = (u32x2){vreg[_i].z, vreg[_i].w}; } } while (0)
    f32x16 O[NDT];
#pragma unroll
    for (int dt = 0; dt < NDT; ++dt)
#pragma unroll
        for (int i = 0; i < 16; ++i) O[dt][i] = 0.f;
    float mrow = -1.0e30f, lrow = 0.f;
    __syncthreads();
    FA_LOAD(0); FA_WRITE(0); FA_LOAD(1); FA_WRITE(BUFSZ); FA_LOAD(2);
    const int koff = kmap * 64 * FA_KROW + lq * FA_KROW + 16 * lh;
    const int voff = NK * 64 * FA_KROW + lq * FA_VROW + 8 * lh;
    f32x16 S0, S1;
    constexpr bool HOISTK = (DV == 64);
    bf16x8 kf[8];
#define FA_KREAD(bufo) do { _Pragma("unroll") for (int ks = 0; ks < 4; ++ks) { kf[2 * ks] = *(const LAS bf16x8*)(lds + (bufo) + koff + ks * 32); kf[2 * ks + 1] = *(const LAS bf16x8*)(lds + (bufo) + koff + ks * 32 + 32 * FA_KROW); } } while (0)
#define FA_QK(A0, A1) do { _Pragma("unroll") for (int i = 0; i < 16; ++i) { A0[i] = 0.f; A1[i] = 0.f; } __builtin_amdgcn_s_setprio(1); \
        _Pragma("unroll") for (int ks = 0; ks < 4; ++ks) { \
            A0 = __builtin_amdgcn_mfma_f32_32x32x16_bf16(kf[2 * ks], Q[ks], A0, 0, 0, 0); \
            A1 = __builtin_amdgcn_mfma_f32_32x32x16_bf16(kf[2 * ks + 1], Q[ks], A1, 0, 0, 0); } __builtin_amdgcn_s_setprio(0); } while (0)
    __syncthreads();
    FA_KREAD(0); FA_QK(S0, S1);
    int bcur = 0, bnx1 = BUFSZ, bnx2 = 2 * BUFSZ;
#pragma unroll 1
    for (int t = 0; t < nt; ++t) {
        __syncthreads();
        if (t + 2 < nt) FA_WRITE(bnx2);
        if (t + 3 < nt) FA_LOAD(t + 3);
        if (HOISTK && t + 1 < nt) FA_KREAD(bnx1);
        constexpr int NVF = DV == 64 ? 4 : 0;
        pg8::u32x4 vf[NVF > 0 ? NVF : 1][2];
#pragma unroll
        for (int q4 = 0; q4 < NVF; ++q4)
#pragma unroll
            for (int dt = 0; dt < 2; ++dt) { const int a = bcur + voff + dt * 32 * FA_VROW + q4 * 32;
                const u32x2 lo = *(const LAS u32x2*)(lds + a), hi = *(const LAS u32x2*)(lds + a + 16); vf[q4][dt] = (pg8::u32x4){lo.x, lo.y, hi.x, hi.y}; }
        f32x16 N0, N1;
        if (t + 1 < nt) { if (!HOISTK) FA_KREAD(bnx1); FA_QK(N0, N1); }
        float mx;
        { float m8[8];
#pragma unroll
          for (int i = 0; i < 8; ++i) asm("v_max3_f32 %0, %1, %2, %3" : "=v"(m8[i]) : "v"(S0[2 * i]), "v"(S0[2 * i + 1]), "v"(S1[2 * i]));
#pragma unroll
          for (int i = 0; i < 4; ++i) asm("v_max3_f32 %0, %1, %2, %3" : "=v"(m8[i]) : "v"(m8[i]), "v"(S1[4 * i + 1]), "v"(S1[4 * i + 3]));
          float a, b, c, d;
          asm("v_max3_f32 %0, %1, %2, %3" : "=v"(a) : "v"(m8[0]), "v"(m8[1]), "v"(m8[2]));
          asm("v_max3_f32 %0, %1, %2, %3" : "=v"(b) : "v"(m8[3]), "v"(m8[4]), "v"(m8[5]));
          asm("v_max3_f32 %0, %1, %2, %3" : "=v"(c) : "v"(m8[6]), "v"(m8[7]), "v"(a));
          asm("v_max3_f32 %0, %1, %2, %3" : "=v"(d) : "v"(b), "v"(c), "v"(mrow));
          mx = d; }
        float mnew; { const auto sw = __builtin_amdgcn_permlane32_swap(__float_as_uint(mx), __float_as_uint(mx), false, false); mnew = fmaxf(__uint_as_float(sw[0]), __uint_as_float(sw[1])); }
        if (__builtin_amdgcn_ballot_w64(mnew > mrow) != 0ull) {
            const float alpha = __builtin_amdgcn_exp2f((mrow - mnew) * FA_C);
            lrow *= alpha;
#pragma unroll
            for (int dt = 0; dt < NDT; ++dt)
#pragma unroll
                for (int i = 0; i < 16; ++i) O[dt][i] *= alpha;
            mrow = mnew;
        }
        const float mc = mrow * FA_C;
        f32x2 rs2 = {0.f, 0.f};
#pragma unroll
        for (int i = 0; i < 8; ++i) {
            f32x2 e0 = {S0[2 * i], S0[2 * i + 1]}, e1 = {S1[2 * i], S1[2 * i + 1]};
            e0 = e0 * FA_C - mc; e1 = e1 * FA_C - mc;
            e0.x = __builtin_amdgcn_exp2f(e0.x); e0.y = __builtin_amdgcn_exp2f(e0.y); e1.x = __builtin_amdgcn_exp2f(e1.x); e1.y = __builtin_amdgcn_exp2f(e1.y);
            S0[2 * i] = e0.x; S0[2 * i + 1] = e0.y; S1[2 * i] = e1.x; S1[2 * i + 1] = e1.y;
            rs2 += e0 + e1;
        }
        lrow += rs2.x + rs2.y;
#pragma unroll
        for (int kh = 0; kh < 2; ++kh)
#pragma unroll
            for (int s2 = 0; s2 < 2; ++s2) {
                pg8::u32x4 pw;
                if (kh == 0) { pw.x = pg8::cvt_pk_bf16(S0[8 * s2], S0[8 * s2 + 1]); pw.y = pg8::cvt_pk_bf16(S0[8 * s2 + 2], S0[8 * s2 + 3]); pw.z = pg8::cvt_pk_bf16(S0[8 * s2 + 4], S0[8 * s2 + 5]); pw.w = pg8::cvt_pk_bf16(S0[8 * s2 + 6], S0[8 * s2 + 7]); }
                else { pw.x = pg8::cvt_pk_bf16(S1[8 * s2], S1[8 * s2 + 1]); pw.y = pg8::cvt_pk_bf16(S1[8 * s2 + 2], S1[8 * s2 + 3]); pw.z = pg8::cvt_pk_bf16(S1[8 * s2 + 4], S1[8 * s2 + 5]); pw.w = pg8::cvt_pk_bf16(S1[8 * s2 + 6], S1[8 * s2 + 7]); }
                const bf16x8 pf = __builtin_bit_cast(bf16x8, pw);
#pragma unroll
                for (int dt = 0; dt < NDT; ++dt) {
                    pg8::u32x4 vw;
                    if (dt < 2 && kh * 2 + s2 < NVF) vw = vf[kh * 2 + s2 < NVF ? kh * 2 + s2 : 0][dt];
                    else { const int a = bcur + voff + dt * 32 * FA_VROW + (kh * 32 + 16 * s2) * 2;
                        const u32x2 lo = *(const LAS u32x2*)(lds + a), hi = *(const LAS u32x2*)(lds + a + 16); vw = (pg8::u32x4){lo.x, lo.y, hi.x, hi.y}; }
                    O[dt] = __builtin_amdgcn_mfma_f32_32x32x16_bf16(__builtin_bit_cast(bf16x8, vw), pf, O[dt], 0, 0, 0);
                }
            }
        S0 = N0; S1 = N1;
        { const int tmp = bcur; bcur = bnx1; bnx1 = bnx2; bnx2 = tmp; }
    }
#undef FA_QK
#undef FA_KREAD
    { const auto sw = __builtin_amdgcn_permlane32_swap(__float_as_uint(lrow), __float_as_uint(lrow), false, false); lrow = __uint_as_float(sw[0]) + __uint_as_float(sw[1]); }
    const float inv = 1.f / lrow;
    const size_t orow = rowb + (ctxq ? 0 : CTXL) + tok0 + lq;
    if (DV == 64) {
        unsigned char* o = (unsigned char*)uni(p.oa) + orow * 512 + (head * 4 + (wid >> 1)) * 64 + 4 * lh;
        const float i16 = inv * 16.f;
#pragma unroll
        for (int dt = 0; dt < NDT; ++dt)
#pragma unroll
            for (int g4 = 0; g4 < 4; ++g4) { int q = 0;
                q = __builtin_amdgcn_cvt_pk_fp8_f32(fminf(fmaxf(O[dt][4 * g4] * i16, -448.f), 448.f), fminf(fmaxf(O[dt][4 * g4 + 1] * i16, -448.f), 448.f), q, false);
                q = __builtin_amdgcn_cvt_pk_fp8_f32(fminf(fmaxf(O[dt][4 * g4 + 2] * i16, -448.f), 448.f), fminf(fmaxf(O[dt][4 * g4 + 3] * i16, -448.f), 448.f), q, true);
                *(GAS int*)(o + dt * 32 + 8 * g4) = q; }
    } else {
        __syncthreads();
        LAS float* xch = (LAS float*)lds + (wid & 3) * (64 * 64) + lane;
        if (wid >= 4) {
#pragma unroll
            for (int dt = 0; dt < NDT; ++dt)
#pragma unroll
                for (int i = 0; i < 16; ++i) xch[(dt * 16 + i) * 64] = O[dt][i] * inv;
        }
        __syncthreads();
        if (wid < 4) {
            const float lam = uni(p.lam)[l];
            float ss = 0.f;
#pragma unroll
            for (int dt = 0; dt < NDT; ++dt)
#pragma unroll
                for (int i = 0; i < 16; ++i) { const float v = O[dt][i] * inv - lam * xch[(dt * 16 + i) * 64]; O[dt][i] = v; ss += v * v; }
            { const auto sw = __builtin_amdgcn_permlane32_swap(__float_as_uint(ss), __float_as_uint(ss), false, false); ss = __uint_as_float(sw[0]) + __uint_as_float(sw[1]); }
            const float sc = rsqrtf(ss * (1.f / 128.f) + 1e-6f) * (1.f - lam_init_of(l)) * 16.f;
            const float* gsub = uni(p.subln) + l * 128 + 4 * lh;
            unsigned char* o = (unsigned char*)uni(p.oc) + orow * 512 + head * 128 + 4 * lh;
#pragma unroll
            for (int dt = 0; dt < NDT; ++dt)
#pragma unroll
                for (int g4 = 0; g4 < 4; ++g4) { const pg8::f32x4 g = *(const GAS pg8::f32x4*)(gsub + dt * 32 + 8 * g4);
                    int q = 0;
                    q = __builtin_amdgcn_cvt_pk_fp8_f32(fminf(fmaxf(O[dt][4 * g4] * sc * g.x, -448.f), 448.f), fminf(fmaxf(O[dt][4 * g4 + 1] * sc * g.y, -448.f), 448.f), q, false);
                    q = __builtin_amdgcn_cvt_pk_fp8_f32(fminf(fmaxf(O[dt][4 * g4 + 2] * sc * g.z, -448.f), 448.f), fminf(fmaxf(O[dt][4 * g4 + 3] * sc * g.w, -448.f), 448.f), q, true);
                    *(GAS int*)(o + dt * 32 + 8 * g4) = q; }
        }
    }
#undef FA_LOAD
#undef FA_WRITE
}
}
__device__ __noinline__ void phase_conv_dma(const Params& p, int mode, int l, int t_begin, int ntiles, int t_step, float* ldsf);
__device__ __noinline__ void phase_conv_ring(const Params& p, int l, int chunk, float* ldsf, unsigned* ctr);
__device__ __forceinline__ void phase_attn_f(const Params& p, int l_, bool do_ctx, unsigned char* smem, float* ldsf) {
    const int l = uni(l_);
    LAS unsigned char* lds = LDS_U(ldsf);
    unsigned* ctr = uni(p.actr) + l * 32 + (blockIdx.x & 7);
    volatile LAS unsigned* slot = (volatile LAS unsigned*)smem + 8;
    const int NA = do_ctx ? 144 : 128;
    const int LIM = l == 0 ? CONV_LIM0 : 384;
    bool have_next = false;
    for (;;) {
        int tid = threadIdx.x; asm volatile("" : "+v"(tid));
        __syncthreads();
        if (tid == 0) { const unsigned k = have_next ? *(volatile LAS unsigned*)36 : atomicAdd(ctr, 1u), q = blockIdx.x & 7; unsigned item;
            int a = -1, j = -1;
            const int G2 = NA < LIM / 2 ? NA : LIM / 2;
            if (k < 3u * G2) { const int g = (int)(k / 3u), r = (int)(k - 3u * (unsigned)g); if (r == 0) a = g; else j = 2 * g + (r - 1); }
            else { const int k2 = (int)(k - 3u * G2); if (k2 < NA - G2) a = G2 + k2; else j = 2 * G2 + (k2 - (NA - G2)); }
            if (a >= 0) item = a < 64 ? q * 64 + a : a < 128 ? 512 + q * 64 + (a - 64) : a < 136 ? 1024 + q * 8 + (a - 128) : 1088 + q * 8 + (a - 136);
            else item = j < LIM ? (0x10000u | (q * 384 + (unsigned)j)) : 0xFFFFFFFFu;
            *slot = item; }
        __syncthreads();
        const unsigned us = (unsigned)__builtin_amdgcn_readfirstlane((int)*slot);
        if (us == 0xFFFFFFFFu) break;
        if (us & 0x10000u) { const int ch = (int)(us & 0xFFFFu); phase_conv_ring(p, l, ch, ldsf, ctr); have_next = true; continue; }
        have_next = false;
        const int u = (int)us;
        if (u < 512) fa::attn_unit_f<128>(p, l, u >> 6, (u >> 4) & 3, u & 15, false, lds, tid);
        else if (u < 1024) { const int v = u - 512; fa::attn_unit_f<64>(p, l, v >> 6, (v >> 5) & 1, v & 31, false, lds, tid); }
        else if (u < 1088) { const int v = u - 1024; fa::attn_unit_f<128>(p, l, v >> 3, (v >> 1) & 3, v & 1, true, lds, tid); }
        else { const int v = u - 1088; fa::attn_unit_f<64>(p, l, v >> 3, (v >> 2) & 1, v & 3, true, lds, tid); }
    }
}

__device__ __forceinline__ void conv_fill(const Params& p, int l, int lim, int maxchunks, float* ldsf) {
    unsigned* ctr2 = uni(p.actr) + l * 32 + 8 + (blockIdx.x & 7);
    volatile LAS unsigned* slot = (volatile LAS unsigned*)32;
    for (int c = 0; c < maxchunks; ++c) {
        int tid = threadIdx.x; asm volatile("" : "+v"(tid));
        __syncthreads();
        if (tid == 0) *slot = atomicAdd(ctr2, 1u);
        __syncthreads();
        const int j = lim + __builtin_amdgcn_readfirstlane((int)*slot);
        if (j >= 384) break;
        const int ch = (blockIdx.x & 7) * 384 + j;
        phase_conv_ring(p, l, ch, ldsf, nullptr);
    }
}
__device__ __forceinline__ void xpose64x2(const float* src, size_t ldsrc, bf16_t* drow, size_t K) {
    typedef float f2v __attribute__((ext_vector_type(2)));
    f2v v[64];
#pragma unroll
    for (int j = 0; j < 64; ++j) v[j] = __builtin_nontemporal_load((const f2v*)(src + (size_t)j * ldsrc));
#pragma unroll
    for (int q = 0; q < 8; ++q) { pg8::u32x4 o;
        o.x = pg8::cvt_pk_bf16(v[8 * q + 0].x, v[8 * q + 1].x); o.y = pg8::cvt_pk_bf16(v[8 * q + 2].x, v[8 * q + 3].x); o.z = pg8::cvt_pk_bf16(v[8 * q + 4].x, v[8 * q + 5].x); o.w = pg8::cvt_pk_bf16(v[8 * q + 6].x, v[8 * q + 7].x);
        *(pg8::u32x4*)(drow + q * 8) = o; }
#pragma unroll
    for (int q = 0; q < 8; ++q) { pg8::u32x4 o;
        o.x = pg8::cvt_pk_bf16(v[8 * q + 0].y, v[8 * q + 1].y); o.y = pg8::cvt_pk_bf16(v[8 * q + 2].y, v[8 * q + 3].y); o.z = pg8::cvt_pk_bf16(v[8 * q + 4].y, v[8 * q + 5].y); o.w = pg8::cvt_pk_bf16(v[8 * q + 6].y, v[8 * q + 7].y);
        *(pg8::u32x4*)(drow + K + q * 8) = o; }
}
__device__ __forceinline__ void phase_econv(const Params& p, int l, float* lds) {
    int tid_ = threadIdx.x; asm volatile("" : "+v"(tid_));
    const int wid = tid_ >> 6, lane = tid_ & 63;
    const int gw = blockIdx.x * 8 + wid, ngw = gridDim.x * 8;
    for (int it = gw; it < 256 * 96; it += ngw) {
        const int e = it / 96, r = it - e * 96;
        if (r < 64) { const int m = r >> 5, nb = (r >> 4) & 1, kb = r & 15, n = nb * 128 + lane * 2;
            const float* w = (m ? p.eu : p.eg) + ((size_t)l * 256 + e) * 1024 * 256;
            const int row = nb * 256 + m * 128 + lane * 2;
            xpose64x2(w + (size_t)kb * 64 * 256 + n, 256, p.Wt_e1 + (size_t)e * 512 * 1024 + (size_t)row * 1024 + kb * 64, 1024);
        } else { const int q = r - 64, nb = q >> 2, kb = q & 3, n = nb * 128 + lane * 2;
            xpose64x2(p.ed + ((size_t)l * 256 + e) * 256 * 1024 + (size_t)kb * 64 * 1024 + n, 1024, p.Wt_e2 + (size_t)e * 1024 * 256 + (size_t)n * 256 + kb * 64, 256); }
    }
}
struct ConvTile { const float* src; size_t rs; bf16_t* dst; bool skip; float f8; };
__device__ __forceinline__ ConvTile conv_tile(const Params& p, int mode, int l, int tile, int n) {
    ConvTile c; c.skip = false; c.f8 = 0.f;
    if (mode == 0) {
        const int e = tile / 48, r = tile - e * 48;
        if (r < 32) { const int m = r >> 4, kb = r & 15; c.src = (m ? p.eu : p.eg) + ((size_t)l * 256 + e) * 1024 * 256 + (size_t)kb * 64 * 256; c.rs = 256;
            c.dst = p.Wt_e1 + (size_t)e * 512 * 1024 + (size_t)((n >> 7) * 256 + m * 128 + (n & 127)) * 1024 + kb * 64; }
        else { const int q = r - 32, nb = q >> 2, kb = q & 3; c.src = p.ed + ((size_t)l * 256 + e) * 256 * 1024 + (size_t)kb * 64 * 1024 + nb * 256; c.rs = 1024;
            c.dst = p.Wt_e2 + (size_t)e * 1024 * 256 + (size_t)(nb * 256 + n) * 256 + kb * 64; }
    } else if (mode == 1) {
        const int ll = tile / 592; int r = tile - ll * 592;
        if (r < 368) { const int nb = r >> 4, kb = r & 15, ns = nb * 256 + n;
            c.skip = (nb == 3 || nb == 4);
            c.src = p.w_in + (size_t)ll * 1024 * IN_W + (size_t)kb * 64 * IN_W + nb * 256; c.rs = IN_W;
            c.dst = (bf16_t*)((unsigned char*)p.Wt_in + (size_t)ll * PW * 1024 + (size_t)(ns < 768 ? ns : ns + 512) * 1024 + kb * 64); c.f8 = 256.f; }
        else if (r < 368 + 96) { const int q = r - 368, br = q >> 5, nb = (q >> 3) & 3, kb = q & 7;
            c.src = (br == 0 ? p.wa : br == 1 ? p.wb : p.wc) + (size_t)ll * 512 * 1024 + (size_t)kb * 64 * 1024 + nb * 256; c.rs = 1024;
            c.dst = (bf16_t*)((unsigned char*)p.Wt_br + ((size_t)ll * 3 + br) * 1024 * 512 + (size_t)(nb * 256 + n) * 512 + kb * 64); c.f8 = 256.f; }
        else if (r < 368 + 96 + 64) { const int q = r - 464, nb = q >> 4, kb = q & 15;
            c.src = p.wout + (size_t)ll * 1024 * 1024 + (size_t)kb * 64 * 1024 + nb * 256; c.rs = 1024;
            c.dst = (bf16_t*)((unsigned char*)p.Wt_out + (size_t)ll * 1024 * 1024 + (size_t)(nb * 256 + n) * 1024 + kb * 64); c.f8 = 512.f; }
        else if (r < 368 + 96 + 64 + 48) { const int q = r - 528, m = q >> 4, kb = q & 15;
            c.src = (m == 0 ? p.wr : m == 1 ? p.sg : p.su) + (size_t)ll * 1024 * 256 + (size_t)kb * 64 * 256; c.rs = 256;
            c.dst = p.Wt_g + (size_t)ll * 768 * 1024 + (size_t)(m == 0 ? n : 256 + (n >> 7) * 256 + (m - 1) * 128 + (n & 127)) * 1024 + kb * 64; }
        else { const int q = r - 576, nb = q >> 2, kb = q & 3;
            c.src = p.sd + (size_t)ll * 256 * 1024 + (size_t)kb * 64 * 1024 + nb * 256; c.rs = 1024;
            c.dst = p.Wt_sd + (size_t)ll * 1024 * 256 + (size_t)(nb * 256 + n) * 256 + kb * 64; }
    } else {
        const int ll = tile >> 6, nb = (tile >> 4) & 3, kb = tile & 15;
        c.src = p.WF + (size_t)ll * 1024 * 1024 + (size_t)kb * 64 * 1024 + nb * 256; c.rs = 1024;
        c.dst = (bf16_t*)((unsigned char*)p.Wt_in + (size_t)ll * PW * 1024 + (size_t)(768 + nb * 256 + n) * 1024 + kb * 64); c.f8 = 64.f;
    }
    return c;
}
__device__ __noinline__ void phase_conv_dma(const Params& p, int mode, int l, int t_begin, int ntiles, int t_step, float* ldsf) {
    const int tid = threadIdx.x, wid = tid >> 6, lane = tid & 63;
    LAS unsigned char* lds = (LAS unsigned char*)ldsf;
    const int kc = lane & 7, nl = wid * 32 + (lane >> 3);
    constexpr int SLOT = 65536 + 128;
    __syncthreads();
    int t = t_begin;
    auto issue = [&](int tile, int slot) {
        const ConvTile c = conv_tile(p, mode, l, tile, 0);
#pragma unroll
        for (int j = 0; j < 8; ++j) { const int row = wid * 8 + j;
            __builtin_amdgcn_global_load_lds((const unsigned*)(c.src + (size_t)row * c.rs + lane * 4), (LAS unsigned*)(lds + slot * SLOT + row * 1024 + wid * 16), 16, 0, 2); }
    };
    if (t < ntiles) issue(t, 0);
    for (int i = 0; t < ntiles; t += t_step, ++i) {
        asm volatile("s_waitcnt vmcnt(0)" ::: "memory");
        __syncthreads();
        if (t + t_step < ntiles) issue(t + t_step, (i + 1) & 1);
        if (conv_tile(p, mode, l, t, 0).skip) continue;
        const LAS float* base = (const LAS float*)(lds + (i & 1) * SLOT) + (kc * 8) * 256 + kc * 4;
#pragma unroll
        for (int it = 0; it < 4; ++it) { const int n = nl + it * 8;
            const ConvTile c = conv_tile(p, mode, l, t, n);
            float x[8];
#pragma unroll
            for (int k = 0; k < 8; ++k) x[k] = base[k * 256 + n];
            if (c.f8 != 0.f) {
                typedef unsigned u32x2e __attribute__((ext_vector_type(2)));
#pragma unroll
                for (int k = 0; k < 8; ++k) x[k] = fminf(fmaxf(x[k] * c.f8, -448.f), 448.f);
                int q0 = 0, q1 = 0;
                q0 = __builtin_amdgcn_cvt_pk_fp8_f32(x[0], x[1], q0, false); q0 = __builtin_amdgcn_cvt_pk_fp8_f32(x[2], x[3], q0, true);
                q1 = __builtin_amdgcn_cvt_pk_fp8_f32(x[4], x[5], q1, false); q1 = __builtin_amdgcn_cvt_pk_fp8_f32(x[6], x[7], q1, true);
                *(GAS u32x2e*)((unsigned char*)c.dst + kc * 8) = (u32x2e){(unsigned)q0, (unsigned)q1};
            } else {
            pg8::u32x4 o;
            o.x = pg8::cvt_pk_bf16(x[0], x[1]); o.y = pg8::cvt_pk_bf16(x[2], x[3]); o.z = pg8::cvt_pk_bf16(x[4], x[5]); o.w = pg8::cvt_pk_bf16(x[6], x[7]);
            __builtin_nontemporal_store(o, (GAS pg8::u32x4*)(c.dst + kc * 8)); } }
    }
    asm volatile("s_waitcnt vmcnt(0)" ::: "memory");
    __syncthreads();
}
__device__ __noinline__ void phase_conv_ring(const Params& p, int l, int chunk, float* ldsf, unsigned* ctr) {
    const int tid = threadIdx.x, wid = tid >> 6, lane = tid & 63;
    LAS unsigned char* lds = (LAS unsigned char*)ldsf;
    const float* const eg_ = uni(p.eg); const float* const eu_ = uni(p.eu); const float* const ed_ = uni(p.ed);
    unsigned char* const w1_ = (unsigned char*)uni(p.Wt_e1); unsigned char* const w2_ = (unsigned char*)uni(p.Wt_e2);
    const int kc = lane & 7, n = wid * 8 + (lane >> 3);
    constexpr int SLOT = 32768 + 128;
    const int t0 = chunk * 8;
    auto issue = [&](int jt) {
        const int tile = t0 + jt, e = tile / 96, r = tile - e * 96;
        const float* src; int rs;
        if (r < 64) { const int m = r >> 5, kb = (r >> 2) & 7, nq = r & 3; src = (m ? eu_ : eg_) + ((size_t)l * 256 + e) * 1024 * 256 + (size_t)kb * 128 * 256 + nq * 64; rs = 256; }
        else { const int q = r - 64, nb = q >> 1, kb = q & 1; src = ed_ + ((size_t)l * 256 + e) * 256 * 1024 + (size_t)kb * 128 * 1024 + nb * 64; rs = 1024; }
#pragma unroll
        for (int q = 0; q < 4; ++q) { const int row = wid * 16 + q * 4 + (lane >> 4);
            __builtin_amdgcn_global_load_lds((const unsigned*)(src + (size_t)row * rs + (lane & 15) * 4), (LAS unsigned*)(lds + (jt & 3) * SLOT + (wid * 16 + q * 4) * 256 + wid * 16), 16, 0, 2); } };
    __syncthreads();
    unsigned kn; asm volatile("v_mov_b32 %0, 0" : "=v"(kn));
    issue(0); issue(1); issue(2);
#pragma unroll
    for (int jt = 0; jt < 8; ++jt) {
        if (jt < 6) asm volatile("s_waitcnt vmcnt(8)" ::: "memory");
        else if (jt == 6) asm volatile("s_waitcnt vmcnt(4)" ::: "memory");
        else asm volatile("s_waitcnt vmcnt(0)" ::: "memory");
        asm volatile("s_waitcnt lgkmcnt(0)" ::: "memory"); __builtin_amdgcn_s_barrier(); asm volatile("" ::: "memory");
        if (jt + 3 < 8) issue(jt + 3);
        if (jt == 5 && ctr != nullptr && tid == 0) kn = __hip_atomic_fetch_add((GAS unsigned*)ctr, 1u, __ATOMIC_RELAXED, __HIP_MEMORY_SCOPE_AGENT);
        const int tile = t0 + jt, e = tile / 96, r = tile - e * 96;
        const LAS float* base = (const LAS float*)(lds + (jt & 3) * SLOT) + (kc * 16) * 64 + kc * 4 + n;
        float x[16];
#pragma unroll
        for (int k = 0; k < 16; ++k) x[k] = fminf(fmaxf(base[k * 64] * 256.f, -448.f), 448.f);
        unsigned char* dst;
        if (r < 64) { const int m = r >> 5, kb = (r >> 2) & 7, nq = r & 3, nn = nq * 64 + n; dst = w1_ + (size_t)e * 512 * 1024 + (size_t)((nn >> 7) * 256 + m * 128 + (nn & 127)) * 1024 + kb * 128; }
        else { const int q = r - 64, nb = q >> 1, kb = q & 1; dst = w2_ + (size_t)e * 1024 * 256 + (size_t)(nb * 64 + n) * 256 + kb * 128; }
        pg8::i32x4 o;
#pragma unroll
        for (int q = 0; q < 4; ++q) { int w8 = 0; w8 = __builtin_amdgcn_cvt_pk_fp8_f32(x[4 * q], x[4 * q + 1], w8, false); w8 = __builtin_amdgcn_cvt_pk_fp8_f32(x[4 * q + 2], x[4 * q + 3], w8, true); o[q] = w8; }
        __builtin_nontemporal_store(o, (GAS pg8::i32x4*)(dst + kc * 16));
    }
    if (ctr != nullptr && tid == 0) *(volatile LAS unsigned*)36 = kn;
    asm volatile("s_waitcnt lgkmcnt(0)" ::: "memory"); __builtin_amdgcn_s_barrier(); asm volatile("" ::: "memory");
}
__device__ __forceinline__ int build_units256(const Params& p, int* ustart  ) {
    int tid_ = threadIdx.x; asm volatile("" : "+v"(tid_));
    __syncthreads();
    if (tid_ <= 256) ustart[320 + tid_] = p.eoff[tid_];
    __syncthreads();
    if (tid_ == 0) { int s = 0; for (int e = 0; e < 256; ++e) { ustart[e] = s; s += (ustart[320 + e + 1] - ustart[320 + e] + 255) >> 8; } ustart[256] = s; }
    __syncthreads();
    return ustart[256];
}
__device__ __forceinline__ void phase_exp_up_f(const Params& p, int* ustart, float* lds) {
    const int nub = uni(build_units256(p, ustart));
    pg8::ExpOrder S; S.ustart = (const PG8_LAS int*)ustart; S.eoff = uni(p.eoff); S.slot_tok = uni(p.slot_tok); S.nct = 2; S.nun = nub * 2; S.G = gridDim.x; S.c = blockIdx.x; S.gather = true;
    S.A = (const char*)uni(p.u8); S.B = (const char*)uni(p.Wt_e1); S.b_exp = (size_t)512 * 1024; S.b_tile = (size_t)256 * 1024; S.lda_bytes = 1024u;
    pg8::EpiHs E; E.Hs = (unsigned char*)uni(p.Hs); E.slot_w = uni(p.slot_w);
    pg8::gemm_phase<true, true>(LDS_U(lds), 512, 512, 512, S, E);
}
__device__ __forceinline__ void phase_exp_down_f(const Params& p, int* ustart, float* lds) {
    const int nub = uni(build_units256(p, ustart));
    pg8::ExpOrder S; S.ustart = (const PG8_LAS int*)ustart; S.eoff = uni(p.eoff); S.slot_tok = uni(p.slot_tok); S.nct = 4; S.nun = nub * 4; S.G = gridDim.x; S.c = blockIdx.x; S.gather = false;
    S.A = (const char*)uni(p.Hs); S.B = (const char*)uni(p.Wt_e2); S.b_exp = (size_t)1024 * 256; S.b_tile = (size_t)256 * 256; S.lda_bytes = 256u;
    pg8::EpiYs E; E.Ys = (unsigned char*)uni(p.Ys);
    pg8::gemm_phase<false, true>(LDS_U(lds), 128, 128, 128, S, E);
}

__global__ void __launch_bounds__(NTHR, 2) fwd(Params pk) {
    extern __shared__ __attribute__((aligned(16))) unsigned char smem[];
    if (threadIdx.x == 0) *(uint4*)smem = make_uint4(0u, 0u, 0u, 0u);
    Params* ps = (Params*)(smem + 64);
    if (threadIdx.x < sizeof(Params) / 8) ((unsigned long long*)ps)[threadIdx.x] = ((const unsigned long long*)&pk)[threadIdx.x];
    __syncthreads();
    const Params& p = *ps;
    (void)xcd_barrier_post(pk.bar, (volatile LAS unsigned*)smem);
#define GRID_BARRIER() do { XcdBarrier _b; _b.bar = uni(ps->bar); _b.x = xb_xcc_id(); _b.st = (volatile LAS unsigned*)smem; xcd_barrier(_b); } while (0)
    int* ustart = (int*)(smem + 1024);
    float* lds = (float*)(smem + 4096);
    phase_pro(p, lds);
    phase_wprep(p, 0, lds);
    phase_conv_dma(p, 1, 0, blockIdx.x, 2 * 592, gridDim.x, lds);
    GRID_BARRIER();
    phase_conv_dma(p, 2, 0, blockIdx.x, 128, gridDim.x, lds);
    phase_lnmod0(p);
    GRID_BARRIER();
#pragma unroll 1
    for (int l = 0; l < 2; ++l) {
        phase_inproj_f(p, l, lds, false);
        GRID_BARRIER();
        phase_normrope(p, l);
        phase_xt(p, l == 0, lds);
        GRID_BARRIER();
        phase_inproj_f(p, l, lds, true);
        phase_fourier_f(p, l == 0, lds);
        phase_attn_f(p, l, l == 0, smem, lds);
        GRID_BARRIER();
        phase_ygemm_f(p, l, lds);
        if (l == 0 && blockIdx.x >= 32) conv_fill(p, 0, CONV_LIM0, 3, lds);
        GRID_BARRIER();
        phase_outproj_f(p, l, lds);
        if (l == 0 && blockIdx.x >= 32) conv_fill(p, 0, CONV_LIM0, 2, lds);
        GRID_BARRIER();
        phase_ln1(p, l);
        GRID_BARRIER();
        phase_router_shared_f(p, l, lds);
        GRID_BARRIER();
        phase_route(p, l, lds);
        phase_shdown_f(p, l, lds);
        GRID_BARRIER();
        phase_slots(p, l == 1, lds);
        conv_fill(p, l, l == 0 ? CONV_LIM0 : 384, 1 << 20, lds);
        GRID_BARRIER();
        phase_exp_up_f(p, ustart, lds);
        GRID_BARRIER();
        phase_exp_down_f(p, ustart, lds);
        GRID_BARRIER();
        phase_ln2(p, l);
        GRID_BARRIER();
    }
}

static inline size_t bump(size_t& off, size_t bytes) { const size_t o = off; off = (off + bytes + 255) & ~(size_t)255; return o; }

extern "C" void kernel_launch(void* const* d_in, const int* in_sizes, int n_in, void* d_out, int out_size, void* d_ws, size_t ws_size, hipStream_t stream) {
    static int grid = 0;
    if (grid == 0) {
        int dev = 0, cus = 0, per_cu = 0;
        hipGetDevice(&dev);
        hipDeviceGetAttribute(&cus, hipDeviceAttributeMultiprocessorCount, dev);
        hipFuncSetAttribute((const void*)fwd, hipFuncAttributeMaxDynamicSharedMemorySize, LDS_BYTES);
        hipOccupancyMaxActiveBlocksPerMultiprocessor(&per_cu, (const void*)fwd, NTHR, LDS_BYTES);
        (void)hipGetLastError();
        grid = 256;
        if (cus < 256 || per_cu < 1) fprintf(stderr, "kernel_launch: needs 256 CUs with one resident workgroup each (cus %d, per_cu %d)\n", cus, per_cu);
    }
    Params p{};
    const float* const* in = (const float* const*)d_in;
    p.x = in[0]; p.c = in[1]; p.ctx = in[2]; p.c_ctx = in[3]; p.w_mod = in[4]; p.b_mod = in[5]; p.w_in = in[6]; p.qn = in[7]; p.kn = in[8];
    p.lq1 = in[9]; p.lk1 = in[10]; p.lq2 = in[11]; p.lk2 = in[12]; p.subln = in[13]; p.wa = in[14]; p.wb = in[15]; p.wc = in[16]; p.wout = in[17];
    p.ln1g = in[18]; p.ln1b = in[19]; p.wr = in[20]; p.br = in[21]; p.sg = in[22]; p.su = in[23]; p.sd = in[24]; p.eg = in[25]; p.eu = in[26]; p.ed = in[27];
    p.ln2g = in[28]; p.ln2b = in[29];
    p.out = (float*)d_out;
    char* ws = (char*)d_ws; size_t off = 0;
    p.bar = (unsigned*)(ws + bump(off, XCD_BAR_WORDS * 4));
    p.mod = (float*)(ws + bump(off, (size_t)2 * 9 * 6144 * 4));
    p.WF = (float*)(ws + bump(off, (size_t)2 * 1024 * 1024 * 4));
    p.ropec = (float*)(ws + bump(off, 2048 * 32 * 4)); p.ropes = (float*)(ws + bump(off, 2048 * 32 * 4));
    p.tc = (float*)(ws + bump(off, 2048 * 4)); p.ts = (float*)(ws + bump(off, 2048 * 4));
    p.lam = (float*)(ws + bump(off, 256));
    p.hbuf = (float*)(ws + bump(off, (size_t)T_ALL * DM * 4));
    p.z = (float*)(ws + bump(off, (size_t)T_ALL * DM * 4));
    p.logits = (float*)(ws + bump(off, (size_t)T_ALL * 256 * 4));
    p.f = (float*)(ws + bump(off, (size_t)T_ALL * DM * 4));
    p.slot_w = (float*)(ws + bump(off, (size_t)NSLOT * 4));
    p.rw = (float*)(ws + bump(off, (size_t)T_ALL * 8 * 4));
    p.ridx = (int*)(ws + bump(off, (size_t)T_ALL * 8 * 4));
    p.lrank = (int*)(ws + bump(off, (size_t)256 * 576 * 4));
    p.cntWG = (int*)(ws + bump(off, (size_t)256 * 256 * 4));
    p.slot_tok = (int*)(ws + bump(off, (size_t)NSLOT * 4));
    p.tok_slot = (int*)(ws + bump(off, (size_t)T_ALL * 8 * 4));
    p.eoff = (int*)(ws + bump(off, 257 * 4));
    p.u = (act_t*)(ws + bump(off, (size_t)T_ALL * DM * sizeof(act_t)));
    p.u8 = (unsigned char*)(ws + bump(off, (size_t)T_ALL * DM));
    p.PF = (unsigned char*)(ws + bump(off, (size_t)T_ALL * 1024));
    p.oa = (act_t*)(ws + bump(off, (size_t)T_ALL * 512 * sizeof(act_t)));
    p.ob = (act_t*)(ws + bump(off, (size_t)T_ALL * 512 * sizeof(act_t)));
    p.oc = (act_t*)(ws + bump(off, (size_t)T_ALL * 512 * sizeof(act_t)));
    p.y = (act_t*)(ws + bump(off, (size_t)T_ALL * DM * sizeof(act_t)));
    p.shact = (act_t*)(ws + bump(off, (size_t)T_ALL * 256 * sizeof(act_t)));
    p.Hs = (act_t*)(ws + bump(off, (size_t)(NSLOT + 256) * 256 * sizeof(act_t)));
    p.Wt_e1 = (bf16_t*)(ws + bump(off, (size_t)256 * 512 * 1024 * 2));
    p.Wt_e2 = (bf16_t*)(ws + bump(off, (size_t)256 * 1024 * 256 * 2));
    p.Wt_in = (bf16_t*)(ws + bump(off, (size_t)2 * PW * 1024 * 2));
    p.Wt_br = (bf16_t*)(ws + bump(off, (size_t)2 * 3 * 1024 * 512 * 2));
    p.Wt_out = (bf16_t*)(ws + bump(off, (size_t)2 * 1024 * 1024 * 2));
    p.Wt_g = (bf16_t*)(ws + bump(off, (size_t)2 * 768 * 1024 * 2));
    p.Wt_sd = (bf16_t*)(ws + bump(off, (size_t)2 * 1024 * 256 * 2));
    p.ytmp = (float*)(ws + bump(off, (size_t)T_ALL * DM * 4));
    p.Gq = (unsigned char*)(ws + bump(off, (size_t)T_ALL * 3072));
    p.VTa = (bf16_t*)(ws + bump(off, (size_t)8 * 128 * LTOT * 2)); p.VTc = (bf16_t*)(ws + bump(off, (size_t)8 * 512 * LTOT * 2));
    p.actr = (unsigned*)(ws + bump(off, 256));
    p.De = (bf16_t*)(ws + bump(off, (size_t)1024 * 2048 * 2)); p.Do = (bf16_t*)(ws + bump(off, (size_t)1024 * 2048 * 2)); p.Dc = (bf16_t*)(ws + bump(off, (size_t)256 * 512 * 2));
    p.XTe = (bf16_t*)(ws + bump(off, (size_t)4096 * 2048 * 2)); p.XTo = (bf16_t*)(ws + bump(off, (size_t)4096 * 2048 * 2)); p.XTc = (bf16_t*)(ws + bump(off, (size_t)4096 * 512 * 2));
    const size_t psz = (size_t)T_ALL * PW * sizeof(act_t), ysz = (size_t)NSLOT * DM * sizeof(act_t);
    const size_t shared = bump(off, psz > ysz ? psz : ysz);
    p.P = (act_t*)(ws + shared); p.Ys = (act_t*)(ws + shared);
    if (off > ws_size) { fprintf(stderr, "kernel_launch: workspace too small: need %zu, have %zu\n", off, ws_size); return; }
    hipMemsetAsync(p.bar, 0, XCD_BAR_WORDS * 4, stream);
    hipLaunchKernelGGL(fwd, dim3(grid), dim3(NTHR), LDS_BYTES, stream, p);
}
```

```cpp
#include <hip/hip_runtime.h>
#include <stdint.h>
#include <stdio.h>

#define DM 1024
#define NBATCH 8
#define SEQ 2048
#define CTXL 256
#define LTOT 2304
#define T_ALL 18432
#define IN_W 5888
#define PW 6400
#define C_QA 0
#define C_KA 512
#define C_VA 640
#define C_FA 768
#define C_QC 1792
#define C_KC 2304
#define C_VC 2816
#define C_G 3328
#define NEXP 256
#define NSLOT (T_ALL * 8)
#define NTHR 512
#define LDS_BYTES 163840
#define ALPHA 1.41421356237f

typedef unsigned short bf16_t;
#define ACT_BF16 1
#ifdef ACT_BF16
typedef bf16_t act_t;
#else
typedef float act_t;
#endif

__device__ __forceinline__ float bf2f(bf16_t v) { return __uint_as_float(((unsigned)v) << 16); }
__device__ __forceinline__ bf16_t f2bf(float f) { unsigned u = __float_as_uint(f); u += 0x7FFFu + ((u >> 16) & 1u); return (bf16_t)(u >> 16); }
__device__ __forceinline__ float ldv(const float* p, size_t i) { return p[i]; }
__device__ __forceinline__ float ldv(const bf16_t* p, size_t i) { return bf2f(p[i]); }
__device__ __forceinline__ void stv(float* p, size_t i, float v) { p[i] = v; }
__device__ __forceinline__ void stv(bf16_t* p, size_t i, float v) { p[i] = f2bf(v); }
__device__ __forceinline__ float4 ld4(const float* p, size_t i) { return *(const float4*)(p + i); }
__device__ __forceinline__ float4 ld4(const bf16_t* p, size_t i) { uint2 r = *(const uint2*)(p + i); float4 o; o.x = __uint_as_float(r.x << 16); o.y = __uint_as_float(r.x & 0xFFFF0000u); o.z = __uint_as_float(r.y << 16); o.w = __uint_as_float(r.y & 0xFFFF0000u); return o; }
__device__ __forceinline__ void st4(float* p, size_t i, float4 v) { *(float4*)(p + i) = v; }
__device__ __forceinline__ void st4(bf16_t* p, size_t i, float4 v) { uint2 r; r.x = (unsigned)f2bf(v.x) | ((unsigned)f2bf(v.y) << 16); r.y = (unsigned)f2bf(v.z) | ((unsigned)f2bf(v.w) << 16); *(uint2*)(p + i) = r; }

#define XB_TMO      128
#define XB_XCNT(j)  (256  + 64 * (j))
#define XB_XSUB(j)  (1280 + 64 * (j))
#define XB_XGEN(j)  (2304 + 64 * (j))
#define XB_TOP      3328
#define XB_TOPGEN   3392
#define XCD_BAR_WORDS 3456
#define XB_SPIN_CAP (1u << 27)
#define LAS __attribute__((address_space(3)))

__device__ __forceinline__ unsigned xb_ld(unsigned* p)              { return __hip_atomic_load(p, __ATOMIC_RELAXED, __HIP_MEMORY_SCOPE_AGENT); }
__device__ __forceinline__ unsigned xb_add(unsigned* p, unsigned v) { return __hip_atomic_fetch_add(p, v, __ATOMIC_RELAXED, __HIP_MEMORY_SCOPE_AGENT); }
__device__ __forceinline__ unsigned xb_xcc_id() { return (unsigned)__builtin_amdgcn_s_getreg((3 << 11) | 20) & 0xFu; }
#define XB_SPIN(cond, bar) do { unsigned _sp = 0; while (cond) { __builtin_amdgcn_s_sleep(1); \
    if ((++_sp & 255u) == 0u) { if (xb_ld(&(bar)[XB_TMO])) break; if (_sp > XB_SPIN_CAP) { atomicAdd(&(bar)[XB_TMO], 1u); break; } } } } while (0)

struct XcdBarrier { unsigned* bar; unsigned x; volatile LAS unsigned* st; };

__device__ __forceinline__ XcdBarrier xcd_barrier_post(unsigned* bar, volatile LAS unsigned* st) {
    XcdBarrier b; b.bar = bar; b.x = xb_xcc_id(); b.st = st;
    if (threadIdx.x == 0) (void)xb_add(&bar[XB_XCNT(b.x)], 1u);
    return b;
}
__device__ __forceinline__ void xcd_barrier_complete(unsigned* bar, unsigned x, unsigned& nloc, unsigned& nx) {
    const unsigned G = gridDim.x * gridDim.y * gridDim.z;
    unsigned sum, cnt, mine, sp = 0u;
    for (;;) {
        sum = 0u; cnt = 0u; mine = 0u;
#pragma unroll
        for (unsigned j = 0; j < 16; ++j) { const unsigned c = xb_ld(&bar[XB_XCNT(j)]); sum += c; cnt += (c > 0u) ? 1u : 0u; mine = (j == x) ? c : mine; }
        if (sum == G) break;
        __builtin_amdgcn_s_sleep(1);
        if ((++sp & 255u) == 0u) { if (xb_ld(&bar[XB_TMO])) break; if (sp > XB_SPIN_CAP) { atomicAdd(&bar[XB_TMO], 1u); break; } }
    }
    nloc = mine > 0u ? mine : 1u; nx = cnt > 0u ? cnt : 1u;
}
__device__ __forceinline__ void xcd_barrier(const XcdBarrier& b) {
    asm volatile("s_waitcnt vmcnt(0)" ::: "memory");
    __syncthreads();
    if (threadIdx.x == 0) {
        unsigned* bar = b.bar;
        __builtin_amdgcn_s_waitcnt(0);
        unsigned nloc = b.st[0], nx = b.st[1];
        if (nloc == 0u) { xcd_barrier_complete(bar, b.x, nloc, nx); b.st[0] = nloc; b.st[1] = nx; }
        const unsigned old = xb_add(&bar[XB_XSUB(b.x)], 1u);
        const unsigned gen = old / nloc;
        if (old + 1u == (gen + 1u) * nloc) {
            __builtin_amdgcn_fence(__ATOMIC_RELEASE, "agent");
            asm volatile("s_waitcnt vmcnt(0)" ::: "memory");
            const unsigned og = xb_add(&bar[XB_TOP], 1u);
            const unsigned tg = og / nx;
            if (og + 1u == (tg + 1u) * nx) xb_add(&bar[XB_TOPGEN], 1u);
            else XB_SPIN(xb_ld(&bar[XB_TOPGEN]) == tg, bar);
            __builtin_amdgcn_fence(__ATOMIC_ACQUIRE, "agent");
            xb_add(&bar[XB_XGEN(b.x)], 1u);
            asm volatile("s_waitcnt vmcnt(0)" ::: "memory");
        } else {
            XB_SPIN(xb_ld(&bar[XB_XGEN(b.x)]) == gen, bar);
            __builtin_amdgcn_fence(__ATOMIC_ACQUIRE, "agent");
            asm volatile("s_waitcnt vmcnt(0)" ::: "memory");
        }
    }
    __syncthreads();
}

#define CONV_LIM0 244
struct Params {
    const float *x, *c, *ctx, *c_ctx, *w_mod, *b_mod, *w_in, *qn, *kn, *lq1, *lk1, *lq2, *lk2, *subln,
                *wa, *wb, *wc, *wout, *ln1g, *ln1b, *wr, *br, *sg, *su, *sd, *eg, *eu, *ed, *ln2g, *ln2b;
    float* out;
    unsigned* bar;
    float *mod, *WF, *ropec, *ropes, *tc, *ts, *lam, *hbuf, *z, *logits, *f, *slot_w, *rw;
    act_t *u, *P, *oa, *ob, *oc, *y, *shact, *Hs, *Ys;
    int *ridx, *lrank, *cntWG, *slot_tok, *tok_slot, *eoff;
    bf16_t *Wt_in, *Wt_br, *Wt_out, *Wt_g, *Wt_sd;
    float* ytmp;
    bf16_t *Wt_e1, *Wt_e2;
    unsigned char* PF;
    unsigned char* u8;
    unsigned char* Gq;
    bf16_t *VTa, *VTc;
    unsigned* actr;
    bf16_t *De, *Do, *Dc, *XTe, *XTo, *XTc;
};

__device__ __forceinline__ float wave_sum(float v) {
#pragma unroll
    for (int o = 32; o > 0; o >>= 1) v += __shfl_xor(v, o);
    return v;
}
__device__ __forceinline__ float wave_max(float v) {
#pragma unroll
    for (int o = 32; o > 0; o >>= 1) v = fmaxf(v, __shfl_xor(v, o));
    return v;
}
__device__ __forceinline__ float sigmoidf_(float v) { return 1.f / (1.f + expf(-v)); }
__device__ __forceinline__ float siluf_(float v) { return v / (1.f + expf(-v)); }
__device__ __forceinline__ float lam_init_of(int l) { return l == 0 ? 0.2f : 0.35550906759f; }

__device__ __forceinline__ const float* in_row(const Params& p, int r) {
    const int b = r / LTOT, j = r - b * LTOT;
    return j < CTXL ? p.ctx + ((size_t)b * CTXL + j) * DM : p.x + ((size_t)b * SEQ + (j - CTXL)) * DM;
}
__device__ __forceinline__ int mod_idx(int r) { const int b = r / LTOT, j = r - b * LTOT; return j < CTXL ? 8 : b; }
__device__ __forceinline__ const float* modv(const Params& p, int l, int mi, int i) { return p.mod + ((size_t)(l * 9 + mi) * 6 + i) * DM; }

__device__ __forceinline__ void ln_stats(const float (&v)[16], float& mu, float& rstd) {
    float s = 0.f;
#pragma unroll
    for (int i = 0; i < 16; ++i) s += v[i];
    mu = wave_sum(s) * (1.f / DM);
    float q = 0.f;
#pragma unroll
    for (int i = 0; i < 16; ++i) { const float d = v[i] - mu; q += d * d; }
    rstd = rsqrtf(wave_sum(q) * (1.f / DM) + 1e-5f);
}
__device__ __forceinline__ void load_row16(const float* src, int lane, float (&v)[16]) {
#pragma unroll
    for (int i = 0; i < 4; ++i) { const float4 t = *(const float4*)(src + i * 256 + lane * 4); v[i * 4 + 0] = t.x; v[i * 4 + 1] = t.y; v[i * 4 + 2] = t.z; v[i * 4 + 3] = t.w; }
}

template <class FA, class FB>
__device__ __forceinline__ void sgemm_tile(float (&acc)[4][4], int K, FA fa, FB fb, float* lds) {
    float* As = lds;
    float* Bs = lds + 16 * 64;
    const int tid = threadIdx.x, ty = tid >> 5, tx = tid & 31;
#pragma unroll
    for (int i = 0; i < 4; ++i)
#pragma unroll
        for (int j = 0; j < 4; ++j) acc[i][j] = 0.f;
#pragma unroll 1
    for (int k0 = 0; k0 < K; k0 += 16) {
        __syncthreads();
#pragma unroll
        for (int i = 0; i < 2; ++i) { const int e = tid + i * NTHR; const int r = e >> 4, kk = e & 15; As[kk * 64 + r] = fa(r, k0 + kk); }
#pragma unroll
        for (int i = 0; i < 4; ++i) { const int e = tid + i * NTHR; const int kk = e >> 7, c = e & 127; Bs[kk * 128 + c] = fb(k0 + kk, c); }
        __syncthreads();
#pragma unroll 4
        for (int kk = 0; kk < 16; ++kk) {
            const float4 a = *(const float4*)&As[kk * 64 + ty * 4];
            const float4 b = *(const float4*)&Bs[kk * 128 + tx * 4];
            const float av[4] = {a.x, a.y, a.z, a.w}, bv[4] = {b.x, b.y, b.z, b.w};
#pragma unroll
            for (int i = 0; i < 4; ++i)
#pragma unroll
                for (int j = 0; j < 4; ++j) acc[i][j] += av[i] * bv[j];
        }
    }
}

__device__ __noinline__ void phase_pro(const Params& p, float* lds) {
    const int tid = threadIdx.x, bid = blockIdx.x, nb = gridDim.x;
    const int gtid = bid * NTHR + tid, gn = nb * NTHR;
    for (int i = tid; i < 9 * 1024; i += NTHR) { const int r = i >> 10, k = i & 1023; const float v = r < 8 ? p.c[r * 1024 + k] : p.c_ctx[k]; lds[i] = siluf_(v); }
    __syncthreads();
    float* red = lds + 9 * 1024;
    for (int g = bid; g < 192; g += nb) {
        const int l = g / 96, col0 = (g % 96) * 64, c4 = tid & 15, kc = tid >> 4;
        float acc[9][4];
#pragma unroll
        for (int i = 0; i < 9; ++i) { acc[i][0] = 0.f; acc[i][1] = 0.f; acc[i][2] = 0.f; acc[i][3] = 0.f; }
        const float* w = p.w_mod + (size_t)l * 1024 * 6144 + col0 + c4 * 4;
#pragma unroll 8
        for (int k = kc * 32; k < kc * 32 + 32; ++k) {
            const float4 wv = *(const float4*)(w + (size_t)k * 6144);
#pragma unroll
            for (int i = 0; i < 9; ++i) { const float s = lds[i * 1024 + k]; acc[i][0] += s * wv.x; acc[i][1] += s * wv.y; acc[i][2] += s * wv.z; acc[i][3] += s * wv.w; }
        }
#pragma unroll
        for (int i = 0; i < 9; ++i) *(float4*)&red[(kc * 9 + i) * 64 + c4 * 4] = make_float4(acc[i][0], acc[i][1], acc[i][2], acc[i][3]);
        __syncthreads();
        for (int o = tid; o < 9 * 64; o += NTHR) { const int i = o >> 6, c = o & 63;
            float s = p.b_mod[l * 6144 + col0 + c];
#pragma unroll 8
            for (int k2 = 0; k2 < 32; ++k2) s += red[(k2 * 9 + i) * 64 + c];
            p.mod[(size_t)(l * 9 + i) * 6144 + col0 + c] = s; }
        __syncthreads();
    }
    for (int i = gtid; i < 2048 * 32; i += gn) {
        const int s = i >> 5, j = i & 31, axis = j >> 4, fi = j & 15;
        const double pos = axis ? (double)(s & 63) : (double)(s >> 6);
        const double inv = pow(10000.0, -(double)fi / 16.0);
        const double ang = (double)(float)((float)pos * (float)inv);
        p.ropec[i] = (float)cos(ang); p.ropes[i] = (float)sin(ang);
    }
    for (int i = gtid; i < 2048; i += gn) { p.tc[i] = (float)cospi((double)i / 1024.0); p.ts[i] = (float)sinpi((double)i / 1024.0); }
    if (bid == 0 && tid < 128) {
        const int l = tid >> 6, lane = tid & 63;
        const float d1 = wave_sum(p.lq1[l * 64 + lane] * p.lk1[l * 64 + lane]);
        const float d2 = wave_sum(p.lq2[l * 64 + lane] * p.lk2[l * 64 + lane]);
        if (lane == 0) { p.lam[l] = expf(d1) - expf(d2) + lam_init_of(l); }
        if (lane < 16) p.actr[l * 32 + lane] = 0u;
    }
    __syncthreads();
    float* t128 = lds;
    if (tid < 128) { t128[tid] = (float)cospi((double)tid / 64.0); t128[128 + tid] = (float)sinpi((double)tid / 64.0); }
    __syncthreads();
    typedef const __attribute__((address_space(4))) float* cfp;
    const int lane = tid & 63;
    for (int it_ = bid * 8 + (tid >> 6); it_ < 2 * 1024 * 4; it_ += nb * 8) {
        const int it = __builtin_amdgcn_readfirstlane(it_), l = it >> 12, k = (it >> 2) & 1023, g = it & 3;
        const unsigned long long wa = (unsigned long long)(p.w_in + ((size_t)l * 1024 + k) * IN_W + 768 + g * 128);
        cfp w = (cfp)(((unsigned long long)(unsigned)__builtin_amdgcn_readfirstlane((int)(wa >> 32)) << 32) | (unsigned)__builtin_amdgcn_readfirstlane((int)wa));
        float c0 = 0.f, s0 = 0.f, c1 = 0.f, s1 = 0.f;
#pragma unroll 8
        for (int c = 0; c < 128; ++c) {
            const float wv = w[c];
            const int i0 = (c * lane) & 127, i1 = i0 ^ ((c & 1) << 6);
            c0 += wv * t128[i0]; s0 += wv * t128[128 + i0]; c1 += wv * t128[i1]; s1 += wv * t128[128 + i1];
        }
        float* o = p.WF + ((size_t)l * 1024 + k) * 1024 + g * 128;
        o[lane] = c0; o[lane + 64] = c1; o[512 + lane] = s0; o[512 + lane + 64] = s1;
    }
}

__device__ __forceinline__ void st_fp8x4(unsigned char* p8, size_t i, float4 o) {
    int q8 = 0;
    q8 = __builtin_amdgcn_cvt_pk_fp8_f32(fminf(fmaxf(o.x * 16.f, -448.f), 448.f), fminf(fmaxf(o.y * 16.f, -448.f), 448.f), q8, false);
    q8 = __builtin_amdgcn_cvt_pk_fp8_f32(fminf(fmaxf(o.z * 16.f, -448.f), 448.f), fminf(fmaxf(o.w * 16.f, -448.f), 448.f), q8, true);
    *(int*)(p8 + i) = q8;
}
__device__ __noinline__ void phase_lnmod0(const Params& p) {
    const int wid = threadIdx.x >> 6, lane = threadIdx.x & 63;
    const int stride = gridDim.x * 8;
    auto proc = [&](int r, float (&v)[16]) {
        float mu, rstd; ln_stats(v, mu, rstd);
        const int mi = mod_idx(r);
        const float* sh = modv(p, 0, mi, 0); const float* sc = modv(p, 0, mi, 1);
#pragma unroll
        for (int i = 0; i < 4; ++i) {
            const int c = i * 256 + lane * 4;
            const float4 s4 = *(const float4*)(sh + c), c4 = *(const float4*)(sc + c);
            float4 o; o.x = (v[i * 4 + 0] - mu) * rstd * (1.f + c4.x) + s4.x; o.y = (v[i * 4 + 1] - mu) * rstd * (1.f + c4.y) + s4.y;
            o.z = (v[i * 4 + 2] - mu) * rstd * (1.f + c4.z) + s4.z; o.w = (v[i * 4 + 3] - mu) * rstd * (1.f + c4.w) + s4.w;
            st_fp8x4(p.u8, (size_t)r * DM + c, o);
        } };
    for (int r = blockIdx.x * 8 + wid; r < T_ALL; r += 2 * stride) {
        const int r2 = r + stride;
        float va[16], vb[16];
        load_row16(in_row(p, r), lane, va);
        if (r2 < T_ALL) load_row16(in_row(p, r2), lane, vb);
        proc(r, va);
        if (r2 < T_ALL) proc(r2, vb);
    }
}

__device__ __noinline__ void phase_inproj(const Params& p, int l, float* lds) {
    const int tid = threadIdx.x, ty = tid >> 5, tx = tid & 31;
    const float* win = p.w_in + (size_t)l * 1024 * IN_W;
    const float* wf = p.WF + (size_t)l * 1024 * 1024;
    for (int t = blockIdx.x; t < 288 * 50; t += gridDim.x) {
        const int rt = t / 50, ct = t % 50, col0 = ct * 128;
        float acc[4][4];
        sgemm_tile(acc, 1024,
            [&](int r, int k) { return ldv(p.u, (size_t)(rt * 64 + r) * DM + k); },
            [&](int k, int c) { const int col = col0 + c;
                if (col < 768) return win[(size_t)k * IN_W + col];
                if (col < 1792) return wf[(size_t)k * 1024 + (col - 768)];
                return win[(size_t)k * IN_W + (col - 512)]; }, lds);
#pragma unroll
        for (int i = 0; i < 4; ++i) { const size_t row = rt * 64 + ty * 4 + i;
            st4(p.P, row * PW + col0 + tx * 4, make_float4(acc[i][0], acc[i][1], acc[i][2], acc[i][3])); }
    }
}

__device__ __forceinline__ void load64(const float* p, float (&kr)[64]) {
#pragma unroll
    for (int i = 0; i < 16; ++i) { const float4 t = *(const float4*)(p + i * 4); kr[i * 4] = t.x; kr[i * 4 + 1] = t.y; kr[i * 4 + 2] = t.z; kr[i * 4 + 3] = t.w; }
}
__device__ __forceinline__ void load64(const bf16_t* p, float (&kr)[64]) {
#pragma unroll
    for (int i = 0; i < 16; ++i) { const float4 t = ld4(p, i * 4); kr[i * 4] = t.x; kr[i * 4 + 1] = t.y; kr[i * 4 + 2] = t.z; kr[i * 4 + 3] = t.w; }
}
template <int QB, int NMAP, int VD>
__device__ __noinline__ void attn_unit(const Params& p, int l, int b, int head, int qblk, bool ctxq, float* lds) {
    const int L = ctxq ? CTXL : LTOT;
    float* S = lds;
    float* Q = lds + 36864;
    const int tid = threadIdx.x, wid = tid >> 6, lane = tid & 63;
    const size_t rowbase = (size_t)b * LTOT;
    const int jq0 = (ctxq ? 0 : CTXL) + qblk * QB;
    const bool gqa = (NMAP == 1);
    const int qcol = gqa ? C_QA + head * 64 : C_QC + head * 128;
    const int kcol = gqa ? C_KA + (head >> 2) * 64 : C_KC + head * 128;
    const int vcol = gqa ? C_VA + (head >> 2) * 64 : C_VC + head * 128;
    __syncthreads();
    for (int i = tid; i < NMAP * QB * 64; i += NTHR) { const int m = i / (QB * 64), q = (i >> 6) % QB, d = i & 63;
        Q[i] = ldv(p.P, (rowbase + jq0 + q) * PW + qcol + m * 64 + d) * 0.125f; }
    __syncthreads();
    for (int j = tid; j < L; j += NTHR) {
#pragma unroll 1
        for (int m = 0; m < NMAP; ++m) {
            float kr[64]; load64(p.P + (rowbase + j) * PW + kcol + m * 64, kr);
#pragma unroll 1
            for (int q = 0; q < QB; ++q) {
                const float* qp = Q + (m * QB + q) * 64; float d = 0.f;
#pragma unroll
                for (int e = 0; e < 64; ++e) d += qp[e] * kr[e];
                S[(m * QB + q) * L + j] = d;
            }
        }
    }
    __syncthreads();
#pragma unroll
    for (int rr = 0; rr < 2; ++rr) {
        float* sr = S + (wid * 2 + rr) * L;
        float mx = -3.0e38f;
        for (int j = lane; j < L; j += 64) mx = fmaxf(mx, sr[j]);
        mx = wave_max(mx);
        float sum = 0.f;
        for (int j = lane; j < L; j += 64) { const float e = expf(sr[j] - mx); sr[j] = e; sum += e; }
        sum = wave_sum(sum);
        const float inv = 1.f / sum;
        for (int j = lane; j < L; j += 64) sr[j] *= inv;
    }
    __syncthreads();
    if (NMAP == 2) {
        const float lam = p.lam[l];
        for (int i = tid; i < QB * L; i += NTHR) S[i] -= lam * S[QB * L + i];
        __syncthreads();
    }
    const int q = tid / (VD / 2), e = (tid % (VD / 2)) * 2;
    float o0 = 0.f, o1 = 0.f;
    const float* sq = S + q * L;
    const act_t* vp = p.P + rowbase * PW + vcol + e;
#pragma unroll 4
    for (int j = 0; j < L; ++j) { const float pj = sq[j]; o0 += pj * ldv(vp, (size_t)j * PW); o1 += pj * ldv(vp, (size_t)j * PW + 1); }
    const size_t orow = rowbase + jq0 + q;
    if (gqa) { stv(p.oa, orow * 512 + head * 64 + e, o0); stv(p.oa, orow * 512 + head * 64 + e + 1, o1); }
    else {
        const float ss = wave_sum(o0 * o0 + o1 * o1);
        const float sc = rsqrtf(ss * (1.f / 128.f) + 1e-6f) * (1.f - lam_init_of(l));
        stv(p.oc, orow * 512 + head * 128 + e, o0 * sc * p.subln[l * 128 + e]); stv(p.oc, orow * 512 + head * 128 + e + 1, o1 * sc * p.subln[l * 128 + e + 1]);
    }
}
__device__ __forceinline__ void phase_attn(const Params& p, int l, bool do_ctx, float* lds) {
    for (int t = blockIdx.x; t < 8192; t += gridDim.x) attn_unit<16, 1, 64>(p, l, t >> 10, (t >> 7) & 7, t & 127, false, lds);
    for (int t = blockIdx.x; t < 8192; t += gridDim.x) attn_unit<8, 2, 128>(p, l, t >> 10, (t >> 8) & 3, t & 255, false, lds);
    if (do_ctx) {
        for (int t = blockIdx.x; t < 1024; t += gridDim.x) attn_unit<16, 1, 64>(p, l, t >> 7, (t >> 4) & 7, t & 15, true, lds);
        for (int t = blockIdx.x; t < 1024; t += gridDim.x) attn_unit<8, 2, 128>(p, l, t >> 7, (t >> 5) & 3, t & 31, true, lds);
    }
}

__device__ __noinline__ void phase_fourier(const Params& p, bool do_ctx, float* lds) {
    const int tid = threadIdx.x, ty = tid >> 5, tx = tid & 31;
    for (int t = blockIdx.x; t < 8 * 32 * 4; t += gridDim.x) {
        const int b = t >> 7, rt = (t >> 2) & 31, ct = t & 3;
        float acc[4][4];
        sgemm_tile(acc, 4096,
            [&](int r, int k) { const int kk = rt * 64 + r, n = k & 2047, m = (kk * n) & 2047; return k < 2048 ? p.tc[m] : -p.ts[m]; },
            [&](int k, int c) { const int n = k & 2047, wh = k >> 11; return ldv(p.P, ((size_t)b * LTOT + CTXL + n) * PW + C_FA + wh * 512 + ct * 128 + c); }, lds);
#pragma unroll
        for (int i = 0; i < 4; ++i) { const size_t row = (size_t)b * LTOT + CTXL + rt * 64 + ty * 4 + i; const float s = 1.f / 512.f;
            st4(p.ob, row * 512 + ct * 128 + tx * 4, make_float4(acc[i][0] * s, acc[i][1] * s, acc[i][2] * s, acc[i][3] * s)); }
    }
    if (do_ctx) {
        for (int t = blockIdx.x; t < 8 * 4 * 4; t += gridDim.x) {
            const int b = t >> 4, rt = (t >> 2) & 3, ct = t & 3;
            float acc[4][4];
            sgemm_tile(acc, 512,
                [&](int r, int k) { const int kk = rt * 64 + r, n = k & 255, m = (kk * n * 8) & 2047; return k < 256 ? p.tc[m] : -p.ts[m]; },
                [&](int k, int c) { const int n = k & 255, wh = k >> 8; return ldv(p.P, ((size_t)b * LTOT + n) * PW + C_FA + wh * 512 + ct * 128 + c); }, lds);
#pragma unroll
            for (int i = 0; i < 4; ++i) { const size_t row = (size_t)b * LTOT + rt * 64 + ty * 4 + i; const float s = 0.00552427172802f;
                st4(p.ob, row * 512 + ct * 128 + tx * 4, make_float4(acc[i][0] * s, acc[i][1] * s, acc[i][2] * s, acc[i][3] * s)); }
        }
    }
}

__device__ __noinline__ void phase_ygemm(const Params& p, int l, float* lds) {
    const int tid = threadIdx.x, ty = tid >> 5, tx = tid & 31;
    for (int t = blockIdx.x; t < 288 * 8; t += gridDim.x) {
        const int rt = t >> 3, ct = t & 7, col0 = ct * 128;
        float tot[4][4];
#pragma unroll
        for (int i = 0; i < 4; ++i)
#pragma unroll
            for (int j = 0; j < 4; ++j) tot[i][j] = 0.f;
#pragma unroll 1
        for (int br = 0; br < 3; ++br) {
            const act_t* o = br == 0 ? p.oa : br == 1 ? p.ob : p.oc;
            const float* w = (br == 0 ? p.wa : br == 1 ? p.wb : p.wc) + (size_t)l * 512 * 1024;
            float acc[4][4];
            sgemm_tile(acc, 512,
                [&](int r, int k) { return ldv(o, (size_t)(rt * 64 + r) * 512 + k); },
                [&](int k, int c) { return w[(size_t)k * 1024 + col0 + c]; }, lds);
#pragma unroll
            for (int i = 0; i < 4; ++i) { const size_t row = rt * 64 + ty * 4 + i;
                const float4 g = ld4(p.P, row * PW + C_G + br * 1024 + col0 + tx * 4);
                tot[i][0] += sigmoidf_(g.x) * acc[i][0]; tot[i][1] += sigmoidf_(g.y) * acc[i][1]; tot[i][2] += sigmoidf_(g.z) * acc[i][2]; tot[i][3] += sigmoidf_(g.w) * acc[i][3]; }
        }
#pragma unroll
        for (int i = 0; i < 4; ++i) { const size_t row = rt * 64 + ty * 4 + i; st4(p.y, row * DM + col0 + tx * 4, make_float4(tot[i][0], tot[i][1], tot[i][2], tot[i][3])); }
    }
}

__device__ __noinline__ void phase_outproj(const Params& p, int l, float* lds) {
    const int tid = threadIdx.x, ty = tid >> 5, tx = tid & 31;
    const float* w = p.wout + (size_t)l * 1024 * 1024;
    for (int t = blockIdx.x; t < 288 * 8; t += gridDim.x) {
        const int rt = t >> 3, ct = t & 7, col0 = ct * 128;
        float acc[4][4];
        sgemm_tile(acc, 1024,
            [&](int r, int k) { return ldv(p.y, (size_t)(rt * 64 + r) * DM + k); },
            [&](int k, int c) { return w[(size_t)k * 1024 + col0 + c]; }, lds);
#pragma unroll
        for (int i = 0; i < 4; ++i) { const int row = rt * 64 + ty * 4 + i; const int c = col0 + tx * 4;
            const float* hrow = l == 0 ? in_row(p, row) : p.hbuf + (size_t)row * DM;
            const float4 h4 = *(const float4*)(hrow + c); const float4 m4 = *(const float4*)(modv(p, l, mod_idx(row), 2) + c);
            float4 o; o.x = ALPHA * h4.x + m4.x * acc[i][0]; o.y = ALPHA * h4.y + m4.y * acc[i][1]; o.z = ALPHA * h4.z + m4.z * acc[i][2]; o.w = ALPHA * h4.w + m4.w * acc[i][3];
            *(float4*)(p.z + (size_t)row * DM + c) = o; }
    }
}

__device__ __noinline__ void phase_ln1(const Params& p, int l) {
    const int wid = threadIdx.x >> 6, lane = threadIdx.x & 63;
    const int stride = gridDim.x * 8;
    const float* g = p.ln1g + l * DM; const float* bb = p.ln1b + l * DM;
    auto load = [&](int r, float (&v)[16]) {
#pragma unroll
        for (int i = 0; i < 4; ++i) { const float4 t = ld4((const bf16_t*)p.z, (size_t)r * DM + i * 256 + lane * 4); v[i * 4] = t.x; v[i * 4 + 1] = t.y; v[i * 4 + 2] = t.z; v[i * 4 + 3] = t.w; } };
    auto proc = [&](int r, float (&v)[16]) {
        float mu, rstd; ln_stats(v, mu, rstd);
#pragma unroll
        for (int i = 0; i < 4; ++i) { const int c = i * 256 + lane * 4; const float4 g4 = *(const float4*)(g + c), b4 = *(const float4*)(bb + c);
            v[i * 4 + 0] = (v[i * 4 + 0] - mu) * rstd * g4.x + b4.x; v[i * 4 + 1] = (v[i * 4 + 1] - mu) * rstd * g4.y + b4.y;
            v[i * 4 + 2] = (v[i * 4 + 2] - mu) * rstd * g4.z + b4.z; v[i * 4 + 3] = (v[i * 4 + 3] - mu) * rstd * g4.w + b4.w;
            st4((bf16_t*)p.hbuf, (size_t)r * DM + c, make_float4(v[i * 4], v[i * 4 + 1], v[i * 4 + 2], v[i * 4 + 3])); }
        ln_stats(v, mu, rstd);
        const int mi = mod_idx(r);
        const float* sh = modv(p, l, mi, 3); const float* sc = modv(p, l, mi, 4);
#pragma unroll
        for (int i = 0; i < 4; ++i) { const int c = i * 256 + lane * 4; const float4 s4 = *(const float4*)(sh + c), c4 = *(const float4*)(sc + c);
            float4 o; o.x = (v[i * 4 + 0] - mu) * rstd * (1.f + c4.x) + s4.x; o.y = (v[i * 4 + 1] - mu) * rstd * (1.f + c4.y) + s4.y;
            o.z = (v[i * 4 + 2] - mu) * rstd * (1.f + c4.z) + s4.z; o.w = (v[i * 4 + 3] - mu) * rstd * (1.f + c4.w) + s4.w;
            st4(p.u, (size_t)r * DM + c, o);
            { int q8 = 0;
              q8 = __builtin_amdgcn_cvt_pk_fp8_f32(fminf(fmaxf(o.x * 16.f, -448.f), 448.f), fminf(fmaxf(o.y * 16.f, -448.f), 448.f), q8, false);
              q8 = __builtin_amdgcn_cvt_pk_fp8_f32(fminf(fmaxf(o.z * 16.f, -448.f), 448.f), fminf(fmaxf(o.w * 16.f, -448.f), 448.f), q8, true);
              *(int*)(p.u8 + (size_t)r * DM + c) = q8; } } };
    for (int r = blockIdx.x * 8 + wid; r < T_ALL; r += 2 * stride) {
        const int r2 = r + stride;
        const bool okA = !(l == 1 && (r % LTOT) < CTXL), okB = r2 < T_ALL && !(l == 1 && (r2 % LTOT) < CTXL);
        float va[16], vb[16];
        if (okA) load(r, va);
        if (okB) load(r2, vb);
        if (okA) proc(r, va);
        if (okB) proc(r2, vb);
    }
}

__device__ __noinline__ void phase_router_shared(const Params& p, int l, float* lds) {
    const int tid = threadIdx.x, ty = tid >> 5, tx = tid & 31;
    const float* wr = p.wr + (size_t)l * 1024 * 256; const float* sg = p.sg + (size_t)l * 1024 * 256; const float* su = p.su + (size_t)l * 1024 * 256;
    for (int t = blockIdx.x; t < 288 * 4; t += gridDim.x) {
        const int rt = t >> 2, kind = (t >> 1) & 1, ct = t & 1, col0 = ct * 128;
        auto fa = [&](int r, int k) { return ldv(p.u, (size_t)(rt * 64 + r) * DM + k); };
        if (kind == 0) {
            float acc[4][4];
            sgemm_tile(acc, 1024, fa, [&](int k, int c) { return wr[(size_t)k * 256 + col0 + c]; }, lds);
#pragma unroll
            for (int i = 0; i < 4; ++i) { const size_t row = rt * 64 + ty * 4 + i; *(float4*)(p.logits + row * 256 + col0 + tx * 4) = make_float4(acc[i][0], acc[i][1], acc[i][2], acc[i][3]); }
        } else {
            float ag[4][4], au[4][4];
            sgemm_tile(ag, 1024, fa, [&](int k, int c) { return sg[(size_t)k * 256 + col0 + c]; }, lds);
            sgemm_tile(au, 1024, fa, [&](int k, int c) { return su[(size_t)k * 256 + col0 + c]; }, lds);
#pragma unroll
            for (int i = 0; i < 4; ++i) { const size_t row = rt * 64 + ty * 4 + i;
                st4(p.shact, row * 256 + col0 + tx * 4, make_float4(siluf_(ag[i][0]) * au[i][0], siluf_(ag[i][1]) * au[i][1], siluf_(ag[i][2]) * au[i][2], siluf_(ag[i][3]) * au[i][3])); }
        }
    }
}

__device__ __noinline__ void phase_route(const Params& p, int l, float* lds) {
    const int tid = threadIdx.x, wid = tid >> 6, lane = tid & 63, bid = blockIdx.x;
    int* asg = (int*)lds;
    unsigned* bm = (unsigned*)lds + 640;
    for (int i = tid; i < 768; i += NTHR) bm[i] = 0u;
    __syncthreads();
    const float4 b4 = *(const float4*)(p.br + l * 256 + lane * 4);
    const float bz_[4] = {b4.x, b4.y, b4.z, b4.w};
    float4 l4n = *(const float4*)(p.logits + (size_t)(bid * 72 + wid) * 256 + lane * 4);
    for (int tl = wid; tl < 72; tl += 8) {
        const int t = bid * 72 + tl;
        const float4 l4 = l4n;
        if (tl + 8 < 72) l4n = *(const float4*)(p.logits + (size_t)(t + 8) * 256 + lane * 4);
        if (l == 1 && (t % LTOT) < CTXL) { if (lane < 8) asg[tl * 8 + lane] = -1; continue; }
        const float lg[4] = {l4.x, l4.y, l4.z, l4.w};
        float s[4], bz[4];
#pragma unroll
        for (int i = 0; i < 4; ++i) { s[i] = sigmoidf_(lg[i]); bz[i] = s[i] + bz_[i]; }
        float m1 = -3.0e38f, m2 = -3.0e38f;
#pragma unroll
        for (int i = 0; i < 4; ++i) { const float v = bz[i]; if (v > m1) { m2 = m1; m1 = v; } else if (v > m2) m2 = v; }
#pragma unroll
        for (int o = 1; o < 8; o <<= 1) { const float o1 = __shfl_xor(m1, o), o2 = __shfl_xor(m2, o); const float n1 = fmaxf(m1, o1), n2 = fmaxf(fminf(m1, o1), fmaxf(m2, o2)); m1 = n1; m2 = n2; }
        const float gs = m1 + m2; const int g = lane >> 3; int rank = 0;
#pragma unroll
        for (int j = 0; j < 8; ++j) { const float o = __int_as_float(__builtin_amdgcn_readlane(__float_as_int(gs), j * 8)); rank += ((o > gs) || (o == gs && j < g)) ? 1 : 0; }
        const bool gsel = rank < 4;
        unsigned key[4];
#pragma unroll
        for (int i = 0; i < 4; ++i) { const unsigned bits = __float_as_uint(bz[i]); const unsigned k = (bits & 0x80000000u) ? ~bits : (bits | 0x80000000u); key[i] = gsel ? k : 0u; }
        unsigned T = 0u;
#pragma unroll 1
        for (int bit = 31; bit >= 0; --bit) {
            const unsigned Tt = T | (1u << bit);
            const int cnt = __builtin_popcountll(__builtin_amdgcn_ballot_w64(key[0] >= Tt)) + __builtin_popcountll(__builtin_amdgcn_ballot_w64(key[1] >= Tt))
                          + __builtin_popcountll(__builtin_amdgcn_ballot_w64(key[2] >= Tt)) + __builtin_popcountll(__builtin_amdgcn_ballot_w64(key[3] >= Tt));
            if (cnt >= 8) T = Tt;
        }
        unsigned long long mg[4], me[4];
        int n_gt = 0;
#pragma unroll
        for (int i = 0; i < 4; ++i) { mg[i] = __builtin_amdgcn_ballot_w64(key[i] > T); me[i] = __builtin_amdgcn_ballot_w64(key[i] == T); n_gt += __builtin_popcountll(mg[i]); }
        const int need_eq = 8 - n_gt;
        const unsigned long long below = (lane == 0) ? 0ull : (~0ull >> (64 - lane));
        int eq_lower = 0;
#pragma unroll
        for (int i = 0; i < 4; ++i) eq_lower += __builtin_popcountll(me[i] & below);
        bool selm[4]; int eqrun = 0;
#pragma unroll
        for (int i = 0; i < 4; ++i) { const bool isgt = key[i] > T, iseq = key[i] == T; selm[i] = isgt || (iseq && (eq_lower + eqrun) < need_eq); eqrun += iseq ? 1 : 0; }
        unsigned long long ms[4]; int pos = 0;
#pragma unroll
        for (int i = 0; i < 4; ++i) { ms[i] = __builtin_amdgcn_ballot_w64(selm[i]); pos += __builtin_popcountll(ms[i] & below); }
        float mysum = 0.f;
#pragma unroll
        for (int i = 0; i < 4; ++i) mysum += selm[i] ? s[i] : 0.f;
        const float inv = 2.5f / wave_sum(mysum);
#pragma unroll
        for (int i = 0; i < 4; ++i) { if (selm[i]) { p.ridx[(size_t)t * 8 + pos] = lane * 4 + i; p.rw[(size_t)t * 8 + pos] = s[i] * inv; asg[tl * 8 + pos] = lane * 4 + i; ++pos;
                atomicOr(&bm[(lane * 4 + i) * 3 + (tl >> 5)], 1u << (tl & 31)); } }
    }
    __syncthreads();
    if (tid < 256) p.cntWG[bid * 256 + tid] = __builtin_popcount(bm[tid * 3]) + __builtin_popcount(bm[tid * 3 + 1]) + __builtin_popcount(bm[tid * 3 + 2]);
    for (int a = tid; a < 576; a += NTHR) { const int e = asg[a];
        if (e >= 0) { const int tl = a >> 3, w = tl >> 5, bit = tl & 31;
            int rk = __builtin_popcount(bm[e * 3 + w] & ((1u << bit) - 1u));
            if (w > 0) rk += __builtin_popcount(bm[e * 3]);
            if (w > 1) rk += __builtin_popcount(bm[e * 3 + 1]);
            p.lrank[(size_t)bid * 576 + a] = rk; } }
    __syncthreads();
}

__device__ __noinline__ void phase_slots(const Params& p, bool skip_ctx, float* lds) {
    const int tid = threadIdx.x, bid = blockIdx.x;
    int* tot = (int*)lds; int* pre = tot + 256; int* off = pre + 256;
    int* part = off + 320;
    {
        const int e = tid & 255, h = tid >> 8;
        int s = 0, mine = 0;
#pragma unroll 8
        for (int w = h * 128; w < h * 128 + 128; ++w) { const int c = p.cntWG[w * 256 + e]; s += c; mine += (w < bid) ? c : 0; }
        part[(h * 2 + 0) * 256 + e] = s; part[(h * 2 + 1) * 256 + e] = mine;
    }
    __syncthreads();
    if (tid < 256) { tot[tid] = part[tid] + part[512 + tid]; pre[tid] = part[256 + tid] + part[768 + tid]; }
    __syncthreads();
    if (tid < 64) {
        const int a0 = tot[tid * 4], a1 = tot[tid * 4 + 1], a2 = tot[tid * 4 + 2], a3 = tot[tid * 4 + 3];
        const int ls = a0 + a1 + a2 + a3; int inc = ls;
#pragma unroll
        for (int o = 1; o < 64; o <<= 1) { const int t2 = __shfl_up(inc, o); if (tid >= o) inc += t2; }
        const int ex = inc - ls;
        off[tid * 4] = ex; off[tid * 4 + 1] = ex + a0; off[tid * 4 + 2] = ex + a0 + a1; off[tid * 4 + 3] = ex + a0 + a1 + a2;
        if (tid == 63) off[256] = inc;
    }
    __syncthreads();
    if (bid == 0 && tid <= 256) p.eoff[tid] = off[tid];
    for (int a = tid; a < 576; a += NTHR) {
        const int t = bid * 72 + (a >> 3);
        if (skip_ctx && (t % LTOT) < CTXL) continue;
        const int e = p.ridx[(size_t)t * 8 + (a & 7)];
        const int slot = off[e] + pre[e] + p.lrank[(size_t)bid * 576 + a];
        p.slot_tok[slot] = t; p.tok_slot[(size_t)t * 8 + (a & 7)] = slot;
    }
}

__device__ __forceinline__ int build_units(const Params& p, int* ustart  ) {
    __syncthreads();
    if (threadIdx.x == 0) { int s = 0; for (int e = 0; e < 256; ++e) { ustart[e] = s; s += (p.eoff[e + 1] - p.eoff[e] + 63) >> 6; } ustart[256] = s; }
    __syncthreads();
    return ustart[256];
}
__device__ __forceinline__ int find_expert(const int* ustart, int ub) { int lo = 0, hi = 255; while (lo < hi) { const int mid = (lo + hi + 1) >> 1; if (ustart[mid] <= ub) lo = mid; else hi = mid - 1; } return lo; }
__device__ __noinline__ void phase_exp_up(const Params& p, int l, float* lds) {
    const int tid = threadIdx.x, ty = tid >> 5, tx = tid & 31;
    int* ustart = (int*)(lds + 4096);
    const int nub = build_units(p, ustart);
    for (int t = blockIdx.x; t < nub * 2; t += gridDim.x) {
        const int ub = t >> 1, ct = t & 1, col0 = ct * 128;
        const int e = find_expert(ustart, ub);
        const int s0 = p.eoff[e] + (ub - ustart[e]) * 64, s1 = p.eoff[e + 1];
        const float* wg = p.eg + ((size_t)l * 256 + e) * 1024 * 256; const float* wu = p.eu + ((size_t)l * 256 + e) * 1024 * 256;
        auto fa = [&](int r, int k) { const int s = s0 + r; return s < s1 ? ldv(p.u, (size_t)p.slot_tok[s] * DM + k) : 0.f; };
        float ag[4][4], au[4][4];
        sgemm_tile(ag, 1024, fa, [&](int k, int c) { return wg[(size_t)k * 256 + col0 + c]; }, lds);
        sgemm_tile(au, 1024, fa, [&](int k, int c) { return wu[(size_t)k * 256 + col0 + c]; }, lds);
#pragma unroll
        for (int i = 0; i < 4; ++i) { const int s = s0 + ty * 4 + i;
            if (s < s1) st4(p.Hs, (size_t)s * 256 + col0 + tx * 4, make_float4(siluf_(ag[i][0]) * au[i][0], siluf_(ag[i][1]) * au[i][1], siluf_(ag[i][2]) * au[i][2], siluf_(ag[i][3]) * au[i][3])); }
    }
}
__device__ __noinline__ void phase_exp_down(const Params& p, int l, float* lds) {
    const int tid = threadIdx.x, ty = tid >> 5, tx = tid & 31;
    int* ustart = (int*)(lds + 4096);
    const int nub = build_units(p, ustart);
    for (int t = blockIdx.x; t < nub * 8; t += gridDim.x) {
        const int ub = t >> 3, ct = t & 7, col0 = ct * 128;
        const int e = find_expert(ustart, ub);
        const int s0 = p.eoff[e] + (ub - ustart[e]) * 64, s1 = p.eoff[e + 1];
        const float* wd = p.ed + ((size_t)l * 256 + e) * 256 * 1024;
        float acc[4][4];
        sgemm_tile(acc, 256,
            [&](int r, int k) { const int s = s0 + r; return s < s1 ? ldv(p.Hs, (size_t)s * 256 + k) : 0.f; },
            [&](int k, int c) { return wd[(size_t)k * 1024 + col0 + c]; }, lds);
#pragma unroll
        for (int i = 0; i < 4; ++i) { const int s = s0 + ty * 4 + i;
            if (s < s1) { const float w = p.slot_w[s]; st4(p.Ys, (size_t)s * DM + col0 + tx * 4, make_float4(acc[i][0] * w, acc[i][1] * w, acc[i][2] * w, acc[i][3] * w)); } }
    }
}

__device__ __noinline__ void phase_ln2(const Params& p, int l) {
    const int wid = threadIdx.x >> 6, lane = threadIdx.x & 63;
    const int stride = gridDim.x * 8;
    int r = blockIdx.x * 8 + wid;
    int4 sa = make_int4(0, 0, 0, 0), sb = sa;
    if (r < T_ALL && !(l == 1 && (r % LTOT) < CTXL)) { sa = *(const int4*)(p.tok_slot + (size_t)r * 8); sb = *(const int4*)(p.tok_slot + (size_t)r * 8 + 4); }
    for (; r < T_ALL; r += stride) {
        const int rn = r + stride;
        int4 na = make_int4(0, 0, 0, 0), nb = na;
        if (rn < T_ALL && !(l == 1 && (rn % LTOT) < CTXL)) { na = *(const int4*)(p.tok_slot + (size_t)rn * 8); nb = *(const int4*)(p.tok_slot + (size_t)rn * 8 + 4); }
        const int sl[8] = {sa.x, sa.y, sa.z, sa.w, sb.x, sb.y, sb.z, sb.w};
        sa = na; sb = nb;
        if (l == 1 && (r % LTOT) < CTXL) continue;
        const float4 wa = *(const float4*)(p.rw + (size_t)r * 8), wb = *(const float4*)(p.rw + (size_t)r * 8 + 4);
        const float wk[8] = {wa.x, wa.y, wa.z, wa.w, wb.x, wb.y, wb.z, wb.w};
        unsigned yraw[8][4];
        const unsigned char* ys8 = (const unsigned char*)p.Ys;
#pragma unroll
        for (int k = 0; k < 8; ++k)
#pragma unroll
            for (int i = 0; i < 4; ++i) yraw[k][i] = *(const unsigned*)(ys8 + (size_t)sl[k] * DM + i * 256 + lane * 4);
        float ft[16];
#pragma unroll
        for (int i = 0; i < 4; ++i) { const int q = *(const int*)((const unsigned char*)p.f + (size_t)r * DM + i * 256 + lane * 4);
            ft[i * 4] = __builtin_amdgcn_cvt_f32_fp8(q, 0) * (1.f / 32.f); ft[i * 4 + 1] = __builtin_amdgcn_cvt_f32_fp8(q, 1) * (1.f / 32.f); ft[i * 4 + 2] = __builtin_amdgcn_cvt_f32_fp8(q, 2) * (1.f / 32.f); ft[i * 4 + 3] = __builtin_amdgcn_cvt_f32_fp8(q, 3) * (1.f / 32.f); }
        float fr8[16];
#pragma unroll
        for (int i = 0; i < 16; ++i) fr8[i] = 0.f;
#pragma unroll
        for (int k = 0; k < 8; ++k)
#pragma unroll
            for (int i = 0; i < 4; ++i) { const int q = (int)yraw[k][i];
                fr8[i * 4] += wk[k] * __builtin_amdgcn_cvt_f32_fp8(q, 0); fr8[i * 4 + 1] += wk[k] * __builtin_amdgcn_cvt_f32_fp8(q, 1); fr8[i * 4 + 2] += wk[k] * __builtin_amdgcn_cvt_f32_fp8(q, 2); fr8[i * 4 + 3] += wk[k] * __builtin_amdgcn_cvt_f32_fp8(q, 3); }
#pragma unroll
        for (int i = 0; i < 16; ++i) ft[i] += fr8[i] * (1.f / 16.f);
        float v[16];
#pragma unroll
        for (int i = 0; i < 4; ++i) { const float4 t = ld4((const bf16_t*)p.hbuf, (size_t)r * DM + i * 256 + lane * 4); v[i * 4] = t.x; v[i * 4 + 1] = t.y; v[i * 4 + 2] = t.z; v[i * 4 + 3] = t.w; }
        const int mi = mod_idx(r);
        const float* m5 = modv(p, l, mi, 5);
#pragma unroll
        for (int i = 0; i < 4; ++i) { const float4 m4 = *(const float4*)(m5 + i * 256 + lane * 4);
            v[i * 4] = ALPHA * v[i * 4] + m4.x * ft[i * 4]; v[i * 4 + 1] = ALPHA * v[i * 4 + 1] + m4.y * ft[i * 4 + 1]; v[i * 4 + 2] = ALPHA * v[i * 4 + 2] + m4.z * ft[i * 4 + 2]; v[i * 4 + 3] = ALPHA * v[i * 4 + 3] + m4.w * ft[i * 4 + 3]; }
        float mu, rstd; ln_stats(v, mu, rstd);
        const float* g = p.ln2g + l * DM; const float* bb = p.ln2b + l * DM;
        const int b = r / LTOT, j = r - b * LTOT;
#pragma unroll
        for (int i = 0; i < 4; ++i) { const int c = i * 256 + lane * 4; const float4 g4 = *(const float4*)(g + c), b4 = *(const float4*)(bb + c);
            v[i * 4 + 0] = (v[i * 4 + 0] - mu) * rstd * g4.x + b4.x; v[i * 4 + 1] = (v[i * 4 + 1] - mu) * rstd * g4.y + b4.y;
            v[i * 4 + 2] = (v[i * 4 + 2] - mu) * rstd * g4.z + b4.z; v[i * 4 + 3] = (v[i * 4 + 3] - mu) * rstd * g4.w + b4.w;
            const float4 o = make_float4(v[i * 4], v[i * 4 + 1], v[i * 4 + 2], v[i * 4 + 3]);
            if (l == 1) { if (j >= CTXL) *(float4*)(p.out + ((size_t)b * SEQ + (j - CTXL)) * DM + c) = o; }
            else st4((bf16_t*)p.hbuf, (size_t)r * DM + c, o); }
        if (l == 0) {
            ln_stats(v, mu, rstd);
            const float* sh = modv(p, 1, mi, 0); const float* sc = modv(p, 1, mi, 1);
#pragma unroll
            for (int i = 0; i < 4; ++i) { const int c = i * 256 + lane * 4; const float4 s4 = *(const float4*)(sh + c), c4 = *(const float4*)(sc + c);
                float4 o; o.x = (v[i * 4 + 0] - mu) * rstd * (1.f + c4.x) + s4.x; o.y = (v[i * 4 + 1] - mu) * rstd * (1.f + c4.y) + s4.y;
                o.z = (v[i * 4 + 2] - mu) * rstd * (1.f + c4.z) + s4.z; o.w = (v[i * 4 + 3] - mu) * rstd * (1.f + c4.w) + s4.w;
                st_fp8x4(p.u8, (size_t)r * DM + c, o); }
        }
    }
}

template <class T> __device__ __forceinline__ T* uni(T* p) { const unsigned long long v = (unsigned long long)p; const unsigned lo = __builtin_amdgcn_readfirstlane((unsigned)v), hi = __builtin_amdgcn_readfirstlane((unsigned)(v >> 32)); return (T*)(((unsigned long long)hi << 32) | lo); }
__device__ __forceinline__ int uni(int v) { return __builtin_amdgcn_readfirstlane(v); }
namespace pg8 {
#define PG8_LAS __attribute__((address_space(3)))
#define GAS __attribute__((address_space(1)))
typedef short bf16x8 __attribute__((ext_vector_type(8)));
typedef float f32x4 __attribute__((ext_vector_type(4)));
typedef unsigned u32x4 __attribute__((ext_vector_type(4)));
constexpr int BM = 256, BK = 64, HALF = 128, HTB = HALF * BK * 2, STAGE_BYTES = 8 * HTB, NXCD = 8, WGM = 8;
__host__ __device__ __forceinline__ int lds_byte(int r, int c) { const int st = (r >> 4) * 2 + (c >> 5), rr = r & 15, cc = c & 31, ob = rr * 64 + cc * 2; return st * 1024 + (ob ^ (((ob >> 9) & 1) << 5)); }
__host__ __device__ __forceinline__ void stage_rc(int b, int& R, int& C) { const int st = b / 1024, sb = b % 1024, swz = sb ^ (((sb >> 9) & 1) << 5); R = (st >> 1) * 16 + swz / 64; C = (st & 1) * 32 + (swz % 64) / 2; }
__host__ __device__ __forceinline__ int perm32(int rho) { const int n = rho >> 4, i = rho & 15; return 8 * (i >> 2) + 4 * n + (i & 3); }
struct Unit { const char* a; const char* b; int pm, pn, aux; };
typedef __bf16 bf16n2 __attribute__((ext_vector_type(2)));
typedef float f32n2 __attribute__((ext_vector_type(2)));
__device__ __forceinline__ unsigned cvt_pk_bf16(float lo, float hi) { return __builtin_bit_cast(unsigned, __builtin_convertvector((f32n2){lo, hi}, bf16n2)); }
__device__ __forceinline__ u32x4 pack8(const f32x4 v0, const f32x4 v1) { u32x4 w; w.x = cvt_pk_bf16(v0[0], v0[1]); w.y = cvt_pk_bf16(v0[2], v0[3]); w.z = cvt_pk_bf16(v1[0], v1[1]); w.w = cvt_pk_bf16(v1[2], v1[3]); return w; }

typedef int i32x8 __attribute__((ext_vector_type(8)));
typedef int i32x4 __attribute__((ext_vector_type(4)));
__device__ __forceinline__ f32x4 mfma_fp8(const bf16x8 (&b)[2], const bf16x8 (&a)[2], f32x4 c) {
    const i32x8 bv = __builtin_shufflevector(__builtin_bit_cast(i32x4, b[0]), __builtin_bit_cast(i32x4, b[1]), 0, 1, 2, 3, 4, 5, 6, 7);
    const i32x8 av = __builtin_shufflevector(__builtin_bit_cast(i32x4, a[0]), __builtin_bit_cast(i32x4, a[1]), 0, 1, 2, 3, 4, 5, 6, 7);
    asm volatile("v_mfma_f32_16x16x128_f8f6f4 %0, %1, %2, %0" : "+v"(c) : "v"(bv), "v"(av));
    return c;
}
typedef unsigned u32x2f __attribute__((ext_vector_type(2)));
__device__ __forceinline__ u32x2f pack8_fp8(const f32x4 v0, const f32x4 v1, const float s) {
    f32x4 a = v0 * s, b = v1 * s;
#pragma unroll
    for (int j = 0; j < 4; ++j) { a[j] = fminf(fmaxf(a[j], -448.f), 448.f); b[j] = fminf(fmaxf(b[j], -448.f), 448.f); }
    int q0 = 0, q1 = 0;
    q0 = __builtin_amdgcn_cvt_pk_fp8_f32(a[0], a[1], q0, false); q0 = __builtin_amdgcn_cvt_pk_fp8_f32(a[2], a[3], q0, true);
    q1 = __builtin_amdgcn_cvt_pk_fp8_f32(b[0], b[1], q1, false); q1 = __builtin_amdgcn_cvt_pk_fp8_f32(b[2], b[3], q1, true);
    return (u32x2f){(unsigned)q0, (unsigned)q1};
}
struct TileOrder {
    int nM, nN, nwg, G, c, sub, pn_off; bool skipctx;
    const char *A0, *B0; size_t a_tile, b_tile, a_sub, b_sub;
    __device__ __forceinline__ unsigned row_off(const Unit&, int) const { return 0u; }
    __device__ void init(int M, int N, int G_, int c_, int sub_) { nM = M / BM; nN = N / BM; nwg = nM * nN; G = G_; c = c_; sub = sub_; skipctx = false; pn_off = 0; }
    __device__ bool next(int i, Unit& u) const {
        const int ti = i / sub, s = i - ti * sub;
        const long L = (long)ti * G + c; if (L >= nwg) return false;
        int wgid = (int)L; { const int q = nwg / NXCD, r = nwg % NXCD, xcd = wgid % NXCD, off = wgid / NXCD; wgid = (xcd < r ? xcd * (q + 1) : r * (q + 1) + (xcd - r) * q) + off; }
        const int nig = WGM * nN, gid = wgid / nig, fm = gid * WGM, gsz = (nM - fm) < WGM ? (nM - fm) : WGM;
        u.pm = fm + ((wgid % nig) % gsz); u.pn = (wgid % nig) / gsz + pn_off; u.aux = s;
        if (skipctx) u.pm = (u.pm >> 3) * 9 + 1 + (u.pm & 7);
        u.a = A0 + (size_t)s * a_sub + (size_t)u.pm * a_tile; u.b = B0 + (size_t)s * b_sub + (size_t)u.pn * b_tile;
        return true;
    }
};

struct CtxKVOrder {
    int G, c; const char *A0, *B0; size_t a_tile, b_tile;
    __device__ __forceinline__ unsigned row_off(const Unit&, int) const { return 0u; }
    __device__ __forceinline__ bool next(int i, Unit& u) const {
        const int uid = i * G + c; if (uid >= 40) return false;
        const int b = uid / 5, k = uid - b * 5;
        u.pm = b * 9; u.pn = k == 0 ? 2 : 8 + k; u.aux = 0;
        u.a = A0 + (size_t)u.pm * a_tile; u.b = B0 + (size_t)u.pn * b_tile;
        return true;
    }
};
template <bool GATHER = false, bool FP8 = false, class Epi, class Sched>
__device__ __forceinline__ void gemm_phase(PG8_LAS unsigned char* lds, const int K, const int lda, const int ldb, const Sched& S, const Epi& E) {
    int tid = threadIdx.x; asm volatile("" : "+v"(tid));
    const int wid = __builtin_amdgcn_readfirstlane(tid >> 6), lane = tid & 63, wr = wid >> 2, wc = wid & 3, fr = lane & 15, fq = lane >> 4;
    const int nt = K / BK;
    unsigned voffA[2], voffB[2];
#pragma unroll
    for (int i = 0; i < 2; ++i) { int R, C; stage_rc(tid * 16 + i * 8192, R, C); const int Rb = (R & ~31) + perm32(R & 31);
        voffA[i] = (unsigned)(R * lda + C) * 2u; voffB[i] = (unsigned)(Rb * ldb + C) * 2u; }
    unsigned gc[2][2], gn[2][2];
    const size_t kstep = (size_t)(BK * 2);
    const size_t hstepA = (size_t)HALF * lda * 2, hstepB = (size_t)HALF * ldb * 2;
    const unsigned ldsw = (unsigned)wid * 1024u;
    const int aoff = lds_byte(wr * 64 + fr, fq * 8), boff = lds_byte(wc * 32 + fr, fq * 8);
#define PG8_SA(b, h) (((b) * 2 + (h)) * HTB)
#define PG8_SB(b, h) ((4 + (b) * 2 + (h)) * HTB)
#define PG8_STAGE(bufoff, gbase, voff) do { _Pragma("unroll") for (int _i = 0; _i < 2; ++_i) \
        __builtin_amdgcn_global_load_lds((const unsigned*)((const char*)(gbase) + (voff)[_i]), (PG8_LAS unsigned*)(lds + (bufoff) + ldsw + _i * 8192), 16, 0, 0); } while (0)
#define PG8_STAGE_A(bufoff, gbase, h, late) do { _Pragma("unroll") for (int _i = 0; _i < 2; ++_i) { \
        const size_t _o = GATHER ? (size_t)(((late) && last) ? gn[h][_i] : gc[h][_i]) : (size_t)voffA[_i] + (size_t)(h) * hstepA; \
        __builtin_amdgcn_global_load_lds((const unsigned*)((const char*)(gbase) + _o), (PG8_LAS unsigned*)(lds + (bufoff) + ldsw + _i * 8192), 16, 0, 0); } } while (0)
#define PG8_GOFF(dst, un) do { if (GATHER) { _Pragma("unroll") for (int _h = 0; _h < 2; ++_h) _Pragma("unroll") for (int _i = 0; _i < 2; ++_i) { int _R, _C; stage_rc(tid * 16 + _i * 8192, _R, _C); dst[_h][_i] = S.row_off(un, _h * HALF + _R) + (unsigned)(_C * 2); } } } while (0)
#define PG8_LDA(dst, b, h) do { _Pragma("unroll") for (int m = 0; m < 4; ++m) _Pragma("unroll") for (int k = 0; k < 2; ++k) dst[m][k] = *(const PG8_LAS bf16x8*)(lds + PG8_SA(b, h) + aoff + m * 2048 + k * 1024); } while (0)
#define PG8_LDB(dst, b, h) do { _Pragma("unroll") for (int n = 0; n < 2; ++n) _Pragma("unroll") for (int k = 0; k < 2; ++k) dst[n][k] = *(const PG8_LAS bf16x8*)(lds + PG8_SB(b, h) + boff + n * 2048 + k * 1024); } while (0)
#define PG8_MMA(ai, bj, At, Bt) do { __builtin_amdgcn_s_setprio(1); _Pragma("unroll") for (int m = 0; m < 4; ++m) _Pragma("unroll") for (int n = 0; n < 2; ++n) { \
        if constexpr (FP8) acc[ai][bj][m][n] = mfma_fp8(Bt[n], At[m], acc[ai][bj][m][n]); \
        else { _Pragma("unroll") for (int k = 0; k < 2; ++k) acc[ai][bj][m][n] = __builtin_amdgcn_mfma_f32_16x16x32_bf16(Bt[n][k], At[m][k], acc[ai][bj][m][n], 0, 0, 0); } } \
        __builtin_amdgcn_s_setprio(0); } while (0)
#define PG8_WAIT_V(n) asm volatile("s_waitcnt vmcnt(" #n ")" ::: "memory")
#define PG8_WAIT_L(n) asm volatile("s_waitcnt lgkmcnt(" #n ")" ::: "memory")
#define PG8_BAR __builtin_amdgcn_s_barrier()
#define PG8_SCHED __builtin_amdgcn_sched_barrier(0)
    Unit cur, nxt; int ui = 0;
    if (!S.next(0, cur)) return;
    f32x4 acc[2][2][4][2];
#pragma unroll
    for (int a = 0; a < 2; ++a)
#pragma unroll
        for (int b = 0; b < 2; ++b)
#pragma unroll
            for (int m = 0; m < 4; ++m)
#pragma unroll
                for (int n = 0; n < 2; ++n) acc[a][b][m][n] = (f32x4){0.f, 0.f, 0.f, 0.f};
    bf16x8 At[4][2], B0[2][2], B1[2][2];
    const char* cA = cur.a; const char* cB = cur.b;
    PG8_GOFF(gc, cur); PG8_GOFF(gn, cur);
    { const bool last = false;
    PG8_STAGE(PG8_SB(0, 0), cB, voffB); PG8_STAGE_A(PG8_SA(0, 0), cA, 0, false); PG8_STAGE(PG8_SB(0, 1), cB + hstepB, voffB); PG8_STAGE_A(PG8_SA(0, 1), cA, 1, false);
    if (wr == 1) PG8_BAR;
    PG8_WAIT_V(4); PG8_BAR;
    PG8_STAGE(PG8_SB(1, 0), cB + kstep, voffB); PG8_STAGE_A(PG8_SA(1, 0), cA + kstep, 0, false); PG8_STAGE(PG8_SB(1, 1), cB + hstepB + kstep, voffB); }
    PG8_WAIT_V(6); PG8_BAR;
    for (;;) {
        const bool has_next = S.next(ui + 1, nxt);
        const char* nA = has_next ? nxt.a : cA; const char* nB = has_next ? nxt.b : cB;
        if (has_next) PG8_GOFF(gn, nxt);
#pragma unroll 1
        for (int t = 0; t < nt; t += 2) {
            const bool last = (t == nt - 2);
            const char* a1 = cA + (size_t)(t + 1) * kstep;
            const char* a2 = last ? nA : cA + (size_t)(t + 2) * kstep; const char* b2 = last ? nB : cB + (size_t)(t + 2) * kstep;
            const char* a3 = a2 + kstep; const char* b3 = b2 + kstep;
            PG8_LDB(B0, 0, 0); PG8_SCHED; PG8_LDA(At, 0, 0); PG8_STAGE_A(PG8_SA(1, 1), a1, 1, false);
            PG8_WAIT_L(8); PG8_BAR; PG8_WAIT_L(0); PG8_MMA(0, 0, At, B0); PG8_BAR; PG8_SCHED;
            PG8_LDB(B1, 0, 1); PG8_STAGE(PG8_SB(0, 0), b2, voffB);
            PG8_BAR; PG8_WAIT_L(0); PG8_MMA(0, 1, At, B1); PG8_BAR;
            PG8_LDA(At, 0, 1); PG8_STAGE_A(PG8_SA(0, 0), a2, 0, true);
            PG8_BAR; PG8_WAIT_L(0); PG8_MMA(1, 0, At, B0); PG8_BAR; PG8_SCHED;
            PG8_STAGE(PG8_SB(0, 1), b2 + hstepB, voffB);
            PG8_WAIT_V(6); PG8_BAR; PG8_MMA(1, 1, At, B1); PG8_BAR;
            PG8_LDB(B0, 1, 0); PG8_SCHED; PG8_LDA(At, 1, 0); PG8_STAGE_A(PG8_SA(0, 1), a2, 1, true);
            PG8_WAIT_L(8); PG8_BAR; PG8_WAIT_L(0); PG8_MMA(0, 0, At, B0); PG8_BAR; PG8_SCHED;
            PG8_LDB(B1, 1, 1); PG8_STAGE(PG8_SB(1, 0), b3, voffB);
            PG8_BAR; PG8_WAIT_L(0); PG8_MMA(0, 1, At, B1); PG8_BAR;
            PG8_LDA(At, 1, 1); PG8_STAGE_A(PG8_SA(1, 0), a3, 0, true);
            PG8_BAR; PG8_WAIT_L(0); PG8_MMA(1, 0, At, B0); PG8_BAR; PG8_SCHED;
            PG8_STAGE(PG8_SB(1, 1), b3 + hstepB, voffB);
            PG8_WAIT_V(6); PG8_BAR; PG8_MMA(1, 1, At, B1); PG8_BAR;
        }
        if constexpr (FP8) asm volatile("s_nop 7\n\ts_nop 7\n\ts_nop 7" ::: "memory");
        const bool keep = E(acc, cur, wr, wc, fr, fq);
        if (!has_next) break;
        if (!keep) {
#pragma unroll
        for (int a = 0; a < 2; ++a)
#pragma unroll
            for (int b = 0; b < 2; ++b)
#pragma unroll
                for (int m = 0; m < 4; ++m)
#pragma unroll
                    for (int n = 0; n < 2; ++n) acc[a][b][m][n] = (f32x4){0.f, 0.f, 0.f, 0.f}; }
        cur = nxt; cA = nA; cB = nB; ++ui;
        if (GATHER) {
#pragma unroll
            for (int _h = 0; _h < 2; ++_h)
#pragma unroll
                for (int _i = 0; _i < 2; ++_i) gc[_h][_i] = gn[_h][_i]; }
    }
    PG8_WAIT_V(0);
    if (wr == 0) PG8_BAR;
    PG8_BAR;
#undef PG8_SA
#undef PG8_SB
#undef PG8_STAGE
#undef PG8_STAGE_A
#undef PG8_GOFF
#undef PG8_LDA
#undef PG8_LDB
#undef PG8_MMA
#undef PG8_WAIT_V
#undef PG8_WAIT_L
#undef PG8_BAR
#undef PG8_SCHED
}
typedef f32x4 Acc[2][2][4][2];

struct EpiStoreBf16 {
    bf16_t* O; int ldc;
    __device__ __forceinline__ bool operator()(Acc& acc, const Unit& u, int wr, int wc, int fr, int fq) const {
        const int row0 = u.pm * BM + wr * 64 + fr, col0 = u.pn * BM + wc * 32 + 8 * fq;
#pragma unroll
        for (int ai = 0; ai < 2; ++ai)
#pragma unroll
            for (int m = 0; m < 4; ++m) { bf16_t* rowp = O + (size_t)(row0 + ai * HALF + m * 16) * ldc + col0;
#pragma unroll
                for (int bj = 0; bj < 2; ++bj) *(GAS u32x4*)(rowp + bj * HALF) = pack8(acc[ai][bj][m][0], acc[ai][bj][m][1]); }
        return false;
    }
};
struct EpiStoreFp8 {
    unsigned char* O; int ldc; float scale;
    __device__ __forceinline__ bool operator()(Acc& acc, const Unit& u, int wr, int wc, int fr, int fq) const {
        const int row0 = u.pm * BM + wr * 64 + fr, col0 = u.pn * BM + wc * 32 + 8 * fq;
#pragma unroll
        for (int ai = 0; ai < 2; ++ai)
#pragma unroll
            for (int m = 0; m < 4; ++m) { unsigned char* rowp = O + (size_t)(row0 + ai * HALF + m * 16) * ldc + col0;
#pragma unroll
                for (int bj = 0; bj < 2; ++bj) *(GAS u32x2f*)(rowp + bj * HALF) = pack8_fp8(acc[ai][bj][m][0], acc[ai][bj][m][1], scale); }
        return false;
    }
};
struct EpiInproj {
    bf16_t* O; unsigned char* Gq; unsigned char* PF;
    __device__ __forceinline__ bool operator()(Acc& acc, const Unit& u, int wr, int wc, int fr, int fq) const {
        const int row0 = u.pm * BM + wr * 64 + fr, cw = wc * 32 + 8 * fq;
        const float sc = (u.pn >= 3 && u.pn < 7) ? 1.f / (16.f * 64.f) : 1.f / (16.f * 256.f);
        if (u.pn >= 3 && u.pn < 7) {
#pragma unroll
            for (int ai = 0; ai < 2; ++ai)
#pragma unroll
                for (int m = 0; m < 4; ++m) { unsigned char* rowp = PF + (size_t)(row0 + ai * HALF + m * 16) * 1024 + (u.pn - 3) * BM + cw;
#pragma unroll
                    for (int bj = 0; bj < 2; ++bj) *(GAS u32x2f*)(rowp + bj * HALF) = pack8_fp8(acc[ai][bj][m][0], acc[ai][bj][m][1], sc * 4.f); }
        } else if (u.pn < 13) {
#pragma unroll
            for (int ai = 0; ai < 2; ++ai)
#pragma unroll
                for (int m = 0; m < 4; ++m) { bf16_t* rowp = O + (size_t)(row0 + ai * HALF + m * 16) * PW + u.pn * BM + cw;
#pragma unroll
                    for (int bj = 0; bj < 2; ++bj) *(GAS u32x4*)(rowp + bj * HALF) = pack8(acc[ai][bj][m][0] * sc, acc[ai][bj][m][1] * sc); }
        } else {
            typedef unsigned u32x2e __attribute__((ext_vector_type(2)));
#pragma unroll
            for (int ai = 0; ai < 2; ++ai)
#pragma unroll
                for (int m = 0; m < 4; ++m) { unsigned char* rowp = Gq + (size_t)(row0 + ai * HALF + m * 16) * 1536 + (((u.pn - 13) * BM + cw) >> 1);
#pragma unroll
                    for (int bj = 0; bj < 2; ++bj) { f32x4 a0 = acc[ai][bj][m][0] * sc, a1 = acc[ai][bj][m][1] * sc;
                        unsigned w4 = 0u;
#pragma unroll
                        for (int j = 0; j < 4; ++j) { const float g0 = __builtin_amdgcn_rcpf(1.f + __expf(-a0[j])), g1 = __builtin_amdgcn_rcpf(1.f + __expf(-a1[j]));
                            const unsigned n0 = (unsigned)fminf(g0 * 16.f, 15.f), n1 = (unsigned)fminf(g1 * 16.f, 15.f);
                            w4 |= (n0 << (4 * j)) | (n1 << (16 + 4 * j)); }
                        *(GAS unsigned*)(rowp + bj * (HALF / 2)) = w4; } }
        }
        return false;
    }
};
struct EpiF32 {
    float* C; int ldc;
    __device__ __forceinline__ bool operator()(Acc& acc, const Unit& u, int wr, int wc, int fr, int fq) const {
        const int row0 = u.pm * BM + wr * 64 + fr, col0 = u.pn * BM + wc * 32 + 8 * fq;
#pragma unroll
        for (int ai = 0; ai < 2; ++ai)
#pragma unroll
            for (int m = 0; m < 4; ++m) { float* rowp = C + (size_t)(row0 + ai * HALF + m * 16) * ldc + col0;
#pragma unroll
                for (int bj = 0; bj < 2; ++bj) { *(GAS f32x4*)(rowp + bj * HALF) = acc[ai][bj][m][0]; *(GAS f32x4*)(rowp + bj * HALF + 4) = acc[ai][bj][m][1]; } }
        return false;
    }
};
__device__ __forceinline__ float fsig(float v) { return __builtin_amdgcn_rcpf(1.f + __expf(-v)); }
__device__ __forceinline__ void unpack8(const u32x4 w, float (&g)[8]) {
    g[0] = __uint_as_float(w.x << 16); g[1] = __uint_as_float(w.x & 0xFFFF0000u); g[2] = __uint_as_float(w.y << 16); g[3] = __uint_as_float(w.y & 0xFFFF0000u);
    g[4] = __uint_as_float(w.z << 16); g[5] = __uint_as_float(w.z & 0xFFFF0000u); g[6] = __uint_as_float(w.w << 16); g[7] = __uint_as_float(w.w & 0xFFFF0000u);
}
struct EpiY {
    const unsigned char* Gq; unsigned char* y;
    __device__ __forceinline__ bool operator()(Acc& acc, const Unit& u, int wr, int wc, int fr, int fq) const {
        const int row0 = u.pm * BM + wr * 64 + fr, col0 = u.pn * BM + wc * 32 + 8 * fq, br = u.aux;
        unsigned ga[2][4][2], gb[2][4][2];
#pragma unroll
        for (int ai = 0; ai < 2; ++ai)
#pragma unroll
            for (int m = 0; m < 4; ++m)
#pragma unroll
                for (int bj = 0; bj < 2; ++bj) { const unsigned char* gp = Gq + (size_t)(row0 + ai * HALF + m * 16) * 1536 + br * 512 + ((col0 + bj * HALF) >> 1);
                    ga[ai][m][bj] = *(const GAS unsigned*)gp; gb[ai][m][bj] = br < 2 ? *(const GAS unsigned*)(gp + 512) : ga[ai][m][bj]; }
#pragma unroll
        for (int ai = 0; ai < 2; ++ai)
#pragma unroll
            for (int m = 0; m < 4; ++m)
#pragma unroll
                for (int bj = 0; bj < 2; ++bj) {
#pragma unroll
                    for (int j = 0; j < 8; ++j) { const float a = (float)((ga[ai][m][bj] >> (4 * j)) & 15u) * (1.f / 16.f) + (1.f / 32.f), b = (float)((gb[ai][m][bj] >> (4 * j)) & 15u) * (1.f / 16.f) + (1.f / 32.f);
                        const float f = br < 2 ? a * __builtin_amdgcn_rcpf(b) : a;
                        if (j < 4) acc[ai][bj][m][0][j] *= f; else acc[ai][bj][m][1][j - 4] *= f; }
                    if (br == 2) *(GAS u32x2f*)(y + (size_t)(row0 + ai * HALF + m * 16) * DM + col0 + bj * HALF) = pack8_fp8(acc[ai][bj][m][0], acc[ai][bj][m][1], 16.f / 4096.f); }
        return br != 2;
    }
};
struct EpiZ {
    const float* hsrc_x; const float* hsrc_ctx; const bf16_t* hbuf; const float* mod2; bf16_t* z; int layer;
    __device__ __forceinline__ bool operator()(Acc& acc, const Unit& u, int wr, int wc, int fr, int fq) const {
        const int b = u.pm / 9, jt = u.pm - b * 9;
        const float* hbase = jt == 0 ? hsrc_ctx + (size_t)b * CTXL * DM : hsrc_x + ((size_t)b * SEQ + (jt - 1) * 256) * DM;
        const bf16_t* hb16 = hbuf + (size_t)u.pm * BM * DM;
        const float* m2 = mod2 + (size_t)(jt == 0 ? 8 : b) * 6144;
        int rl0 = wr * 64 + fr; asm volatile("" : "+v"(rl0));
        const int col0 = u.pn * BM + wc * 32 + 8 * fq;
#pragma unroll
        for (int bj = 0; bj < 2; ++bj) { const int c = col0 + bj * HALF; const f32x4 ma = *(const GAS f32x4*)(m2 + c) * (1.f / 8192.f), mb = *(const GAS f32x4*)(m2 + c + 4) * (1.f / 8192.f);
#pragma unroll
            for (int ai = 0; ai < 2; ++ai) {
                f32x4 h0[4], h1[4];
                if (layer == 0) {
#pragma unroll
                    for (int m = 0; m < 4; ++m) { const float* hp = hbase + (size_t)(rl0 + ai * HALF + m * 16) * DM + c; h0[m] = *(const GAS f32x4*)hp; h1[m] = *(const GAS f32x4*)(hp + 4); }
                } else {
                    u32x4 hr[4];
#pragma unroll
                    for (int m = 0; m < 4; ++m) hr[m] = *(const GAS u32x4*)(hb16 + (size_t)(rl0 + ai * HALF + m * 16) * DM + c);
#pragma unroll
                    for (int m = 0; m < 4; ++m) { float t[8]; unpack8(hr[m], t); h0[m] = (f32x4){t[0], t[1], t[2], t[3]}; h1[m] = (f32x4){t[4], t[5], t[6], t[7]}; }
                }
#pragma unroll
                for (int m = 0; m < 4; ++m) { bf16_t* zp = z + ((size_t)u.pm * BM + rl0 + ai * HALF + m * 16) * DM + c;
                    *(GAS u32x4*)zp = pack8(ALPHA * h0[m] + ma * acc[ai][bj][m][0], ALPHA * h1[m] + mb * acc[ai][bj][m][1]); } } }
        return false;
    }
};
struct EpiG {
    float* logits; bf16_t* shact;
    __device__ __forceinline__ bool operator()(Acc& acc, const Unit& u, int wr, int wc, int fr, int fq) const {
        const int row0 = u.pm * BM + wr * 64 + fr, cw = wc * 32 + 8 * fq;
#pragma unroll
        for (int ai = 0; ai < 2; ++ai)
#pragma unroll
            for (int m = 0; m < 4; ++m) { const size_t row = (size_t)(row0 + ai * HALF + m * 16);
                if (u.pn == 0) {
#pragma unroll
                    for (int bj = 0; bj < 2; ++bj) { float* lp = logits + row * 256 + bj * HALF + cw; *(f32x4*)lp = acc[ai][bj][m][0]; *(GAS f32x4*)(lp + 4) = acc[ai][bj][m][1]; }
                } else {
                    f32x4 v0, v1;
#pragma unroll
                    for (int j = 0; j < 4; ++j) { const float g0 = acc[ai][0][m][0][j], g1 = acc[ai][0][m][1][j];
                        v0[j] = g0 * fsig(g0) * acc[ai][1][m][0][j]; v1[j] = g1 * fsig(g1) * acc[ai][1][m][1][j]; }
                    *(GAS u32x4*)(shact + row * 256 + (u.pn - 1) * 128 + cw) = pack8(v0, v1);
                } }
        return false;
    }
};

struct ExpOrder {
    const PG8_LAS int* ustart; const int* eoff; const int* slot_tok; int nct, nun, G, c; bool gather;
    const char* A; const char* B; size_t b_exp, b_tile; unsigned lda_bytes;
    __device__ __forceinline__ bool next(int i, Unit& u) const {
        const int cv = ((c & 7) << 5) | (c >> 3);
        const int uid = i * G + cv; if (uid >= nun) return false;
        const int ub = uid / nct, ct = uid - ub * nct;
        int lo = 0, hi = 255; while (lo < hi) { const int mid = (lo + hi + 1) >> 1; if (ustart[mid] <= ub) lo = mid; else hi = mid - 1; }
        const int e = lo, s0 = ustart[320 + e] + (ub - ustart[e]) * 256;
        u.pm = s0; u.aux = ustart[320 + e + 1]; u.pn = ct;
        u.b = B + (size_t)e * b_exp + (size_t)ct * b_tile; u.a = gather ? A : A + (size_t)s0 * lda_bytes;
        return true;
    }
    __device__ __forceinline__ unsigned row_off(const Unit& u, int r) const { const int s = u.pm + r; const int t = s < u.aux ? ((const GAS int*)slot_tok)[s] : 0; return (unsigned)t * lda_bytes; }
};
__device__ __forceinline__ u32x4 widen16(const unsigned ax, const unsigned ay, const unsigned bx, const unsigned by) {
    const auto rx = __builtin_amdgcn_permlane16_swap(ax, bx, false, false);
    const auto ry = __builtin_amdgcn_permlane16_swap(ay, by, false, false);
    return (u32x4){rx[0], ry[0], rx[1], ry[1]};
}
struct EpiHs {
    unsigned char* Hs; const float* slot_w;
    __device__ __forceinline__ bool operator()(Acc& acc, const Unit& u, int wr, int wc, int fr, int fq) const {
        const int cw = u.pn * 128 + wc * 32 + 8 * (fq & ~1);
#pragma unroll
        for (int ai = 0; ai < 2; ++ai)
#pragma unroll
            for (int mp = 0; mp < 4; mp += 2) {
                unsigned q[2][2];
#pragma unroll
                for (int d = 0; d < 2; ++d) { const int m = mp + d; const float ws = 4.f / 4096.f;
                    f32x4 v0, v1;
#pragma unroll
                    for (int j = 0; j < 4; ++j) { const float g0 = acc[ai][0][m][0][j] * (1.f / 4096.f), g1 = acc[ai][0][m][1][j] * (1.f / 4096.f);
                        v0[j] = fminf(fmaxf(g0 * fsig(g0) * acc[ai][1][m][0][j] * ws, -448.f), 448.f); v1[j] = fminf(fmaxf(g1 * fsig(g1) * acc[ai][1][m][1][j] * ws, -448.f), 448.f); }
                    int q0 = 0, q1 = 0;
                    q0 = __builtin_amdgcn_cvt_pk_fp8_f32(v0[0], v0[1], q0, false); q0 = __builtin_amdgcn_cvt_pk_fp8_f32(v0[2], v0[3], q0, true);
                    q1 = __builtin_amdgcn_cvt_pk_fp8_f32(v1[0], v1[1], q1, false); q1 = __builtin_amdgcn_cvt_pk_fp8_f32(v1[2], v1[3], q1, true);
                    q[d][0] = (unsigned)q0; q[d][1] = (unsigned)q1; }
                const u32x4 w = widen16(q[0][0], q[0][1], q[1][0], q[1][1]);
                const int s = u.pm + ai * HALF + wr * 64 + (mp + (fq & 1)) * 16 + fr;
                if (s < u.aux) *(GAS u32x4*)(Hs + (size_t)s * 256 + cw) = w; }
        return false;
    }
};
struct EpiYs {
    unsigned char* Ys;
    __device__ __forceinline__ bool operator()(Acc& acc, const Unit& u, int wr, int wc, int fr, int fq) const {
        const int col0 = u.pn * BM + wc * 32 + 8 * (fq & ~1);
#pragma unroll
        for (int ai = 0; ai < 2; ++ai)
#pragma unroll
            for (int mp = 0; mp < 4; mp += 2) { const int s = u.pm + ai * HALF + wr * 64 + (mp + (fq & 1)) * 16 + fr;
#pragma unroll
                for (int bj = 0; bj < 2; ++bj) {
                    unsigned q[2][2];
#pragma unroll
                    for (int d = 0; d < 2; ++d) { f32x4 a0 = acc[ai][bj][mp + d][0] * (1.f / 64.f), a1 = acc[ai][bj][mp + d][1] * (1.f / 64.f);
#pragma unroll
                        for (int j = 0; j < 4; ++j) { a0[j] = fminf(fmaxf(a0[j], -400.f), 400.f); a1[j] = fminf(fmaxf(a1[j], -400.f), 400.f); }
                        int q0 = 0, q1 = 0;
                        q0 = __builtin_amdgcn_cvt_pk_fp8_f32(a0[0], a0[1], q0, false); q0 = __builtin_amdgcn_cvt_pk_fp8_f32(a0[2], a0[3], q0, true);
                        q1 = __builtin_amdgcn_cvt_pk_fp8_f32(a1[0], a1[1], q1, false); q1 = __builtin_amdgcn_cvt_pk_fp8_f32(a1[2], a1[3], q1, true);
                        q[d][0] = (unsigned)q0; q[d][1] = (unsigned)q1; }
                    const u32x4 w = widen16(q[0][0], q[0][1], q[1][0], q[1][1]);
                    if (s < u.aux) *(GAS u32x4*)(Ys + (size_t)s * DM + col0 + bj * HALF) = w; } }
        return false;
    }
};
}

__device__ __forceinline__ void xpose64(const float* src, size_t ldsrc, bf16_t* drow, size_t K) {
#pragma unroll 1
    for (int hh = 0; hh < 2; ++hh) {
        float4 v[32];
#pragma unroll
        for (int j = 0; j < 32; ++j) v[j] = *(const float4*)(src + (size_t)(hh * 32 + j) * ldsrc);
#pragma unroll
        for (int q = 0; q < 4; ++q) { pg8::u32x4 o;
            o.x = pg8::cvt_pk_bf16(v[8 * q + 0].x, v[8 * q + 1].x); o.y = pg8::cvt_pk_bf16(v[8 * q + 2].x, v[8 * q + 3].x); o.z = pg8::cvt_pk_bf16(v[8 * q + 4].x, v[8 * q + 5].x); o.w = pg8::cvt_pk_bf16(v[8 * q + 6].x, v[8 * q + 7].x);
            *(GAS pg8::u32x4*)(drow + hh * 32 + q * 8) = o; }
#pragma unroll
        for (int q = 0; q < 4; ++q) { pg8::u32x4 o;
            o.x = pg8::cvt_pk_bf16(v[8 * q + 0].y, v[8 * q + 1].y); o.y = pg8::cvt_pk_bf16(v[8 * q + 2].y, v[8 * q + 3].y); o.z = pg8::cvt_pk_bf16(v[8 * q + 4].y, v[8 * q + 5].y); o.w = pg8::cvt_pk_bf16(v[8 * q + 6].y, v[8 * q + 7].y);
            *(GAS pg8::u32x4*)(drow + K + hh * 32 + q * 8) = o; }
#pragma unroll
        for (int q = 0; q < 4; ++q) { pg8::u32x4 o;
            o.x = pg8::cvt_pk_bf16(v[8 * q + 0].z, v[8 * q + 1].z); o.y = pg8::cvt_pk_bf16(v[8 * q + 2].z, v[8 * q + 3].z); o.z = pg8::cvt_pk_bf16(v[8 * q + 4].z, v[8 * q + 5].z); o.w = pg8::cvt_pk_bf16(v[8 * q + 6].z, v[8 * q + 7].z);
            *(GAS pg8::u32x4*)(drow + 2 * K + hh * 32 + q * 8) = o; }
#pragma unroll
        for (int q = 0; q < 4; ++q) { pg8::u32x4 o;
            o.x = pg8::cvt_pk_bf16(v[8 * q + 0].w, v[8 * q + 1].w); o.y = pg8::cvt_pk_bf16(v[8 * q + 2].w, v[8 * q + 3].w); o.z = pg8::cvt_pk_bf16(v[8 * q + 4].w, v[8 * q + 5].w); o.w = pg8::cvt_pk_bf16(v[8 * q + 6].w, v[8 * q + 7].w);
            *(GAS pg8::u32x4*)(drow + 3 * K + hh * 32 + q * 8) = o; }
    }
}
__device__ __forceinline__ void phase_wprep(const Params& p, int part, float* lds) {
    int tid_ = threadIdx.x; asm volatile("" : "+v"(tid_));
    const int wid = tid_ >> 6, lane = tid_ & 63;
    const int gw = blockIdx.x * 8 + wid, ngw = gridDim.x * 8;
    {
        const int gtid = blockIdx.x * NTHR + tid_, gn = gridDim.x * NTHR;
        for (int i = gtid; i < 2 * 1024 * 2048 + 256 * 512; i += gn) {
            int ph; bool sn; bf16_t* dst;
            if (i < 2 * 1024 * 2048) { const int par = i >> 21, m = (i >> 11) & 1023, k = i & 2047, n = k & 1023; sn = k >= 1024; ph = ((2 * m + par) * n) & 2047; dst = (par ? p.Do : p.De) + (size_t)m * 2048 + k; }
            else { const int q = i - 2 * 1024 * 2048, kk = q >> 9, k = q & 511, n = k & 255; sn = k >= 256; ph = (8 * kk * n) & 2047; dst = p.Dc + q; }
            const float a = (float)ph * (1.f / 1024.f);
            *dst = f2bf(sn ? -sinpif(a) : cospif(a));
        }
    }
}

#define LDS_U(lds) ((PG8_LAS unsigned char*)(unsigned)__builtin_amdgcn_readfirstlane((unsigned)(unsigned long long)(PG8_LAS unsigned char*)(lds)))
__device__ __forceinline__ void phase_inproj_f(const Params& p, int l_, float* lds, bool deferred) {
    const int l = uni(l_);
    const int NC = l == 1 ? 23 : 24;
    pg8::EpiInproj E; E.O = uni(p.P); E.Gq = uni(p.Gq); E.PF = uni(p.PF);
    {
        pg8::TileOrder S;
        if (!deferred) S.init(l == 1 ? 64 * 256 : T_ALL, NC * 256, gridDim.x, blockIdx.x, 1);
        else { S.init(l == 1 ? 64 * 256 : T_ALL, (25 - NC) * 256, gridDim.x, (blockIdx.x + 128) & 255, 1); S.pn_off = NC; }
        S.skipctx = (l == 1);
        S.A0 = (const char*)uni(p.u8); S.B0 = (const char*)uni(p.Wt_in) + (size_t)l * PW * 1024; S.a_tile = (size_t)256 * 1024; S.b_tile = (size_t)256 * 1024; S.a_sub = 0; S.b_sub = 0;
        pg8::gemm_phase<false, true>(LDS_U(lds), 512, 512, 512, S, E);
    }
    if (l == 1 && !deferred) {
        pg8::CtxKVOrder S; S.G = gridDim.x; S.c = (blockIdx.x + 64) & 255;
        S.A0 = (const char*)uni(p.u8); S.B0 = (const char*)uni(p.Wt_in) + (size_t)l * PW * 1024; S.a_tile = (size_t)256 * 1024; S.b_tile = (size_t)256 * 1024;
        pg8::gemm_phase<false, true>(LDS_U(lds), 512, 512, 512, S, E);
    }
}
__device__ __forceinline__ void phase_ygemm_f(const Params& p, int l_, float* lds) {
    const int l = uni(l_);
    pg8::TileOrder S; S.init(l == 1 ? 64 * 256 : T_ALL, DM, gridDim.x, blockIdx.x, 3); S.skipctx = (l == 1);
    S.A0 = (const char*)uni(p.oa); S.a_sub = (size_t)T_ALL * 512 * 2;
    S.B0 = (const char*)uni(p.Wt_br) + (size_t)l * 3 * 1024 * 512; S.b_sub = (size_t)1024 * 512;
    S.a_tile = (size_t)256 * 512; S.b_tile = (size_t)256 * 512;
    pg8::EpiY E; E.Gq = uni(p.Gq); E.y = (unsigned char*)uni(p.y);
    pg8::gemm_phase<false, true>(LDS_U(lds), 256, 256, 256, S, E);
}
__device__ __forceinline__ void phase_outproj_f(const Params& p, int l_, float* lds) {
    const int l = uni(l_);
    pg8::TileOrder S; S.init(l == 1 ? 64 * 256 : T_ALL, DM, gridDim.x, blockIdx.x, 1); S.skipctx = (l == 1);
    S.A0 = (const char*)uni(p.y); S.B0 = (const char*)uni(p.Wt_out) + (size_t)l * 1024 * 1024; S.a_tile = (size_t)256 * 1024; S.b_tile = (size_t)256 * 1024; S.a_sub = 0; S.b_sub = 0;
    pg8::EpiZ E; E.hsrc_x = uni(p.x); E.hsrc_ctx = uni(p.ctx); E.hbuf = (const bf16_t*)uni(p.hbuf); E.mod2 = uni(p.mod) + (size_t)l * 9 * 6144 + 2 * 1024; E.z = (bf16_t*)uni(p.z); E.layer = l;
    pg8::gemm_phase<false, true>(LDS_U(lds), 512, 512, 512, S, E);
}
__device__ __forceinline__ void phase_router_shared_f(const Params& p, int l_, float* lds) {
    const int l = uni(l_);
    pg8::TileOrder S; S.init(l == 1 ? 64 * 256 : T_ALL, 768, gridDim.x, blockIdx.x, 1); S.skipctx = (l == 1);
    S.A0 = (const char*)uni(p.u); S.B0 = (const char*)(uni(p.Wt_g) + (size_t)l * 768 * 1024); S.a_tile = (size_t)256 * 1024 * 2; S.b_tile = (size_t)256 * 1024 * 2; S.a_sub = 0; S.b_sub = 0;
    pg8::EpiG E; E.logits = uni(p.logits); E.shact = uni(p.shact);
    pg8::gemm_phase(LDS_U(lds), 1024, 1024, 1024, S, E);
}
__device__ __forceinline__ void phase_shdown_f(const Params& p, int l_, float* lds) {
    const int l = uni(l_);
    pg8::TileOrder S; S.init(l == 1 ? 64 * 256 : T_ALL, DM, gridDim.x, blockIdx.x, 1); S.skipctx = (l == 1);
    S.A0 = (const char*)uni(p.shact); S.B0 = (const char*)(uni(p.Wt_sd) + (size_t)l * 1024 * 256); S.a_tile = (size_t)256 * 256 * 2; S.b_tile = (size_t)256 * 256 * 2; S.a_sub = 0; S.b_sub = 0;
    pg8::EpiStoreFp8 E; E.O = (unsigned char*)uni(p.f); E.ldc = DM; E.scale = 32.f;
    pg8::gemm_phase(LDS_U(lds), 256, 256, 256, S, E);
}

__device__ __noinline__ void phase_normrope(const Params& p, int l) {
    const int wid = threadIdx.x >> 6, lane = threadIdx.x & 63, li = lane & 7;
    float qg[8], kg[8];
#pragma unroll
    for (int j = 0; j < 8; ++j) { qg[j] = p.qn[l * 64 + li * 8 + j]; kg[j] = p.kn[l * 64 + li * 8 + j]; }
    const int tio = (li >> 2) * 16 + (li & 1) * 8;
    pg8::u32x4 raw[4], rawn[4]; float4 tb[4], tbn[4];
    auto load = [&](int r, pg8::u32x4 (&rw)[4], float4 (&t)[4]) {
        const int b = r / LTOT, j0 = r - b * LTOT; const int s = j0 >= CTXL ? j0 - CTXL : 0;
        t[0] = *(const float4*)(p.ropec + s * 32 + tio); t[1] = *(const float4*)(p.ropec + s * 32 + tio + 4); t[2] = *(const float4*)(p.ropes + s * 32 + tio); t[3] = *(const float4*)(p.ropes + s * 32 + tio + 4);
        const bf16_t* row = p.P + (size_t)r * PW;
        rw[0] = *(const pg8::u32x4*)(row + C_QA + lane * 8);
        rw[1] = lane < 16 ? *(const pg8::u32x4*)(row + C_KA + lane * 8) : (pg8::u32x4){0u, 0u, 0u, 0u};
        rw[2] = *(const pg8::u32x4*)(row + C_QC + lane * 8);
        rw[3] = *(const pg8::u32x4*)(row + C_KC + lane * 8); };
    const int stride = gridDim.x * 8;
    int r = blockIdx.x * 8 + wid;
    if (r < T_ALL) load(r, raw, tb);
    for (; r < T_ALL; r += stride) {
        if (r + stride < T_ALL) load(r + stride, rawn, tbn);
        const int b = r / LTOT, j0 = r - b * LTOT; const bool lat = j0 >= CTXL;
        float cs[8], sn[8];
        cs[0] = tb[0].x; cs[1] = tb[0].y; cs[2] = tb[0].z; cs[3] = tb[0].w; cs[4] = tb[1].x; cs[5] = tb[1].y; cs[6] = tb[1].z; cs[7] = tb[1].w;
        sn[0] = tb[2].x; sn[1] = tb[2].y; sn[2] = tb[2].z; sn[3] = tb[2].w; sn[4] = tb[3].x; sn[5] = tb[3].y; sn[6] = tb[3].z; sn[7] = tb[3].w;
        if (!lat) {
#pragma unroll
            for (int j = 0; j < 8; ++j) { cs[j] = 1.f; sn[j] = 0.f; } }
        bf16_t* row = p.P + (size_t)r * PW;
#pragma unroll
        for (int i = 0; i < 4; ++i) {
            float x[8]; pg8::unpack8(raw[i], x);
            if (i < 2) {
                float ss = 0.f;
#pragma unroll
                for (int j = 0; j < 8; ++j) ss += x[j] * x[j];
                ss += __shfl_xor(ss, 1); ss += __shfl_xor(ss, 2); ss += __shfl_xor(ss, 4);
                const float sc = rsqrtf(ss * (1.f / 64.f) + 1e-6f);
#pragma unroll
                for (int j = 0; j < 8; ++j) x[j] *= sc * (i == 0 ? qg[j] : kg[j]);
            }
            float y[8];
#pragma unroll
            for (int j = 0; j < 8; ++j) { const float pr = __shfl_xor(x[j], 2); const float rot = (li & 2) ? pr : -pr; y[j] = x[j] * cs[j] + rot * sn[j]; }
            pg8::u32x4 o; o.x = pg8::cvt_pk_bf16(y[0], y[1]); o.y = pg8::cvt_pk_bf16(y[2], y[3]); o.z = pg8::cvt_pk_bf16(y[4], y[5]); o.w = pg8::cvt_pk_bf16(y[6], y[7]);
            const int col = i == 0 ? C_QA : i == 1 ? C_KA : i == 2 ? C_QC : C_KC;
            if (i != 1 || lane < 16) *(pg8::u32x4*)(row + col + lane * 8) = o;
        }
#pragma unroll
        for (int i = 0; i < 4; ++i) { raw[i] = rawn[i]; tb[i] = tbn[i]; }
    }
}
__device__ __noinline__ void phase_xt(const Params& p, bool do_ctx, float* lds) {
    const int wid = threadIdx.x >> 6, lane = threadIdx.x & 63;
    bf16_t* te = (bf16_t*)lds + wid * (2 * 64 * 72);
    bf16_t* to = te + 64 * 72;
    __syncthreads();
    const int gw = blockIdx.x * 8 + wid, ngw = gridDim.x * 8;
    const int nlat = 8 * 2 * 8 * 16, nctx = do_ctx ? 8 * 2 * 8 * 4 : 0;
    for (int it = gw; it < nlat + nctx; it += ngw) {
        const bool lat = it < nlat; const int q = lat ? it : it - nlat;
        int b, wh, cb, nb;
        if (lat) { b = q >> 8; wh = (q >> 7) & 1; cb = (q >> 4) & 7; nb = q & 15; } else { b = q >> 6; wh = (q >> 5) & 1; cb = (q >> 2) & 7; nb = q & 3; }
        const int r8 = lane >> 3, c8 = (lane & 7) * 8;
#pragma unroll
        for (int i = 0; i < 8; ++i) {
            const int n = nb * 64 + i * 8 + r8;
            const size_t row = (size_t)b * LTOT + (lat ? CTXL + n : n);
            const unsigned char* src = p.PF + row * 1024 + wh * 512 + cb * 64 + c8;
            float x0[8], x1[8];
            typedef float f32x2x __attribute__((ext_vector_type(2)));
            { const pg8::u32x2f w0 = *(const GAS pg8::u32x2f*)src, w1 = lat ? *(const GAS pg8::u32x2f*)(src + (size_t)1024 * 1024) : w0;
#pragma unroll
              for (int h = 0; h < 2; ++h) { const int a = (int)(h ? w0.y : w0.x), bq = (int)(h ? w1.y : w1.x);
                  const f32x2x a0 = __builtin_amdgcn_cvt_pk_f32_fp8(a, false), a1 = __builtin_amdgcn_cvt_pk_f32_fp8(a, true), b0 = __builtin_amdgcn_cvt_pk_f32_fp8(bq, false), b1 = __builtin_amdgcn_cvt_pk_f32_fp8(bq, true);
                  x0[4 * h] = a0[0] * 0.25f; x0[4 * h + 1] = a0[1] * 0.25f; x0[4 * h + 2] = a1[0] * 0.25f; x0[4 * h + 3] = a1[1] * 0.25f;
                  x1[4 * h] = b0[0] * 0.25f; x1[4 * h + 1] = b0[1] * 0.25f; x1[4 * h + 2] = b1[0] * 0.25f; x1[4 * h + 3] = b1[1] * 0.25f; } }
#pragma unroll
            for (int j = 0; j < 8; ++j) { te[(c8 + j) * 72 + i * 8 + r8] = f2bf(lat ? x0[j] + x1[j] : x0[j]); if (lat) to[(c8 + j) * 72 + i * 8 + r8] = f2bf(x0[j] - x1[j]); }
        }
        asm volatile("s_waitcnt lgkmcnt(0)" ::: "memory");
#pragma unroll
        for (int i = 0; i < 8; ++i) {
            const int cc = i * 8 + r8;
            const size_t xr = (size_t)b * 512 + cb * 64 + cc;
            if (lat) {
                *(GAS pg8::u32x4*)(p.XTe + xr * 2048 + wh * 1024 + nb * 64 + c8) = *(const pg8::u32x4*)(te + cc * 72 + c8);
                *(GAS pg8::u32x4*)(p.XTo + xr * 2048 + wh * 1024 + nb * 64 + c8) = *(const pg8::u32x4*)(to + cc * 72 + c8);
            } else *(GAS pg8::u32x4*)(p.XTc + xr * 512 + wh * 256 + nb * 64 + c8) = *(const pg8::u32x4*)(te + cc * 72 + c8);
        }
        asm volatile("s_waitcnt lgkmcnt(0)" ::: "memory");
    }
    for (int it = gw; it < 8 * 10 * 36; it += ngw) {
        const int b = it / 360, r = it - b * 360, cb = r / 36, kb = r - cb * 36;
        const int scol = cb < 2 ? C_VA + cb * 64 : C_VC + (cb - 2) * 64;
        bf16_t* dst = cb < 2 ? p.VTa + ((size_t)b * 128 + cb * 64) * LTOT : p.VTc + ((size_t)b * 512 + (cb - 2) * 64) * LTOT;
        const int r8 = lane >> 3, c8 = (lane & 7) * 8;
#pragma unroll
        for (int i = 0; i < 8; ++i) {
            const bf16_t* s = p.P + ((size_t)b * LTOT + kb * 64 + i * 8 + r8) * PW + scol + c8;
            const pg8::u32x4 w = *(const pg8::u32x4*)s;
            const unsigned ww[4] = {w.x, w.y, w.z, w.w};
#pragma unroll
            for (int j = 0; j < 8; ++j) te[(c8 + j) * 72 + i * 8 + r8] = (bf16_t)(ww[j >> 1] >> ((j & 1) * 16));
        }
        asm volatile("s_waitcnt lgkmcnt(0)" ::: "memory");
#pragma unroll
        for (int i = 0; i < 8; ++i) { const int cc = i * 8 + r8;
            *(GAS pg8::u32x4*)(dst + (size_t)cc * LTOT + kb * 64 + c8) = *(const pg8::u32x4*)(te + cc * 72 + c8); }
        asm volatile("s_waitcnt lgkmcnt(0)" ::: "memory");
    }
}
namespace pg8 {
struct FoOrder {
    const char *De, *Do, *XTe, *XTo; int nun, G, c; bool ctx;
    __device__ __forceinline__ unsigned row_off(const Unit&, int) const { return 0u; }
    __device__ __forceinline__ bool next(int i, Unit& u) const {
        const int uid = i * G + c; if (uid >= nun) return false;
        u.pm = ctx ? 0 : uid >> 4; u.pn = uid & 15; u.aux = 0;
        const size_t kb = ctx ? 512 * 2 : 2048 * 2;
        u.a = (u.pm < 4 ? De + (size_t)u.pm * 256 * kb : Do + (size_t)(u.pm - 4) * 256 * kb);
        u.b = (u.pm < 4 ? XTe : XTo) + (size_t)u.pn * 256 * kb;
        return true;
    }
};
struct EpiFo {
    unsigned char* ob; float scale; bool ctx;
    __device__ __forceinline__ bool operator()(Acc& acc, const Unit& u, int wr, int wc, int fr, int fq) const {
        const int b = u.pn >> 1, col0 = (u.pn & 1) * 256 + wc * 32 + 8 * fq;
        const int par = u.pm >> 2, m0 = (u.pm & 3) * 256;
#pragma unroll
        for (int ai = 0; ai < 2; ++ai)
#pragma unroll
            for (int m = 0; m < 4; ++m) { const int rl = ai * HALF + wr * 64 + m * 16 + fr;
                const size_t row = (size_t)b * LTOT + (ctx ? rl : CTXL + 2 * (m0 + rl) + par);
#pragma unroll
                for (int bj = 0; bj < 2; ++bj) *(GAS u32x2f*)(ob + row * 512 + col0 + bj * HALF) = pack8_fp8(acc[ai][bj][m][0], acc[ai][bj][m][1], scale * 16.f); }
        return false;
    }
};
}
__device__ __forceinline__ void phase_fourier_f(const Params& p, bool do_ctx, float* lds) {
    {
        pg8::FoOrder S; S.De = (const char*)uni(p.De); S.Do = (const char*)uni(p.Do); S.XTe = (const char*)uni(p.XTe); S.XTo = (const char*)uni(p.XTo); S.nun = 128; S.G = gridDim.x; S.c = blockIdx.x; S.ctx = false;
        pg8::EpiFo E; E.ob = (unsigned char*)uni(p.ob); E.scale = 1.f / 512.f; E.ctx = false;
        pg8::gemm_phase<false>(LDS_U(lds), 2048, 2048, 2048, S, E);
    }
    if (do_ctx) {
        pg8::FoOrder S; S.De = (const char*)uni(p.Dc); S.Do = S.De; S.XTe = (const char*)uni(p.XTc); S.XTo = S.XTe; S.nun = 16; S.G = gridDim.x; S.c = (blockIdx.x + 56) & 255; S.ctx = true;
        pg8::EpiFo E; E.ob = (unsigned char*)uni(p.ob); E.scale = 0.00552427172802f; E.ctx = true;
        pg8::gemm_phase<false>(LDS_U(lds), 512, 512, 512, S, E);
    }
}

namespace fa {
typedef short bf16x8 __attribute__((ext_vector_type(8)));
typedef short bf16x4 __attribute__((ext_vector_type(4)));
typedef float f32x16 __attribute__((ext_vector_type(16)));
typedef unsigned u32x2 __attribute__((ext_vector_type(2)));
typedef float f32x2 __attribute__((ext_vector_type(2)));
#define FA_KROW 144
#define FA_VROW 136
#define FA_C 0.18033688011f
template <int DV>
__device__ __forceinline__ void attn_unit_f(const Params& p, const int l, const int b, const int head, const int qblk, const bool ctxq, LAS unsigned char* lds, int tid) {
    constexpr int NK = DV == 64 ? 1 : 2, NDT = DV / 32, BUFSZ = NK * 64 * FA_KROW + DV * FA_VROW, NCH = DV == 64 ? 1 : 2;
    const int wid = __builtin_amdgcn_readfirstlane(tid >> 6), lane = tid & 63, lq = lane & 31, lh = lane >> 5;
    const int nt = ctxq ? 4 : 36;
    const bf16_t* P = uni(p.P);
    const size_t rowb = (size_t)b * LTOT;
    int tok0, qcol, kmap;
    if (DV == 64) { tok0 = qblk * 64 + (wid & 1) * 32; qcol = C_QA + (head * 4 + (wid >> 1)) * 64; kmap = 0; }
    else { tok0 = qblk * 128 + (wid & 3) * 32; qcol = C_QC + head * 128 + (wid >> 2) * 64; kmap = wid >> 2; }
    const size_t qrow = rowb + (ctxq ? 0 : CTXL) + tok0 + lq;
    bf16x8 Q[4];
#pragma unroll
    for (int ks = 0; ks < 4; ++ks) Q[ks] = *(const GAS bf16x8*)(P + qrow * PW + qcol + ks * 16 + 8 * lh);
    const bf16_t* ksrc[NCH]; const bf16_t* vsrc[NCH]; int kdst[NCH], vdst[NCH];
#pragma unroll
    for (int i = 0; i < NCH; ++i) {
        const int c = tid + i * NTHR, mm = c >> 9, key = (c >> 3) & 63, piece = c & 7;
        ksrc[i] = P + (rowb + key) * PW + (DV == 64 ? C_KA + head * 64 : C_KC + head * 128 + mm * 64) + piece * 8;
        kdst[i] = mm * 64 * FA_KROW + key * FA_KROW + piece * 16;
        const int d = c >> 3;
        vsrc[i] = (DV == 64 ? uni(p.VTa) + ((size_t)(b * 2 + head) * 64 + d) * LTOT : uni(p.VTc) + ((size_t)(b * 4 + head) * 128 + d) * LTOT) + piece * 8;
        vdst[i] = NK * 64 * FA_KROW + d * FA_VROW + piece * 16;
    }
    pg8::u32x4 kreg[NCH], vreg[NCH];
#define FA_LOAD(t) do { _Pragma("unroll") for (int _i = 0; _i < NCH; ++_i) { kreg[_i] = *(const GAS pg8::u32x4*)(ksrc[_i] + (size_t)(t) * 64 * PW); vreg[_i] = *(const GAS pg8::u32x4*)(vsrc[_i] + (t) * 64); } } while (0)
#define FA_WRITE(bufo) do { _Pragma("unroll") for (int _i = 0; _i < NCH; ++_i) { *(LAS pg8::u32x4*)(lds + (bufo) + kdst[_i]) = kreg[_i]; \
        *(LAS u32x2*)(lds + (bufo) + vdst[_i]) = (u32x2){vreg[_i].x, vreg[_i].y}; *(LAS u32x2*)(lds + (bufo) + vdst[_i] + 8) = (u32x2){vreg[_i].z, vreg[_i].w}; } } while (0)
    f32x16 O[NDT];
#pragma unroll
    for (int dt = 0; dt < NDT; ++dt)
#pragma unroll
        for (int i = 0; i < 16; ++i) O[dt][i] = 0.f;
    float mrow = -1.0e30f, lrow = 0.f;
    __syncthreads();
    FA_LOAD(0); FA_WRITE(0); FA_LOAD(1); FA_WRITE(BUFSZ); FA_LOAD(2);
    const int koff = kmap * 64 * FA_KROW + lq * FA_KROW + 16 * lh;
    const int voff = NK * 64 * FA_KROW + lq * FA_VROW + 8 * lh;
    f32x16 S0, S1;
    constexpr bool HOISTK = (DV == 64);
    bf16x8 kf[8];
#define FA_KREAD(bufo) do { _Pragma("unroll") for (int ks = 0; ks < 4; ++ks) { kf[2 * ks] = *(const LAS bf16x8*)(lds + (bufo) + koff + ks * 32); kf[2 * ks + 1] = *(const LAS bf16x8*)(lds + (bufo) + koff + ks * 32 + 32 * FA_KROW); } } while (0)
#define FA_QK(A0, A1) do { _Pragma("unroll") for (int i = 0; i < 16; ++i) { A0[i] = 0.f; A1[i] = 0.f; } __builtin_amdgcn_s_setprio(1); \
        _Pragma("unroll") for (int ks = 0; ks < 4; ++ks) { \
            A0 = __builtin_amdgcn_mfma_f32_32x32x16_bf16(kf[2 * ks], Q[ks], A0, 0, 0, 0); \
            A1 = __builtin_amdgcn_mfma_f32_32x32x16_bf16(kf[2 * ks + 1], Q[ks], A1, 0, 0, 0); } __builtin_amdgcn_s_setprio(0); } while (0)
    __syncthreads();
    FA_KREAD(0); FA_QK(S0, S1);
    int bcur = 0, bnx1 = BUFSZ, bnx2 = 2 * BUFSZ;
#pragma unroll 1
    for (int t = 0; t < nt; ++t) {
        __syncthreads();
        if (t + 2 < nt) FA_WRITE(bnx2);
        if (t + 3 < nt) FA_LOAD(t + 3);
        if (HOISTK && t + 1 < nt) FA_KREAD(bnx1);
        constexpr int NVF = DV == 64 ? 4 : 0;
        pg8::u32x4 vf[NVF > 0 ? NVF : 1][2];
#pragma unroll
        for (int q4 = 0; q4 < NVF; ++q4)
#pragma unroll
            for (int dt = 0; dt < 2; ++dt) { const int a = bcur + voff + dt * 32 * FA_VROW + q4 * 32;
                const u32x2 lo = *(const LAS u32x2*)(lds + a), hi = *(const LAS u32x2*)(lds + a + 16); vf[q4][dt] = (pg8::u32x4){lo.x, lo.y, hi.x, hi.y}; }
        f32x16 N0, N1;
        if (t + 1 < nt) { if (!HOISTK) FA_KREAD(bnx1); FA_QK(N0, N1); }
        float mx;
        { float m8[8];
#pragma unroll
          for (int i = 0; i < 8; ++i) asm("v_max3_f32 %0, %1, %2, %3" : "=v"(m8[i]) : "v"(S0[2 * i]), "v"(S0[2 * i + 1]), "v"(S1[2 * i]));
#pragma unroll
          for (int i = 0; i < 4; ++i) asm("v_max3_f32 %0, %1, %2, %3" : "=v"(m8[i]) : "v"(m8[i]), "v"(S1[4 * i + 1]), "v"(S1[4 * i + 3]));
          float a, b, c, d;
          asm("v_max3_f32 %0, %1, %2, %3" : "=v"(a) : "v"(m8[0]), "v"(m8[1]), "v"(m8[2]));
          asm("v_max3_f32 %0, %1, %2, %3" : "=v"(b) : "v"(m8[3]), "v"(m8[4]), "v"(m8[5]));
          asm("v_max3_f32 %0, %1, %2, %3" : "=v"(c) : "v"(m8[6]), "v"(m8[7]), "v"(a));
          asm("v_max3_f32 %0, %1, %2, %3" : "=v"(d) : "v"(b), "v"(c), "v"(mrow));
          mx = d; }
        float mnew; { const auto sw = __builtin_amdgcn_permlane32_swap(__float_as_uint(mx), __float_as_uint(mx), false, false); mnew = fmaxf(__uint_as_float(sw[0]), __uint_as_float(sw[1])); }
        if (__builtin_amdgcn_ballot_w64(mnew > mrow) != 0ull) {
            const float alpha = __builtin_amdgcn_exp2f((mrow - mnew) * FA_C);
            lrow *= alpha;
#pragma unroll
            for (int dt = 0; dt < NDT; ++dt)
#pragma unroll
                for (int i = 0; i < 16; ++i) O[dt][i] *= alpha;
            mrow = mnew;
        }
        const float mc = mrow * FA_C;
        f32x2 rs2 = {0.f, 0.f};
#pragma unroll
        for (int i = 0; i < 8; ++i) {
            f32x2 e0 = {S0[2 * i], S0[2 * i + 1]}, e1 = {S1[2 * i], S1[2 * i + 1]};
            e0 = e0 * FA_C - mc; e1 = e1 * FA_C - mc;
            e0.x = __builtin_amdgcn_exp2f(e0.x); e0.y = __builtin_amdgcn_exp2f(e0.y); e1.x = __builtin_amdgcn_exp2f(e1.x); e1.y = __builtin_amdgcn_exp2f(e1.y);
            S0[2 * i] = e0.x; S0[2 * i + 1] = e0.y; S1[2 * i] = e1.x; S1[2 * i + 1] = e1.y;
            rs2 += e0 + e1;
        }
        lrow += rs2.x + rs2.y;
#pragma unroll
        for (int kh = 0; kh < 2; ++kh)
#pragma unroll
            for (int s2 = 0; s2 < 2; ++s2) {
                pg8::u32x4 pw;
                if (kh == 0) { pw.x = pg8::cvt_pk_bf16(S0[8 * s2], S0[8 * s2 + 1]); pw.y = pg8::cvt_pk_bf16(S0[8 * s2 + 2], S0[8 * s2 + 3]); pw.z = pg8::cvt_pk_bf16(S0[8 * s2 + 4], S0[8 * s2 + 5]); pw.w = pg8::cvt_pk_bf16(S0[8 * s2 + 6], S0[8 * s2 + 7]); }
                else { pw.x = pg8::cvt_pk_bf16(S1[8 * s2], S1[8 * s2 + 1]); pw.y = pg8::cvt_pk_bf16(S1[8 * s2 + 2], S1[8 * s2 + 3]); pw.z = pg8::cvt_pk_bf16(S1[8 * s2 + 4], S1[8 * s2 + 5]); pw.w = pg8::cvt_pk_bf16(S1[8 * s2 + 6], S1[8 * s2 + 7]); }
                const bf16x8 pf = __builtin_bit_cast(bf16x8, pw);
#pragma unroll
                for (int dt = 0; dt < NDT; ++dt) {
                    pg8::u32x4 vw;
                    if (dt < 2 && kh * 2 + s2 < NVF) vw = vf[kh * 2 + s2 < NVF ? kh * 2 + s2 : 0][dt];
                    else { const int a = bcur + voff + dt * 32 * FA_VROW + (kh * 32 + 16 * s2) * 2;
                        const u32x2 lo = *(const LAS u32x2*)(lds + a), hi = *(const LAS u32x2*)(lds + a + 16); vw = (pg8::u32x4){lo.x, lo.y, hi.x, hi.y}; }
                    O[dt] = __builtin_amdgcn_mfma_f32_32x32x16_bf16(__builtin_bit_cast(bf16x8, vw), pf, O[dt], 0, 0, 0);
                }
            }
        S0 = N0; S1 = N1;
        { const int tmp = bcur; bcur = bnx1; bnx1 = bnx2; bnx2 = tmp; }
    }
#undef FA_QK
#undef FA_KREAD
    { const auto sw = __builtin_amdgcn_permlane32_swap(__float_as_uint(lrow), __float_as_uint(lrow), false, false); lrow = __uint_as_float(sw[0]) + __uint_as_float(sw[1]); }
    const float inv = 1.f / lrow;
    const size_t orow = rowb + (ctxq ? 0 : CTXL) + tok0 + lq;
    if (DV == 64) {
        unsigned char* o = (unsigned char*)uni(p.oa) + orow * 512 + (head * 4 + (wid >> 1)) * 64 + 4 * lh;
        const float i16 = inv * 16.f;
#pragma unroll
        for (int dt = 0; dt < NDT; ++dt)
#pragma unroll
            for (int g4 = 0; g4 < 4; ++g4) { int q = 0;
                q = __builtin_amdgcn_cvt_pk_fp8_f32(fminf(fmaxf(O[dt][4 * g4] * i16, -448.f), 448.f), fminf(fmaxf(O[dt][4 * g4 + 1] * i16, -448.f), 448.f), q, false);
                q = __builtin_amdgcn_cvt_pk_fp8_f32(fminf(fmaxf(O[dt][4 * g4 + 2] * i16, -448.f), 448.f), fminf(fmaxf(O[dt][4 * g4 + 3] * i16, -448.f), 448.f), q, true);
                *(GAS int*)(o + dt * 32 + 8 * g4) = q; }
    } else {
        __syncthreads();
        LAS float* xch = (LAS float*)lds + (wid & 3) * (64 * 64) + lane;
        if (wid >= 4) {
#pragma unroll
            for (int dt = 0; dt < NDT; ++dt)
#pragma unroll
                for (int i = 0; i < 16; ++i) xch[(dt * 16 + i) * 64] = O[dt][i] * inv;
        }
        __syncthreads();
        if (wid < 4) {
            const float lam = uni(p.lam)[l];
            float ss = 0.f;
#pragma unroll
            for (int dt = 0; dt < NDT; ++dt)
#pragma unroll
                for (int i = 0; i < 16; ++i) { const float v = O[dt][i] * inv - lam * xch[(dt * 16 + i) * 64]; O[dt][i] = v; ss += v * v; }
            { const auto sw = __builtin_amdgcn_permlane32_swap(__float_as_uint(ss), __float_as_uint(ss), false, false); ss = __uint_as_float(sw[0]) + __uint_as_float(sw[1]); }
            const float sc = rsqrtf(ss * (1.f / 128.f) + 1e-6f) * (1.f - lam_init_of(l)) * 16.f;
            const float* gsub = uni(p.subln) + l * 128 + 4 * lh;
            unsigned char* o = (unsigned char*)uni(p.oc) + orow * 512 + head * 128 + 4 * lh;
#pragma unroll
            for (int dt = 0; dt < NDT; ++dt)
#pragma unroll
                for (int g4 = 0; g4 < 4; ++g4) { const pg8::f32x4 g = *(const GAS pg8::f32x4*)(gsub + dt * 32 + 8 * g4);
                    int q = 0;
                    q = __builtin_amdgcn_cvt_pk_fp8_f32(fminf(fmaxf(O[dt][4 * g4] * sc * g.x, -448.f), 448.f), fminf(fmaxf(O[dt][4 * g4 + 1] * sc * g.y, -448.f), 448.f), q, false);
                    q = __builtin_amdgcn_cvt_pk_fp8_f32(fminf(fmaxf(O[dt][4 * g4 + 2] * sc * g.z, -448.f), 448.f), fminf(fmaxf(O[dt][4 * g4 + 3] * sc * g.w, -448.f), 448.f), q, true);
                    *(GAS int*)(o + dt * 32 + 8 * g4) = q; }
        }
    }
#undef FA_LOAD
#undef FA_WRITE
}
}
__device__ __noinline__ void phase_conv_dma(const Params& p, int mode, int l, int t_begin, int ntiles, int t_step, float* ldsf);
__device__ __noinline__ void phase_conv_ring(const Params& p, int l, int chunk, float* ldsf, unsigned* ctr);
__device__ __forceinline__ void phase_attn_f(const Params& p, int l_, bool do_ctx, unsigned char* smem, float* ldsf) {
    const int l = uni(l_);
    LAS unsigned char* lds = LDS_U(ldsf);
    unsigned* ctr = uni(p.actr) + l * 32 + (blockIdx.x & 7);
    volatile LAS unsigned* slot = (volatile LAS unsigned*)smem + 8;
    const int NA = do_ctx ? 144 : 128;
    const int LIM = l == 0 ? CONV_LIM0 : 384;
    bool have_next = false;
    for (;;) {
        int tid = threadIdx.x; asm volatile("" : "+v"(tid));
        __syncthreads();
        if (tid == 0) { const unsigned k = have_next ? *(volatile LAS unsigned*)36 : atomicAdd(ctr, 1u), q = blockIdx.x & 7; unsigned item;
            int a = -1, j = -1;
            const int G2 = NA < LIM / 2 ? NA : LIM / 2;
            if (k < 3u * G2) { const int g = (int)(k / 3u), r = (int)(k - 3u * (unsigned)g); if (r == 0) a = g; else j = 2 * g + (r - 1); }
            else { const int k2 = (int)(k - 3u * G2); if (k2 < NA - G2) a = G2 + k2; else j = 2 * G2 + (k2 - (NA - G2)); }
            if (a >= 0) item = a < 64 ? q * 64 + a : a < 128 ? 512 + q * 64 + (a - 64) : a < 136 ? 1024 + q * 8 + (a - 128) : 1088 + q * 8 + (a - 136);
            else item = j < LIM ? (0x10000u | (q * 384 + (unsigned)j)) : 0xFFFFFFFFu;
            *slot = item; }
        __syncthreads();
        const unsigned us = (unsigned)__builtin_amdgcn_readfirstlane((int)*slot);
        if (us == 0xFFFFFFFFu) break;
        if (us & 0x10000u) { const int ch = (int)(us & 0xFFFFu); phase_conv_ring(p, l, ch, ldsf, ctr); have_next = true; continue; }
        have_next = false;
        const int u = (int)us;
        if (u < 512) fa::attn_unit_f<128>(p, l, u >> 6, (u >> 4) & 3, u & 15, false, lds, tid);
        else if (u < 1024) { const int v = u - 512; fa::attn_unit_f<64>(p, l, v >> 6, (v >> 5) & 1, v & 31, false, lds, tid); }
        else if (u < 1088) { const int v = u - 1024; fa::attn_unit_f<128>(p, l, v >> 3, (v >> 1) & 3, v & 1, true, lds, tid); }
        else { const int v = u - 1088; fa::attn_unit_f<64>(p, l, v >> 3, (v >> 2) & 1, v & 3, true, lds, tid); }
    }
}

__device__ __forceinline__ void conv_fill(const Params& p, int l, int lim, int maxchunks, float* ldsf) {
    unsigned* ctr2 = uni(p.actr) + l * 32 + 8 + (blockIdx.x & 7);
    volatile LAS unsigned* slot = (volatile LAS unsigned*)32;
    for (int c = 0; c < maxchunks; ++c) {
        int tid = threadIdx.x; asm volatile("" : "+v"(tid));
        __syncthreads();
        if (tid == 0) *slot = atomicAdd(ctr2, 1u);
        __syncthreads();
        const int j = lim + __builtin_amdgcn_readfirstlane((int)*slot);
        if (j >= 384) break;
        const int ch = (blockIdx.x & 7) * 384 + j;
        phase_conv_ring(p, l, ch, ldsf, nullptr);
    }
}
__device__ __forceinline__ void xpose64x2(const float* src, size_t ldsrc, bf16_t* drow, size_t K) {
    typedef float f2v __attribute__((ext_vector_type(2)));
    f2v v[64];
#pragma unroll
    for (int j = 0; j < 64; ++j) v[j] = __builtin_nontemporal_load((const f2v*)(src + (size_t)j * ldsrc));
#pragma unroll
    for (int q = 0; q < 8; ++q) { pg8::u32x4 o;
        o.x = pg8::cvt_pk_bf16(v[8 * q + 0].x, v[8 * q + 1].x); o.y = pg8::cvt_pk_bf16(v[8 * q + 2].x, v[8 * q + 3].x); o.z = pg8::cvt_pk_bf16(v[8 * q + 4].x, v[8 * q + 5].x); o.w = pg8::cvt_pk_bf16(v[8 * q + 6].x, v[8 * q + 7].x);
        *(pg8::u32x4*)(drow + q * 8) = o; }
#pragma unroll
    for (int q = 0; q < 8; ++q) { pg8::u32x4 o;
        o.x = pg8::cvt_pk_bf16(v[8 * q + 0].y, v[8 * q + 1].y); o.y = pg8::cvt_pk_bf16(v[8 * q + 2].y, v[8 * q + 3].y); o.z = pg8::cvt_pk_bf16(v[8 * q + 4].y, v[8 * q + 5].y); o.w = pg8::cvt_pk_bf16(v[8 * q + 6].y, v[8 * q + 7].y);
        *(pg8::u32x4*)(drow + K + q * 8) = o; }
}
__device__ __forceinline__ void phase_econv(const Params& p, int l, float* lds) {
    int tid_ = threadIdx.x; asm volatile("" : "+v"(tid_));
    const int wid = tid_ >> 6, lane = tid_ & 63;
    const int gw = blockIdx.x * 8 + wid, ngw = gridDim.x * 8;
    for (int it = gw; it < 256 * 96; it += ngw) {
        const int e = it / 96, r = it - e * 96;
        if (r < 64) { const int m = r >> 5, nb = (r >> 4) & 1, kb = r & 15, n = nb * 128 + lane * 2;
            const float* w = (m ? p.eu : p.eg) + ((size_t)l * 256 + e) * 1024 * 256;
            const int row = nb * 256 + m * 128 + lane * 2;
            xpose64x2(w + (size_t)kb * 64 * 256 + n, 256, p.Wt_e1 + (size_t)e * 512 * 1024 + (size_t)row * 1024 + kb * 64, 1024);
        } else { const int q = r - 64, nb = q >> 2, kb = q & 3, n = nb * 128 + lane * 2;
            xpose64x2(p.ed + ((size_t)l * 256 + e) * 256 * 1024 + (size_t)kb * 64 * 1024 + n, 1024, p.Wt_e2 + (size_t)e * 1024 * 256 + (size_t)n * 256 + kb * 64, 256); }
    }
}
struct ConvTile { const float* src; size_t rs; bf16_t* dst; bool skip; float f8; };
__device__ __forceinline__ ConvTile conv_tile(const Params& p, int mode, int l, int tile, int n) {
    ConvTile c; c.skip = false; c.f8 = 0.f;
    if (mode == 0) {
        const int e = tile / 48, r = tile - e * 48;
        if (r < 32) { const int m = r >> 4, kb = r & 15; c.src = (m ? p.eu : p.eg) + ((size_t)l * 256 + e) * 1024 * 256 + (size_t)kb * 64 * 256; c.rs = 256;
            c.dst = p.Wt_e1 + (size_t)e * 512 * 1024 + (size_t)((n >> 7) * 256 + m * 128 + (n & 127)) * 1024 + kb * 64; }
        else { const int q = r - 32, nb = q >> 2, kb = q & 3; c.src = p.ed + ((size_t)l * 256 + e) * 256 * 1024 + (size_t)kb * 64 * 1024 + nb * 256; c.rs = 1024;
            c.dst = p.Wt_e2 + (size_t)e * 1024 * 256 + (size_t)(nb * 256 + n) * 256 + kb * 64; }
    } else if (mode == 1) {
        const int ll = tile / 592; int r = tile - ll * 592;
        if (r < 368) { const int nb = r >> 4, kb = r & 15, ns = nb * 256 + n;
            c.skip = (nb == 3 || nb == 4);
            c.src = p.w_in + (size_t)ll * 1024 * IN_W + (size_t)kb * 64 * IN_W + nb * 256; c.rs = IN_W;
            c.dst = (bf16_t*)((unsigned char*)p.Wt_in + (size_t)ll * PW * 1024 + (size_t)(ns < 768 ? ns : ns + 512) * 1024 + kb * 64); c.f8 = 256.f; }
        else if (r < 368 + 96) { const int q = r - 368, br = q >> 5, nb = (q >> 3) & 3, kb = q & 7;
            c.src = (br == 0 ? p.wa : br == 1 ? p.wb : p.wc) + (size_t)ll * 512 * 1024 + (size_t)kb * 64 * 1024 + nb * 256; c.rs = 1024;
            c.dst = (bf16_t*)((unsigned char*)p.Wt_br + ((size_t)ll * 3 + br) * 1024 * 512 + (size_t)(nb * 256 + n) * 512 + kb * 64); c.f8 = 256.f; }
        else if (r < 368 + 96 + 64) { const int q = r - 464, nb = q >> 4, kb = q & 15;
            c.src = p.wout + (size_t)ll * 1024 * 1024 + (size_t)kb * 64 * 1024 + nb * 256; c.rs = 1024;
            c.dst = (bf16_t*)((unsigned char*)p.Wt_out + (size_t)ll * 1024 * 1024 + (size_t)(nb * 256 + n) * 1024 + kb * 64); c.f8 = 512.f; }
        else if (r < 368 + 96 + 64 + 48) { const int q = r - 528, m = q >> 4, kb = q & 15;
            c.src = (m == 0 ? p.wr : m == 1 ? p.sg : p.su) + (size_t)ll * 1024 * 256 + (size_t)kb * 64 * 256; c.rs = 256;
            c.dst = p.Wt_g + (size_t)ll * 768 * 1024 + (size_t)(m == 0 ? n : 256 + (n >> 7) * 256 + (m - 1) * 128 + (n & 127)) * 1024 + kb * 64; }
        else { const int q = r - 576, nb = q >> 2, kb = q & 3;
            c.src = p.sd + (size_t)ll * 256 * 1024 + (size_t)kb * 64 * 1024 + nb * 256; c.rs = 1024;
            c.dst = p.Wt_sd + (size_t)ll * 1024 * 256 + (size_t)(nb * 256 + n) * 256 + kb * 64; }
    } else {
        const int ll = tile >> 6, nb = (tile >> 4) & 3, kb = tile & 15;
        c.src = p.WF + (size_t)ll * 1024 * 1024 + (size_t)kb * 64 * 1024 + nb * 256; c.rs = 1024;
        c.dst = (bf16_t*)((unsigned char*)p.Wt_in + (size_t)ll * PW * 1024 + (size_t)(768 + nb * 256 + n) * 1024 + kb * 64); c.f8 = 64.f;
    }
    return c;
}
__device__ __noinline__ void phase_conv_dma(const Params& p, int mode, int l, int t_begin, int ntiles, int t_step, float* ldsf) {
    const int tid = threadIdx.x, wid = tid >> 6, lane = tid & 63;
    LAS unsigned char* lds = (LAS unsigned char*)ldsf;
    const int kc = lane & 7, nl = wid * 32 + (lane >> 3);
    constexpr int SLOT = 65536 + 128;
    __syncthreads();
    int t = t_begin;
    auto issue = [&](int tile, int slot) {
        const ConvTile c = conv_tile(p, mode, l, tile, 0);
#pragma unroll
        for (int j = 0; j < 8; ++j) { const int row = wid * 8 + j;
            __builtin_amdgcn_global_load_lds((const unsigned*)(c.src + (size_t)row * c.rs + lane * 4), (LAS unsigned*)(lds + slot * SLOT + row * 1024 + wid * 16), 16, 0, 2); }
    };
    if (t < ntiles) issue(t, 0);
    for (int i = 0; t < ntiles; t += t_step, ++i) {
        asm volatile("s_waitcnt vmcnt(0)" ::: "memory");
        __syncthreads();
        if (t + t_step < ntiles) issue(t + t_step, (i + 1) & 1);
        if (conv_tile(p, mode, l, t, 0).skip) continue;
        const LAS float* base = (const LAS float*)(lds + (i & 1) * SLOT) + (kc * 8) * 256 + kc * 4;
#pragma unroll
        for (int it = 0; it < 4; ++it) { const int n = nl + it * 8;
            const ConvTile c = conv_tile(p, mode, l, t, n);
            float x[8];
#pragma unroll
            for (int k = 0; k < 8; ++k) x[k] = base[k * 256 + n];
            if (c.f8 != 0.f) {
                typedef unsigned u32x2e __attribute__((ext_vector_type(2)));
#pragma unroll
                for (int k = 0; k < 8; ++k) x[k] = fminf(fmaxf(x[k] * c.f8, -448.f), 448.f);
                int q0 = 0, q1 = 0;
                q0 = __builtin_amdgcn_cvt_pk_fp8_f32(x[0], x[1], q0, false); q0 = __builtin_amdgcn_cvt_pk_fp8_f32(x[2], x[3], q0, true);
                q1 = __builtin_amdgcn_cvt_pk_fp8_f32(x[4], x[5], q1, false); q1 = __builtin_amdgcn_cvt_pk_fp8_f32(x[6], x[7], q1, true);
                *(GAS u32x2e*)((unsigned char*)c.dst + kc * 8) = (u32x2e){(unsigned)q0, (unsigned)q1};
            } else {
            pg8::u32x4 o;
            o.x = pg8::cvt_pk_bf16(x[0], x[1]); o.y = pg8::cvt_pk_bf16(x[2], x[3]); o.z = pg8::cvt_pk_bf16(x[4], x[5]); o.w = pg8::cvt_pk_bf16(x[6], x[7]);
            __builtin_nontemporal_store(o, (GAS pg8::u32x4*)(c.dst + kc * 8)); } }
    }
    asm volatile("s_waitcnt vmcnt(0)" ::: "memory");
    __syncthreads();
}
__device__ __noinline__ void phase_conv_ring(const Params& p, int l, int chunk, float* ldsf, unsigned* ctr) {
    const int tid = threadIdx.x, wid = tid >> 6, lane = tid & 63;
    LAS unsigned char* lds = (LAS unsigned char*)ldsf;
    const float* const eg_ = uni(p.eg); const float* const eu_ = uni(p.eu); const float* const ed_ = uni(p.ed);
    unsigned char* const w1_ = (unsigned char*)uni(p.Wt_e1); unsigned char* const w2_ = (unsigned char*)uni(p.Wt_e2);
    const int kc = lane & 7, n = wid * 8 + (lane >> 3);
    constexpr int SLOT = 32768 + 128;
    const int t0 = chunk * 8;
    auto issue = [&](int jt) {
        const int tile = t0 + jt, e = tile / 96, r = tile - e * 96;
        const float* src; int rs;
        if (r < 64) { const int m = r >> 5, kb = (r >> 2) & 7, nq = r & 3; src = (m ? eu_ : eg_) + ((size_t)l * 256 + e) * 1024 * 256 + (size_t)kb * 128 * 256 + nq * 64; rs = 256; }
        else { const int q = r - 64, nb = q >> 1, kb = q & 1; src = ed_ + ((size_t)l * 256 + e) * 256 * 1024 + (size_t)kb * 128 * 1024 + nb * 64; rs = 1024; }
#pragma unroll
        for (int q = 0; q < 4; ++q) { const int row = wid * 16 + q * 4 + (lane >> 4);
            __builtin_amdgcn_global_load_lds((const unsigned*)(src + (size_t)row * rs + (lane & 15) * 4), (LAS unsigned*)(lds + (jt & 3) * SLOT + (wid * 16 + q * 4) * 256 + wid * 16), 16, 0, 2); } };
    __syncthreads();
    unsigned kn; asm volatile("v_mov_b32 %0, 0" : "=v"(kn));
    issue(0); issue(1); issue(2);
#pragma unroll
    for (int jt = 0; jt < 8; ++jt) {
        if (jt < 6) asm volatile("s_waitcnt vmcnt(8)" ::: "memory");
        else if (jt == 6) asm volatile("s_waitcnt vmcnt(4)" ::: "memory");
        else asm volatile("s_waitcnt vmcnt(0)" ::: "memory");
        asm volatile("s_waitcnt lgkmcnt(0)" ::: "memory"); __builtin_amdgcn_s_barrier(); asm volatile("" ::: "memory");
        if (jt + 3 < 8) issue(jt + 3);
        if (jt == 5 && ctr != nullptr && tid == 0) kn = __hip_atomic_fetch_add((GAS unsigned*)ctr, 1u, __ATOMIC_RELAXED, __HIP_MEMORY_SCOPE_AGENT);
        const int tile = t0 + jt, e = tile / 96, r = tile - e * 96;
        const LAS float* base = (const LAS float*)(lds + (jt & 3) * SLOT) + (kc * 16) * 64 + kc * 4 + n;
        float x[16];
#pragma unroll
        for (int k = 0; k < 16; ++k) x[k] = fminf(fmaxf(base[k * 64] * 256.f, -448.f), 448.f);
        unsigned char* dst;
        if (r < 64) { const int m = r >> 5, kb = (r >> 2) & 7, nq = r & 3, nn = nq * 64 + n; dst = w1_ + (size_t)e * 512 * 1024 + (size_t)((nn >> 7) * 256 + m * 128 + (nn & 127)) * 1024 + kb * 128; }
        else { const int q = r - 64, nb = q >> 1, kb = q & 1; dst = w2_ + (size_t)e * 1024 * 256 + (size_t)(nb * 64 + n) * 256 + kb * 128; }
        pg8::i32x4 o;
#pragma unroll
        for (int q = 0; q < 4; ++q) { int w8 = 0; w8 = __builtin_amdgcn_cvt_pk_fp8_f32(x[4 * q], x[4 * q + 1], w8, false); w8 = __builtin_amdgcn_cvt_pk_fp8_f32(x[4 * q + 2], x[4 * q + 3], w8, true); o[q] = w8; }
        __builtin_nontemporal_store(o, (GAS pg8::i32x4*)(dst + kc * 16));
    }
    if (ctr != nullptr && tid == 0) *(volatile LAS unsigned*)36 = kn;
    asm volatile("s_waitcnt lgkmcnt(0)" ::: "memory"); __builtin_amdgcn_s_barrier(); asm volatile("" ::: "memory");
}
__device__ __forceinline__ int build_units256(const Params& p, int* ustart  ) {
    int tid_ = threadIdx.x; asm volatile("" : "+v"(tid_));
    __syncthreads();
    if (tid_ <= 256) ustart[320 + tid_] = p.eoff[tid_];
    __syncthreads();
    if (tid_ == 0) { int s = 0; for (int e = 0; e < 256; ++e) { ustart[e] = s; s += (ustart[320 + e + 1] - ustart[320 + e] + 255) >> 8; } ustart[256] = s; }
    __syncthreads();
    return ustart[256];
}
__device__ __forceinline__ void phase_exp_up_f(const Params& p, int* ustart, float* lds) {
    const int nub = uni(build_units256(p, ustart));
    pg8::ExpOrder S; S.ustart = (const PG8_LAS int*)ustart; S.eoff = uni(p.eoff); S.slot_tok = uni(p.slot_tok); S.nct = 2; S.nun = nub * 2; S.G = gridDim.x; S.c = blockIdx.x; S.gather = true;
    S.A = (const char*)uni(p.u8); S.B = (const char*)uni(p.Wt_e1); S.b_exp = (size_t)512 * 1024; S.b_tile = (size_t)256 * 1024; S.lda_bytes = 1024u;
    pg8::EpiHs E; E.Hs = (unsigned char*)uni(p.Hs); E.slot_w = uni(p.slot_w);
    pg8::gemm_phase<true, true>(LDS_U(lds), 512, 512, 512, S, E);
}
__device__ __forceinline__ void phase_exp_down_f(const Params& p, int* ustart, float* lds) {
    const int nub = uni(build_units256(p, ustart));
    pg8::ExpOrder S; S.ustart = (const PG8_LAS int*)ustart; S.eoff = uni(p.eoff); S.slot_tok = uni(p.slot_tok); S.nct = 4; S.nun = nub * 4; S.G = gridDim.x; S.c = blockIdx.x; S.gather = false;
    S.A = (const char*)uni(p.Hs); S.B = (const char*)uni(p.Wt_e2); S.b_exp = (size_t)1024 * 256; S.b_tile = (size_t)256 * 256; S.lda_bytes = 256u;
    pg8::EpiYs E; E.Ys = (unsigned char*)uni(p.Ys);
    pg8::gemm_phase<false, true>(LDS_U(lds), 128, 128, 128, S, E);
}

__global__ void __launch_bounds__(NTHR, 2) fwd(Params pk) {
    extern __shared__ __attribute__((aligned(16))) unsigned char smem[];
    if (threadIdx.x == 0) *(uint4*)smem = make_uint4(0u, 0u, 0u, 0u);
    Params* ps = (Params*)(smem + 64);
    if (threadIdx.x < sizeof(Params) / 8) ((unsigned long long*)ps)[threadIdx.x] = ((const unsigned long long*)&pk)[threadIdx.x];
    __syncthreads();
    const Params& p = *ps;
    (void)xcd_barrier_post(pk.bar, (volatile LAS unsigned*)smem);
#define GRID_BARRIER() do { XcdBarrier _b; _b.bar = uni(ps->bar); _b.x = xb_xcc_id(); _b.st = (volatile LAS unsigned*)smem; xcd_barrier(_b); } while (0)
    int* ustart = (int*)(smem + 1024);
    float* lds = (float*)(smem + 4096);
    phase_pro(p, lds);
    phase_wprep(p, 0, lds);
    phase_conv_dma(p, 1, 0, blockIdx.x, 2 * 592, gridDim.x, lds);
    GRID_BARRIER();
    phase_conv_dma(p, 2, 0, blockIdx.x, 128, gridDim.x, lds);
    phase_lnmod0(p);
    GRID_BARRIER();
#pragma unroll 1
    for (int l = 0; l < 2; ++l) {
        phase_inproj_f(p, l, lds, false);
        GRID_BARRIER();
        phase_normrope(p, l);
        phase_xt(p, l == 0, lds);
        GRID_BARRIER();
        phase_inproj_f(p, l, lds, true);
        phase_fourier_f(p, l == 0, lds);
        phase_attn_f(p, l, l == 0, smem, lds);
        GRID_BARRIER();
        phase_ygemm_f(p, l, lds);
        if (l == 0 && blockIdx.x >= 32) conv_fill(p, 0, CONV_LIM0, 3, lds);
        GRID_BARRIER();
        phase_outproj_f(p, l, lds);
        if (l == 0 && blockIdx.x >= 32) conv_fill(p, 0, CONV_LIM0, 2, lds);
        GRID_BARRIER();
        phase_ln1(p, l);
        GRID_BARRIER();
        phase_router_shared_f(p, l, lds);
        GRID_BARRIER();
        phase_route(p, l, lds);
        phase_shdown_f(p, l, lds);
        GRID_BARRIER();
        phase_slots(p, l == 1, lds);
        conv_fill(p, l, l == 0 ? CONV_LIM0 : 384, 1 << 20, lds);
        GRID_BARRIER();
        phase_exp_up_f(p, ustart, lds);
        GRID_BARRIER();
        phase_exp_down_f(p, ustart, lds);
        GRID_BARRIER();
        phase_ln2(p, l);
        GRID_BARRIER();
    }
}

static inline size_t bump(size_t& off, size_t bytes) { const size_t o = off; off = (off + bytes + 255) & ~(size_t)255; return o; }

extern "C" void kernel_launch(void* const* d_in, const int* in_sizes, int n_in, void* d_out, int out_size, void* d_ws, size_t ws_size, hipStream_t stream) {
    static int grid = 0;
    if (grid == 0) {
        int dev = 0, cus = 0, per_cu = 0;
        hipGetDevice(&dev);
        hipDeviceGetAttribute(&cus, hipDeviceAttributeMultiprocessorCount, dev);
        hipFuncSetAttribute((const void*)fwd, hipFuncAttributeMaxDynamicSharedMemorySize, LDS_BYTES);
        hipOccupancyMaxActiveBlocksPerMultiprocessor(&per_cu, (const void*)fwd, NTHR, LDS_BYTES);
        (void)hipGetLastError();
        grid = 256;
        if (cus < 256 || per_cu < 1) fprintf(stderr, "kernel_launch: needs 256 CUs with one resident workgroup each (cus %d, per_cu %d)\n", cus, per_cu);
    }
    Params p{};
    const float* const* in = (const float* const*)d_in;
    p.x = in[0]; p.c = in[1]; p.ctx = in[2]; p.c_ctx = in[3]; p.w_mod = in[4]; p.b_mod = in[5]; p.w_in = in[6]; p.qn = in[7]; p.kn = in[8];
    p.lq1 = in[9]; p.lk1 = in[10]; p.lq2 = in[11]; p.lk2 = in[12]; p.subln = in[13]; p.wa = in[14]; p.wb = in[15]; p.wc = in[16]; p.wout = in[17];
    p.ln1g = in[18]; p.ln1b = in[19]; p.wr = in[20]; p.br = in[21]; p.sg = in[22]; p.su = in[23]; p.sd = in[24]; p.eg = in[25]; p.eu = in[26]; p.ed = in[27];
    p.ln2g = in[28]; p.ln2b = in[29];
    p.out = (float*)d_out;
    char* ws = (char*)d_ws; size_t off = 0;
    p.bar = (unsigned*)(ws + bump(off, XCD_BAR_WORDS * 4));
    p.mod = (float*)(ws + bump(off, (size_t)2 * 9 * 6144 * 4));
    p.WF = (float*)(ws + bump(off, (size_t)2 * 1024 * 1024 * 4));
    p.ropec = (float*)(ws + bump(off, 2048 * 32 * 4)); p.ropes = (float*)(ws + bump(off, 2048 * 32 * 4));
    p.tc = (float*)(ws + bump(off, 2048 * 4)); p.ts = (float*)(ws + bump(off, 2048 * 4));
    p.lam = (float*)(ws + bump(off, 256));
    p.hbuf = (float*)(ws + bump(off, (size_t)T_ALL * DM * 4));
    p.z = (float*)(ws + bump(off, (size_t)T_ALL * DM * 4));
    p.logits = (float*)(ws + bump(off, (size_t)T_ALL * 256 * 4));
    p.f = (float*)(ws + bump(off, (size_t)T_ALL * DM * 4));
    p.slot_w = (float*)(ws + bump(off, (size_t)NSLOT * 4));
    p.rw = (float*)(ws + bump(off, (size_t)T_ALL * 8 * 4));
    p.ridx = (int*)(ws + bump(off, (size_t)T_ALL * 8 * 4));
    p.lrank = (int*)(ws + bump(off, (size_t)256 * 576 * 4));
    p.cntWG = (int*)(ws + bump(off, (size_t)256 * 256 * 4));
    p.slot_tok = (int*)(ws + bump(off, (size_t)NSLOT * 4));
    p.tok_slot = (int*)(ws + bump(off, (size_t)T_ALL * 8 * 4));
    p.eoff = (int*)(ws + bump(off, 257 * 4));
    p.u = (act_t*)(ws + bump(off, (size_t)T_ALL * DM * sizeof(act_t)));
    p.u8 = (unsigned char*)(ws + bump(off, (size_t)T_ALL * DM));
    p.PF = (unsigned char*)(ws + bump(off, (size_t)T_ALL * 1024));
    p.oa = (act_t*)(ws + bump(off, (size_t)T_ALL * 512 * sizeof(act_t)));
    p.ob = (act_t*)(ws + bump(off, (size_t)T_ALL * 512 * sizeof(act_t)));
    p.oc = (act_t*)(ws + bump(off, (size_t)T_ALL * 512 * sizeof(act_t)));
    p.y = (act_t*)(ws + bump(off, (size_t)T_ALL * DM * sizeof(act_t)));
    p.shact = (act_t*)(ws + bump(off, (size_t)T_ALL * 256 * sizeof(act_t)));
    p.Hs = (act_t*)(ws + bump(off, (size_t)(NSLOT + 256) * 256 * sizeof(act_t)));
    p.Wt_e1 = (bf16_t*)(ws + bump(off, (size_t)256 * 512 * 1024 * 2));
    p.Wt_e2 = (bf16_t*)(ws + bump(off, (size_t)256 * 1024 * 256 * 2));
    p.Wt_in = (bf16_t*)(ws + bump(off, (size_t)2 * PW * 1024 * 2));
    p.Wt_br = (bf16_t*)(ws + bump(off, (size_t)2 * 3 * 1024 * 512 * 2));
    p.Wt_out = (bf16_t*)(ws + bump(off, (size_t)2 * 1024 * 1024 * 2));
    p.Wt_g = (bf16_t*)(ws + bump(off, (size_t)2 * 768 * 1024 * 2));
    p.Wt_sd = (bf16_t*)(ws + bump(off, (size_t)2 * 1024 * 256 * 2));
    p.ytmp = (float*)(ws + bump(off, (size_t)T_ALL * DM * 4));
    p.Gq = (unsigned char*)(ws + bump(off, (size_t)T_ALL * 3072));
    p.VTa = (bf16_t*)(ws + bump(off, (size_t)8 * 128 * LTOT * 2)); p.VTc = (bf16_t*)(ws + bump(off, (size_t)8 * 512 * LTOT * 2));
    p.actr = (unsigned*)(ws + bump(off, 256));
    p.De = (bf16_t*)(ws + bump(off, (size_t)1024 * 2048 * 2)); p.Do = (bf16_t*)(ws + bump(off, (size_t)1024 * 2048 * 2)); p.Dc = (bf16_t*)(ws + bump(off, (size_t)256 * 512 * 2));
    p.XTe = (bf16_t*)(ws + bump(off, (size_t)4096 * 2048 * 2)); p.XTo = (bf16_t*)(ws + bump(off, (size_t)4096 * 2048 * 2)); p.XTc = (bf16_t*)(ws + bump(off, (size_t)4096 * 512 * 2));
    const size_t psz = (size_t)T_ALL * PW * sizeof(act_t), ysz = (size_t)NSLOT * DM * sizeof(act_t);
    const size_t shared = bump(off, psz > ysz ? psz : ysz);
    p.P = (act_t*)(ws + shared); p.Ys = (act_t*)(ws + shared);
    if (off > ws_size) { fprintf(stderr, "kernel_launch: workspace too small: need %zu, have %zu\n", off, ws_size); return; }
    hipMemsetAsync(p.bar, 0, XCD_BAR_WORDS * 4, stream);
    hipLaunchKernelGGL(fwd, dim3(grid), dim3(NTHR), LDS_BYTES, stream, p);
}
```

```cpp
#include <hip/hip_runtime.h>
#include <stdint.h>
#include <stdio.h>

#define DM 1024
#define NBATCH 8
#define SEQ 2048
#define CTXL 256
#define LTOT 2304
#define T_ALL 18432
#define IN_W 5888
#define PW 6400
#define C_QA 0
#define C_KA 512
#define C_VA 640
#define C_FA 768
#define C_QC 1792
#define C_KC 2304
#define C_VC 2816
#define C_G 3328
#define NEXP 256
#define NSLOT (T_ALL * 8)
#define NTHR 512
#define LDS_BYTES 163840
#define ALPHA 1.41421356237f

typedef unsigned short bf16_t;
#define ACT_BF16 1
#ifdef ACT_BF16
typedef bf16_t act_t;
#else
typedef float act_t;
#endif

__device__ __forceinline__ float bf2f(bf16_t v) { return __uint_as_float(((unsigned)v) << 16); }
__device__ __forceinline__ bf16_t f2bf(float f) { unsigned u = __float_as_uint(f); u += 0x7FFFu + ((u >> 16) & 1u); return (bf16_t)(u >> 16); }
__device__ __forceinline__ float ldv(const float* p, size_t i) { return p[i]; }
__device__ __forceinline__ float ldv(const bf16_t* p, size_t i) { return bf2f(p[i]); }
__device__ __forceinline__ void stv(float* p, size_t i, float v) { p[i] = v; }
__device__ __forceinline__ void stv(bf16_t* p, size_t i, float v) { p[i] = f2bf(v); }
__device__ __forceinline__ float4 ld4(const float* p, size_t i) { return *(const float4*)(p + i); }
__device__ __forceinline__ float4 ld4(const bf16_t* p, size_t i) { uint2 r = *(const uint2*)(p + i); float4 o; o.x = __uint_as_float(r.x << 16); o.y = __uint_as_float(r.x & 0xFFFF0000u); o.z = __uint_as_float(r.y << 16); o.w = __uint_as_float(r.y & 0xFFFF0000u); return o; }
__device__ __forceinline__ void st4(float* p, size_t i, float4 v) { *(float4*)(p + i) = v; }
__device__ __forceinline__ void st4(bf16_t* p, size_t i, float4 v) { uint2 r; r.x = (unsigned)f2bf(v.x) | ((unsigned)f2bf(v.y) << 16); r.y = (unsigned)f2bf(v.z) | ((unsigned)f2bf(v.w) << 16); *(uint2*)(p + i) = r; }

#define XB_TMO      128
#define XB_XCNT(j)  (256  + 64 * (j))
#define XB_XSUB(j)  (1280 + 64 * (j))
#define XB_XGEN(j)  (2304 + 64 * (j))
#define XB_TOP      3328
#define XB_TOPGEN   3392
#define XCD_BAR_WORDS 3456
#define XB_SPIN_CAP (1u << 27)
#define LAS __attribute__((address_space(3)))

__device__ __forceinline__ unsigned xb_ld(unsigned* p)              { return __hip_atomic_load(p, __ATOMIC_RELAXED, __HIP_MEMORY_SCOPE_AGENT); }
__device__ __forceinline__ unsigned xb_add(unsigned* p, unsigned v) { return __hip_atomic_fetch_add(p, v, __ATOMIC_RELAXED, __HIP_MEMORY_SCOPE_AGENT); }
__device__ __forceinline__ unsigned xb_xcc_id() { return (unsigned)__builtin_amdgcn_s_getreg((3 << 11) | 20) & 0xFu; }
#define XB_SPIN(cond, bar) do { unsigned _sp = 0; while (cond) { __builtin_amdgcn_s_sleep(1); \
    if ((++_sp & 255u) == 0u) { if (xb_ld(&(bar)[XB_TMO])) break; if (_sp > XB_SPIN_CAP) { atomicAdd(&(bar)[XB_TMO], 1u); break; } } } } while (0)

struct XcdBarrier { unsigned* bar; unsigned x; volatile LAS unsigned* st; };

__device__ __forceinline__ XcdBarrier xcd_barrier_post(unsigned* bar, volatile LAS unsigned* st) {
    XcdBarrier b; b.bar = bar; b.x = xb_xcc_id(); b.st = st;
    if (threadIdx.x == 0) (void)xb_add(&bar[XB_XCNT(b.x)], 1u);
    return b;
}
__device__ __forceinline__ void xcd_barrier_complete(unsigned* bar, unsigned x, unsigned& nloc, unsigned& nx) {
    const unsigned G = gridDim.x * gridDim.y * gridDim.z;
    unsigned sum, cnt, mine, sp = 0u;
    for (;;) {
        sum = 0u; cnt = 0u; mine = 0u;
#pragma unroll
        for (unsigned j = 0; j < 16; ++j) { const unsigned c = xb_ld(&bar[XB_XCNT(j)]); sum += c; cnt += (c > 0u) ? 1u : 0u; mine = (j == x) ? c : mine; }
        if (sum == G) break;
        __builtin_amdgcn_s_sleep(1);
        if ((++sp & 255u) == 0u) { if (xb_ld(&bar[XB_TMO])) break; if (sp > XB_SPIN_CAP) { atomicAdd(&bar[XB_TMO], 1u); break; } }
    }
    nloc = mine > 0u ? mine : 1u; nx = cnt > 0u ? cnt : 1u;
}
__device__ __forceinline__ void xcd_barrier(const XcdBarrier& b) {
    asm volatile("s_waitcnt vmcnt(0)" ::: "memory");
    __syncthreads();
    if (threadIdx.x == 0) {
        unsigned* bar = b.bar;
        __builtin_amdgcn_s_waitcnt(0);
        unsigned nloc = b.st[0], nx = b.st[1];
        if (nloc == 0u) { xcd_barrier_complete(bar, b.x, nloc, nx); b.st[0] = nloc; b.st[1] = nx; }
        const unsigned old = xb_add(&bar[XB_XSUB(b.x)], 1u);
        const unsigned gen = old / nloc;
        if (old + 1u == (gen + 1u) * nloc) {
            __builtin_amdgcn_fence(__ATOMIC_RELEASE, "agent");
            asm volatile("s_waitcnt vmcnt(0)" ::: "memory");
            const unsigned og = xb_add(&bar[XB_TOP], 1u);
            const unsigned tg = og / nx;
            if (og + 1u == (tg + 1u) * nx) xb_add(&bar[XB_TOPGEN], 1u);
            else XB_SPIN(xb_ld(&bar[XB_TOPGEN]) == tg, bar);
            __builtin_amdgcn_fence(__ATOMIC_ACQUIRE, "agent");
            xb_add(&bar[XB_XGEN(b.x)], 1u);
            asm volatile("s_waitcnt vmcnt(0)" ::: "memory");
        } else {
            XB_SPIN(xb_ld(&bar[XB_XGEN(b.x)]) == gen, bar);
            __builtin_amdgcn_fence(__ATOMIC_ACQUIRE, "agent");
            asm volatile("s_waitcnt vmcnt(0)" ::: "memory");
        }
    }
    __syncthreads();
}

#define CONV_LIM0 244
struct Params {
    const float *x, *c, *ctx, *c_ctx, *w_mod, *b_mod, *w_in, *qn, *kn, *lq1, *lk1, *lq2, *lk2, *subln,
                *wa, *wb, *wc, *wout, *ln1g, *ln1b, *wr, *br, *sg, *su, *sd, *eg, *eu, *ed, *ln2g, *ln2b;
    float* out;
    unsigned* bar;
    float *mod, *WF, *ropec, *ropes, *tc, *ts, *lam, *hbuf, *z, *logits, *f, *slot_w, *rw;
    act_t *u, *P, *oa, *ob, *oc, *y, *shact, *Hs, *Ys;
    int *ridx, *lrank, *cntWG, *slot_tok, *tok_slot, *eoff;
    bf16_t *Wt_in, *Wt_br, *Wt_out, *Wt_g, *Wt_sd;
    float* ytmp;
    bf16_t *Wt_e1, *Wt_e2;
    unsigned char* PF;
    unsigned char* u8;
    unsigned char* Gq;
    bf16_t *VTa, *VTc;
    unsigned* actr;
    bf16_t *De, *Do, *Dc, *XTe, *XTo, *XTc;
};

__device__ __forceinline__ float wave_sum(float v) {
#pragma unroll
    for (int o = 32; o > 0; o >>= 1) v += __shfl_xor(v, o);
    return v;
}
__device__ __forceinline__ float wave_max(float v) {
#pragma unroll
    for (int o = 32; o > 0; o >>= 1) v = fmaxf(v, __shfl_xor(v, o));
    return v;
}
__device__ __forceinline__ float sigmoidf_(float v) { return 1.f / (1.f + expf(-v)); }
__device__ __forceinline__ float siluf_(float v) { return v / (1.f + expf(-v)); }
__device__ __forceinline__ float lam_init_of(int l) { return l == 0 ? 0.2f : 0.35550906759f; }

__device__ __forceinline__ const float* in_row(const Params& p, int r) {
    const int b = r / LTOT, j = r - b * LTOT;
    return j < CTXL ? p.ctx + ((size_t)b * CTXL + j) * DM : p.x + ((size_t)b * SEQ + (j - CTXL)) * DM;
}
__device__ __forceinline__ int mod_idx(int r) { const int b = r / LTOT, j = r - b * LTOT; return j < CTXL ? 8 : b; }
__device__ __forceinline__ const float* modv(const Params& p, int l, int mi, int i) { return p.mod + ((size_t)(l * 9 + mi) * 6 + i) * DM; }

__device__ __forceinline__ void ln_stats(const float (&v)[16], float& mu, float& rstd) {
    float s = 0.f;
#pragma unroll
    for (int i = 0; i < 16; ++i) s += v[i];
    mu = wave_sum(s) * (1.f / DM);
    float q = 0.f;
#pragma unroll
    for (int i = 0; i < 16; ++i) { const float d = v[i] - mu; q += d * d; }
    rstd = rsqrtf(wave_sum(q) * (1.f / DM) + 1e-5f);
}
__device__ __forceinline__ void load_row16(const float* src, int lane, float (&v)[16]) {
#pragma unroll
    for (int i = 0; i < 4; ++i) { const float4 t = *(const float4*)(src + i * 256 + lane * 4); v[i * 4 + 0] = t.x; v[i * 4 + 1] = t.y; v[i * 4 + 2] = t.z; v[i * 4 + 3] = t.w; }
}

template <class FA, class FB>
__device__ __forceinline__ void sgemm_tile(float (&acc)[4][4], int K, FA fa, FB fb, float* lds) {
    float* As = lds;
    float* Bs = lds + 16 * 64;
    const int tid = threadIdx.x, ty = tid >> 5, tx = tid & 31;
#pragma unroll
    for (int i = 0; i < 4; ++i)
#pragma unroll
        for (int j = 0; j < 4; ++j) acc[i][j] = 0.f;
#pragma unroll 1
    for (int k0 = 0; k0 < K; k0 += 16) {
        __syncthreads();
#pragma unroll
        for (int i = 0; i < 2; ++i) { const int e = tid + i * NTHR; const int r = e >> 4, kk = e & 15; As[kk * 64 + r] = fa(r, k0 + kk); }
#pragma unroll
        for (int i = 0; i < 4; ++i) { const int e = tid + i * NTHR; const int kk = e >> 7, c = e & 127; Bs[kk * 128 + c] = fb(k0 + kk, c); }
        __syncthreads();
#pragma unroll 4
        for (int kk = 0; kk < 16; ++kk) {
            const float4 a = *(const float4*)&As[kk * 64 + ty * 4];
            const float4 b = *(const float4*)&Bs[kk * 128 + tx * 4];
            const float av[4] = {a.x, a.y, a.z, a.w}, bv[4] = {b.x, b.y, b.z, b.w};
#pragma unroll
            for (int i = 0; i < 4; ++i)
#pragma unroll
                for (int j = 0; j < 4; ++j) acc[i][j] += av[i] * bv[j];
        }
    }
}

__device__ __noinline__ void phase_pro(const Params& p, float* lds) {
    const int tid = threadIdx.x, bid = blockIdx.x, nb = gridDim.x;
    const int gtid = bid * NTHR + tid, gn = nb * NTHR;
    for (int i = tid; i < 9 * 1024; i += NTHR) { const int r = i >> 10, k = i & 1023; const float v = r < 8 ? p.c[r * 1024 + k] : p.c_ctx[k]; lds[i] = siluf_(v); }
    __syncthreads();
    float* red = lds + 9 * 1024;
    for (int g = bid; g < 192; g += nb) {
        const int l = g / 96, col0 = (g % 96) * 64, c4 = tid & 15, kc = tid >> 4;
        float acc[9][4];
#pragma unroll
        for (int i = 0; i < 9; ++i) { acc[i][0] = 0.f; acc[i][1] = 0.f; acc[i][2] = 0.f; acc[i][3] = 0.f; }
        const float* w = p.w_mod + (size_t)l * 1024 * 6144 + col0 + c4 * 4;
#pragma unroll 16
        for (int k = kc * 32; k < kc * 32 + 32; ++k) {
            const float4 wv = *(const float4*)(w + (size_t)k * 6144);
#pragma unroll
            for (int i = 0; i < 9; ++i) { const float s = lds[i * 1024 + k]; acc[i][0] += s * wv.x; acc[i][1] += s * wv.y; acc[i][2] += s * wv.z; acc[i][3] += s * wv.w; }
        }
#pragma unroll
        for (int i = 0; i < 9; ++i) *(float4*)&red[(kc * 9 + i) * 64 + c4 * 4] = make_float4(acc[i][0], acc[i][1], acc[i][2], acc[i][3]);
        __syncthreads();
        for (int o = tid; o < 9 * 64; o += NTHR) { const int i = o >> 6, c = o & 63;
            float s = p.b_mod[l * 6144 + col0 + c];
#pragma unroll 8
            for (int k2 = 0; k2 < 32; ++k2) s += red[(k2 * 9 + i) * 64 + c];
            p.mod[(size_t)(l * 9 + i) * 6144 + col0 + c] = s; }
        __syncthreads();
    }
    for (int i = gtid; i < 2048 * 32; i += gn) {
        const int s = i >> 5, j = i & 31, axis = j >> 4, fi = j & 15;
        const double pos = axis ? (double)(s & 63) : (double)(s >> 6);
        const double inv = pow(10000.0, -(double)fi / 16.0);
        const double ang = (double)(float)((float)pos * (float)inv);
        p.ropec[i] = (float)cos(ang); p.ropes[i] = (float)sin(ang);
    }
    for (int i = gtid; i < 2048; i += gn) { p.tc[i] = (float)cospi((double)i / 1024.0); p.ts[i] = (float)sinpi((double)i / 1024.0); }
    if (bid == 0 && tid < 128) {
        const int l = tid >> 6, lane = tid & 63;
        const float d1 = wave_sum(p.lq1[l * 64 + lane] * p.lk1[l * 64 + lane]);
        const float d2 = wave_sum(p.lq2[l * 64 + lane] * p.lk2[l * 64 + lane]);
        if (lane == 0) { p.lam[l] = expf(d1) - expf(d2) + lam_init_of(l); }
        if (lane < 16) p.actr[l * 32 + lane] = 0u;
    }
    __syncthreads();
    float* t128 = lds;
    if (tid < 128) { t128[tid] = (float)cospi((double)tid / 64.0); t128[128 + tid] = (float)sinpi((double)tid / 64.0); }
    __syncthreads();
    typedef const __attribute__((address_space(4))) float* cfp;
    const int lane = tid & 63;
    for (int it_ = bid * 8 + (tid >> 6); it_ < 2 * 1024 * 4; it_ += nb * 8) {
        const int it = __builtin_amdgcn_readfirstlane(it_), l = it >> 12, k = (it >> 2) & 1023, g = it & 3;
        const unsigned long long wa = (unsigned long long)(p.w_in + ((size_t)l * 1024 + k) * IN_W + 768 + g * 128);
        cfp w = (cfp)(((unsigned long long)(unsigned)__builtin_amdgcn_readfirstlane((int)(wa >> 32)) << 32) | (unsigned)__builtin_amdgcn_readfirstlane((int)wa));
        float c0 = 0.f, s0 = 0.f, c1 = 0.f, s1 = 0.f;
#pragma unroll 8
        for (int c = 0; c < 128; ++c) {
            const float wv = w[c];
            const int i0 = (c * lane) & 127, i1 = i0 ^ ((c & 1) << 6);
            c0 += wv * t128[i0]; s0 += wv * t128[128 + i0]; c1 += wv * t128[i1]; s1 += wv * t128[128 + i1];
        }
        float* o = p.WF + ((size_t)l * 1024 + k) * 1024 + g * 128;
        o[lane] = c0; o[lane + 64] = c1; o[512 + lane] = s0; o[512 + lane + 64] = s1;
    }
}

__device__ __forceinline__ void st_fp8x4(unsigned char* p8, size_t i, float4 o) {
    int q8 = 0;
    q8 = __builtin_amdgcn_cvt_pk_fp8_f32(fminf(fmaxf(o.x * 16.f, -448.f), 448.f), fminf(fmaxf(o.y * 16.f, -448.f), 448.f), q8, false);
    q8 = __builtin_amdgcn_cvt_pk_fp8_f32(fminf(fmaxf(o.z * 16.f, -448.f), 448.f), fminf(fmaxf(o.w * 16.f, -448.f), 448.f), q8, true);
    *(int*)(p8 + i) = q8;
}
__device__ __noinline__ void phase_lnmod0(const Params& p) {
    const int wid = threadIdx.x >> 6, lane = threadIdx.x & 63;
    const int stride = gridDim.x * 8;
    auto proc = [&](int r, float (&v)[16]) {
        float mu, rstd; ln_stats(v, mu, rstd);
        const int mi = mod_idx(r);
        const float* sh = modv(p, 0, mi, 0); const float* sc = modv(p, 0, mi, 1);
#pragma unroll
        for (int i = 0; i < 4; ++i) {
            const int c = i * 256 + lane * 4;
            const float4 s4 = *(const float4*)(sh + c), c4 = *(const float4*)(sc + c);
            float4 o; o.x = (v[i * 4 + 0] - mu) * rstd * (1.f + c4.x) + s4.x; o.y = (v[i * 4 + 1] - mu) * rstd * (1.f + c4.y) + s4.y;
            o.z = (v[i * 4 + 2] - mu) * rstd * (1.f + c4.z) + s4.z; o.w = (v[i * 4 + 3] - mu) * rstd * (1.f + c4.w) + s4.w;
            st_fp8x4(p.u8, (size_t)r * DM + c, o);
        } };
    for (int r = blockIdx.x * 8 + wid; r < T_ALL; r += 2 * stride) {
        const int r2 = r + stride;
        float va[16], vb[16];
        load_row16(in_row(p, r), lane, va);
        if (r2 < T_ALL) load_row16(in_row(p, r2), lane, vb);
        proc(r, va);
        if (r2 < T_ALL) proc(r2, vb);
    }
}

__device__ __noinline__ void phase_inproj(const Params& p, int l, float* lds) {
    const int tid = threadIdx.x, ty = tid >> 5, tx = tid & 31;
    const float* win = p.w_in + (size_t)l * 1024 * IN_W;
    const float* wf = p.WF + (size_t)l * 1024 * 1024;
    for (int t = blockIdx.x; t < 288 * 50; t += gridDim.x) {
        const int rt = t / 50, ct = t % 50, col0 = ct * 128;
        float acc[4][4];
        sgemm_tile(acc, 1024,
            [&](int r, int k) { return ldv(p.u, (size_t)(rt * 64 + r) * DM + k); },
            [&](int k, int c) { const int col = col0 + c;
                if (col < 768) return win[(size_t)k * IN_W + col];
                if (col < 1792) return wf[(size_t)k * 1024 + (col - 768)];
                return win[(size_t)k * IN_W + (col - 512)]; }, lds);
#pragma unroll
        for (int i = 0; i < 4; ++i) { const size_t row = rt * 64 + ty * 4 + i;
            st4(p.P, row * PW + col0 + tx * 4, make_float4(acc[i][0], acc[i][1], acc[i][2], acc[i][3])); }
    }
}

__device__ __forceinline__ void load64(const float* p, float (&kr)[64]) {
#pragma unroll
    for (int i = 0; i < 16; ++i) { const float4 t = *(const float4*)(p + i * 4); kr[i * 4] = t.x; kr[i * 4 + 1] = t.y; kr[i * 4 + 2] = t.z; kr[i * 4 + 3] = t.w; }
}
__device__ __forceinline__ void load64(const bf16_t* p, float (&kr)[64]) {
#pragma unroll
    for (int i = 0; i < 16; ++i) { const float4 t = ld4(p, i * 4); kr[i * 4] = t.x; kr[i * 4 + 1] = t.y; kr[i * 4 + 2] = t.z; kr[i * 4 + 3] = t.w; }
}
template <int QB, int NMAP, int VD>
__device__ __noinline__ void attn_unit(const Params& p, int l, int b, int head, int qblk, bool ctxq, float* lds) {
    const int L = ctxq ? CTXL : LTOT;
    float* S = lds;
    float* Q = lds + 36864;
    const int tid = threadIdx.x, wid = tid >> 6, lane = tid & 63;
    const size_t rowbase = (size_t)b * LTOT;
    const int jq0 = (ctxq ? 0 : CTXL) + qblk * QB;
    const bool gqa = (NMAP == 1);
    const int qcol = gqa ? C_QA + head * 64 : C_QC + head * 128;
    const int kcol = gqa ? C_KA + (head >> 2) * 64 : C_KC + head * 128;
    const int vcol = gqa ? C_VA + (head >> 2) * 64 : C_VC + head * 128;
    __syncthreads();
    for (int i = tid; i < NMAP * QB * 64; i += NTHR) { const int m = i / (QB * 64), q = (i >> 6) % QB, d = i & 63;
        Q[i] = ldv(p.P, (rowbase + jq0 + q) * PW + qcol + m * 64 + d) * 0.125f; }
    __syncthreads();
    for (int j = tid; j < L; j += NTHR) {
#pragma unroll 1
        for (int m = 0; m < NMAP; ++m) {
            float kr[64]; load64(p.P + (rowbase + j) * PW + kcol + m * 64, kr);
#pragma unroll 1
            for (int q = 0; q < QB; ++q) {
                const float* qp = Q + (m * QB + q) * 64; float d = 0.f;
#pragma unroll
                for (int e = 0; e < 64; ++e) d += qp[e] * kr[e];
                S[(m * QB + q) * L + j] = d;
            }
        }
    }
    __syncthreads();
#pragma unroll
    for (int rr = 0; rr < 2; ++rr) {
        float* sr = S + (wid * 2 + rr) * L;
        float mx = -3.0e38f;
        for (int j = lane; j < L; j += 64) mx = fmaxf(mx, sr[j]);
        mx = wave_max(mx);
        float sum = 0.f;
        for (int j = lane; j < L; j += 64) { const float e = expf(sr[j] - mx); sr[j] = e; sum += e; }
        sum = wave_sum(sum);
        const float inv = 1.f / sum;
        for (int j = lane; j < L; j += 64) sr[j] *= inv;
    }
    __syncthreads();
    if (NMAP == 2) {
        const float lam = p.lam[l];
        for (int i = tid; i < QB * L; i += NTHR) S[i] -= lam * S[QB * L + i];
        __syncthreads();
    }
    const int q = tid / (VD / 2), e = (tid % (VD / 2)) * 2;
    float o0 = 0.f, o1 = 0.f;
    const float* sq = S + q * L;
    const act_t* vp = p.P + rowbase * PW + vcol + e;
#pragma unroll 4
    for (int j = 0; j < L; ++j) { const float pj = sq[j]; o0 += pj * ldv(vp, (size_t)j * PW); o1 += pj * ldv(vp, (size_t)j * PW + 1); }
    const size_t orow = rowbase + jq0 + q;
    if (gqa) { stv(p.oa, orow * 512 + head * 64 + e, o0); stv(p.oa, orow * 512 + head * 64 + e + 1, o1); }
    else {
        const float ss = wave_sum(o0 * o0 + o1 * o1);
        const float sc = rsqrtf(ss * (1.f / 128.f) + 1e-6f) * (1.f - lam_init_of(l));
        stv(p.oc, orow * 512 + head * 128 + e, o0 * sc * p.subln[l * 128 + e]); stv(p.oc, orow * 512 + head * 128 + e + 1, o1 * sc * p.subln[l * 128 + e + 1]);
    }
}
__device__ __forceinline__ void phase_attn(const Params& p, int l, bool do_ctx, float* lds) {
    for (int t = blockIdx.x; t < 8192; t += gridDim.x) attn_unit<16, 1, 64>(p, l, t >> 10, (t >> 7) & 7, t & 127, false, lds);
    for (int t = blockIdx.x; t < 8192; t += gridDim.x) attn_unit<8, 2, 128>(p, l, t >> 10, (t >> 8) & 3, t & 255, false, lds);
    if (do_ctx) {
        for (int t = blockIdx.x; t < 1024; t += gridDim.x) attn_unit<16, 1, 64>(p, l, t >> 7, (t >> 4) & 7, t & 15, true, lds);
        for (int t = blockIdx.x; t < 1024; t += gridDim.x) attn_unit<8, 2, 128>(p, l, t >> 7, (t >> 5) & 3, t & 31, true, lds);
    }
}

__device__ __noinline__ void phase_fourier(const Params& p, bool do_ctx, float* lds) {
    const int tid = threadIdx.x, ty = tid >> 5, tx = tid & 31;
    for (int t = blockIdx.x; t < 8 * 32 * 4; t += gridDim.x) {
        const int b = t >> 7, rt = (t >> 2) & 31, ct = t & 3;
        float acc[4][4];
        sgemm_tile(acc, 4096,
            [&](int r, int k) { const int kk = rt * 64 + r, n = k & 2047, m = (kk * n) & 2047; return k < 2048 ? p.tc[m] : -p.ts[m]; },
            [&](int k, int c) { const int n = k & 2047, wh = k >> 11; return ldv(p.P, ((size_t)b * LTOT + CTXL + n) * PW + C_FA + wh * 512 + ct * 128 + c); }, lds);
#pragma unroll
        for (int i = 0; i < 4; ++i) { const size_t row = (size_t)b * LTOT + CTXL + rt * 64 + ty * 4 + i; const float s = 1.f / 512.f;
            st4(p.ob, row * 512 + ct * 128 + tx * 4, make_float4(acc[i][0] * s, acc[i][1] * s, acc[i][2] * s, acc[i][3] * s)); }
    }
    if (do_ctx) {
        for (int t = blockIdx.x; t < 8 * 4 * 4; t += gridDim.x) {
            const int b = t >> 4, rt = (t >> 2) & 3, ct = t & 3;
            float acc[4][4];
            sgemm_tile(acc, 512,
                [&](int r, int k) { const int kk = rt * 64 + r, n = k & 255, m = (kk * n * 8) & 2047; return k < 256 ? p.tc[m] : -p.ts[m]; },
                [&](int k, int c) { const int n = k & 255, wh = k >> 8; return ldv(p.P, ((size_t)b * LTOT + n) * PW + C_FA + wh * 512 + ct * 128 + c); }, lds);
#pragma unroll
            for (int i = 0; i < 4; ++i) { const size_t row = (size_t)b * LTOT + rt * 64 + ty * 4 + i; const float s = 0.00552427172802f;
                st4(p.ob, row * 512 + ct * 128 + tx * 4, make_float4(acc[i][0] * s, acc[i][1] * s, acc[i][2] * s, acc[i][3] * s)); }
        }
    }
}

__device__ __noinline__ void phase_ygemm(const Params& p, int l, float* lds) {
    const int tid = threadIdx.x, ty = tid >> 5, tx = tid & 31;
    for (int t = blockIdx.x; t < 288 * 8; t += gridDim.x) {
        const int rt = t >> 3, ct = t & 7, col0 = ct * 128;
        float tot[4][4];
#pragma unroll
        for (int i = 0; i < 4; ++i)
#pragma unroll
            for (int j = 0; j < 4; ++j) tot[i][j] = 0.f;
#pragma unroll 1
        for (int br = 0; br < 3; ++br) {
            const act_t* o = br == 0 ? p.oa : br == 1 ? p.ob : p.oc;
            const float* w = (br == 0 ? p.wa : br == 1 ? p.wb : p.wc) + (size_t)l * 512 * 1024;
            float acc[4][4];
            sgemm_tile(acc, 512,
                [&](int r, int k) { return ldv(o, (size_t)(rt * 64 + r) * 512 + k); },
                [&](int k, int c) { return w[(size_t)k * 1024 + col0 + c]; }, lds);
#pragma unroll
            for (int i = 0; i < 4; ++i) { const size_t row = rt * 64 + ty * 4 + i;
                const float4 g = ld4(p.P, row * PW + C_G + br * 1024 + col0 + tx * 4);
                tot[i][0] += sigmoidf_(g.x) * acc[i][0]; tot[i][1] += sigmoidf_(g.y) * acc[i][1]; tot[i][2] += sigmoidf_(g.z) * acc[i][2]; tot[i][3] += sigmoidf_(g.w) * acc[i][3]; }
        }
#pragma unroll
        for (int i = 0; i < 4; ++i) { const size_t row = rt * 64 + ty * 4 + i; st4(p.y, row * DM + col0 + tx * 4, make_float4(tot[i][0], tot[i][1], tot[i][2], tot[i][3])); }
    }
}

__device__ __noinline__ void phase_outproj(const Params& p, int l, float* lds) {
    const int tid = threadIdx.x, ty = tid >> 5, tx = tid & 31;
    const float* w = p.wout + (size_t)l * 1024 * 1024;
    for (int t = blockIdx.x; t < 288 * 8; t += gridDim.x) {
        const int rt = t >> 3, ct = t & 7, col0 = ct * 128;
        float acc[4][4];
        sgemm_tile(acc, 1024,
            [&](int r, int k) { return ldv(p.y, (size_t)(rt * 64 + r) * DM + k); },
            [&](int k, int c) { return w[(size_t)k * 1024 + col0 + c]; }, lds);
#pragma unroll
        for (int i = 0; i < 4; ++i) { const int row = rt * 64 + ty * 4 + i; const int c = col0 + tx * 4;
            const float* hrow = l == 0 ? in_row(p, row) : p.hbuf + (size_t)row * DM;
            const float4 h4 = *(const float4*)(hrow + c); const float4 m4 = *(const float4*)(modv(p, l, mod_idx(row), 2) + c);
            float4 o; o.x = ALPHA * h4.x + m4.x * acc[i][0]; o.y = ALPHA * h4.y + m4.y * acc[i][1]; o.z = ALPHA * h4.z + m4.z * acc[i][2]; o.w = ALPHA * h4.w + m4.w * acc[i][3];
            *(float4*)(p.z + (size_t)row * DM + c) = o; }
    }
}

__device__ __noinline__ void phase_ln1(const Params& p, int l) {
    const int wid = threadIdx.x >> 6, lane = threadIdx.x & 63;
    const int stride = gridDim.x * 8;
    const float* g = p.ln1g + l * DM; const float* bb = p.ln1b + l * DM;
    auto load = [&](int r, float (&v)[16]) {
#pragma unroll
        for (int i = 0; i < 4; ++i) { const float4 t = ld4((const bf16_t*)p.z, (size_t)r * DM + i * 256 + lane * 4); v[i * 4] = t.x; v[i * 4 + 1] = t.y; v[i * 4 + 2] = t.z; v[i * 4 + 3] = t.w; } };
    auto proc = [&](int r, float (&v)[16]) {
        float mu, rstd; ln_stats(v, mu, rstd);
#pragma unroll
        for (int i = 0; i < 4; ++i) { const int c = i * 256 + lane * 4; const float4 g4 = *(const float4*)(g + c), b4 = *(const float4*)(bb + c);
            v[i * 4 + 0] = (v[i * 4 + 0] - mu) * rstd * g4.x + b4.x; v[i * 4 + 1] = (v[i * 4 + 1] - mu) * rstd * g4.y + b4.y;
            v[i * 4 + 2] = (v[i * 4 + 2] - mu) * rstd * g4.z + b4.z; v[i * 4 + 3] = (v[i * 4 + 3] - mu) * rstd * g4.w + b4.w;
            st4((bf16_t*)p.hbuf, (size_t)r * DM + c, make_float4(v[i * 4], v[i * 4 + 1], v[i * 4 + 2], v[i * 4 + 3])); }
        ln_stats(v, mu, rstd);
        const int mi = mod_idx(r);
        const float* sh = modv(p, l, mi, 3); const float* sc = modv(p, l, mi, 4);
#pragma unroll
        for (int i = 0; i < 4; ++i) { const int c = i * 256 + lane * 4; const float4 s4 = *(const float4*)(sh + c), c4 = *(const float4*)(sc + c);
            float4 o; o.x = (v[i * 4 + 0] - mu) * rstd * (1.f + c4.x) + s4.x; o.y = (v[i * 4 + 1] - mu) * rstd * (1.f + c4.y) + s4.y;
            o.z = (v[i * 4 + 2] - mu) * rstd * (1.f + c4.z) + s4.z; o.w = (v[i * 4 + 3] - mu) * rstd * (1.f + c4.w) + s4.w;
            st4(p.u, (size_t)r * DM + c, o);
            { int q8 = 0;
              q8 = __builtin_amdgcn_cvt_pk_fp8_f32(fminf(fmaxf(o.x * 16.f, -448.f), 448.f), fminf(fmaxf(o.y * 16.f, -448.f), 448.f), q8, false);
              q8 = __builtin_amdgcn_cvt_pk_fp8_f32(fminf(fmaxf(o.z * 16.f, -448.f), 448.f), fminf(fmaxf(o.w * 16.f, -448.f), 448.f), q8, true);
              *(int*)(p.u8 + (size_t)r * DM + c) = q8; } } };
    for (int r = blockIdx.x * 8 + wid; r < T_ALL; r += 2 * stride) {
        const int r2 = r + stride;
        const bool okA = !(l == 1 && (r % LTOT) < CTXL), okB = r2 < T_ALL && !(l == 1 && (r2 % LTOT) < CTXL);
        float va[16], vb[16];
        if (okA) load(r, va);
        if (okB) load(r2, vb);
        if (okA) proc(r, va);
        if (okB) proc(r2, vb);
    }
}

__device__ __noinline__ void phase_router_shared(const Params& p, int l, float* lds) {
    const int tid = threadIdx.x, ty = tid >> 5, tx = tid & 31;
    const float* wr = p.wr + (size_t)l * 1024 * 256; const float* sg = p.sg + (size_t)l * 1024 * 256; const float* su = p.su + (size_t)l * 1024 * 256;
    for (int t = blockIdx.x; t < 288 * 4; t += gridDim.x) {
        const int rt = t >> 2, kind = (t >> 1) & 1, ct = t & 1, col0 = ct * 128;
        auto fa = [&](int r, int k) { return ldv(p.u, (size_t)(rt * 64 + r) * DM + k); };
        if (kind == 0) {
            float acc[4][4];
            sgemm_tile(acc, 1024, fa, [&](int k, int c) { return wr[(size_t)k * 256 + col0 + c]; }, lds);
#pragma unroll
            for (int i = 0; i < 4; ++i) { const size_t row = rt * 64 + ty * 4 + i; *(float4*)(p.logits + row * 256 + col0 + tx * 4) = make_float4(acc[i][0], acc[i][1], acc[i][2], acc[i][3]); }
        } else {
            float ag[4][4], au[4][4];
            sgemm_tile(ag, 1024, fa, [&](int k, int c) { return sg[(size_t)k * 256 + col0 + c]; }, lds);
            sgemm_tile(au, 1024, fa, [&](int k, int c) { return su[(size_t)k * 256 + col0 + c]; }, lds);
#pragma unroll
            for (int i = 0; i < 4; ++i) { const size_t row = rt * 64 + ty * 4 + i;
                st4(p.shact, row * 256 + col0 + tx * 4, make_float4(siluf_(ag[i][0]) * au[i][0], siluf_(ag[i][1]) * au[i][1], siluf_(ag[i][2]) * au[i][2], siluf_(ag[i][3]) * au[i][3])); }
        }
    }
}

__device__ __noinline__ void phase_route(const Params& p, int l, float* lds) {
    const int tid = threadIdx.x, wid = tid >> 6, lane = tid & 63, bid = blockIdx.x;
    int* asg = (int*)lds;
    unsigned* bm = (unsigned*)lds + 640;
    for (int i = tid; i < 768; i += NTHR) bm[i] = 0u;
    __syncthreads();
    const float4 b4 = *(const float4*)(p.br + l * 256 + lane * 4);
    const float bz_[4] = {b4.x, b4.y, b4.z, b4.w};
    float4 l4n[2];
#pragma unroll
    for (int tk = 0; tk < 2; ++tk) l4n[tk] = *(const float4*)(p.logits + (size_t)(bid * 72 + wid + 8 * tk) * 256 + lane * 4);
    for (int tl0 = wid; tl0 < 72; tl0 += 16) {
        float s[2][4], bz[2][4]; unsigned key[2][4]; bool act[2];
#pragma unroll
        for (int tk = 0; tk < 2; ++tk) {
            const int tl = tl0 + 8 * tk, t = bid * 72 + tl;
            const float4 l4 = l4n[tk];
            if (tl + 16 < 72) l4n[tk] = *(const float4*)(p.logits + (size_t)(t + 16) * 256 + lane * 4);
            act[tk] = tl < 72 && !(l == 1 && (t % LTOT) < CTXL);
            if (tl < 72 && !act[tk] && lane < 8) asg[tl * 8 + lane] = -1;
            const float lg[4] = {l4.x, l4.y, l4.z, l4.w};
#pragma unroll
            for (int i = 0; i < 4; ++i) { s[tk][i] = sigmoidf_(lg[i]); bz[tk][i] = s[tk][i] + bz_[i]; }
            float m1 = -3.0e38f, m2 = -3.0e38f;
#pragma unroll
            for (int i = 0; i < 4; ++i) { const float v = bz[tk][i]; if (v > m1) { m2 = m1; m1 = v; } else if (v > m2) m2 = v; }
#pragma unroll
            for (int o = 1; o < 8; o <<= 1) { const float o1 = __shfl_xor(m1, o), o2 = __shfl_xor(m2, o); const float n1 = fmaxf(m1, o1), n2 = fmaxf(fminf(m1, o1), fmaxf(m2, o2)); m1 = n1; m2 = n2; }
            const float gs = m1 + m2; const int g = lane >> 3; int rank = 0;
#pragma unroll
            for (int j = 0; j < 8; ++j) { const float o = __int_as_float(__builtin_amdgcn_readlane(__float_as_int(gs), j * 8)); rank += ((o > gs) || (o == gs && j < g)) ? 1 : 0; }
            const bool gsel = rank < 4 && act[tk];
#pragma unroll
            for (int i = 0; i < 4; ++i) { const unsigned bits = __float_as_uint(bz[tk][i]); const unsigned k = (bits & 0x80000000u) ? ~bits : (bits | 0x80000000u); key[tk][i] = gsel ? k : 0u; }
        }
        unsigned T0 = 0u, T1 = 0u;
#pragma unroll 1
        for (int bit = 31; bit >= 0; --bit) {
            const unsigned Ta = T0 | (1u << bit), Tb = T1 | (1u << bit);
            const int ca = __builtin_popcountll(__builtin_amdgcn_ballot_w64(key[0][0] >= Ta)) + __builtin_popcountll(__builtin_amdgcn_ballot_w64(key[0][1] >= Ta))
                         + __builtin_popcountll(__builtin_amdgcn_ballot_w64(key[0][2] >= Ta)) + __builtin_popcountll(__builtin_amdgcn_ballot_w64(key[0][3] >= Ta));
            const int cb = __builtin_popcountll(__builtin_amdgcn_ballot_w64(key[1][0] >= Tb)) + __builtin_popcountll(__builtin_amdgcn_ballot_w64(key[1][1] >= Tb))
                         + __builtin_popcountll(__builtin_amdgcn_ballot_w64(key[1][2] >= Tb)) + __builtin_popcountll(__builtin_amdgcn_ballot_w64(key[1][3] >= Tb));
            if (ca >= 8) T0 = Ta;
            if (cb >= 8) T1 = Tb;
        }
#pragma unroll
        for (int tk = 0; tk < 2; ++tk) {
            if (!act[tk]) continue;
            const int tl = tl0 + 8 * tk, t = bid * 72 + tl;
            const unsigned T = tk ? T1 : T0;
            unsigned long long mg[4], me[4];
            int n_gt = 0;
#pragma unroll
            for (int i = 0; i < 4; ++i) { mg[i] = __builtin_amdgcn_ballot_w64(key[tk][i] > T); me[i] = __builtin_amdgcn_ballot_w64(key[tk][i] == T); n_gt += __builtin_popcountll(mg[i]); }
            const int need_eq = 8 - n_gt;
            const unsigned long long below = (lane == 0) ? 0ull : (~0ull >> (64 - lane));
            int eq_lower = 0;
#pragma unroll
            for (int i = 0; i < 4; ++i) eq_lower += __builtin_popcountll(me[i] & below);
            bool selm[4]; int eqrun = 0;
#pragma unroll
            for (int i = 0; i < 4; ++i) { const bool isgt = key[tk][i] > T, iseq = key[tk][i] == T; selm[i] = isgt || (iseq && (eq_lower + eqrun) < need_eq); eqrun += iseq ? 1 : 0; }
            unsigned long long ms[4]; int pos = 0;
#pragma unroll
            for (int i = 0; i < 4; ++i) { ms[i] = __builtin_amdgcn_ballot_w64(selm[i]); pos += __builtin_popcountll(ms[i] & below); }
            float mysum = 0.f;
#pragma unroll
            for (int i = 0; i < 4; ++i) mysum += selm[i] ? s[tk][i] : 0.f;
            const float inv = 2.5f / wave_sum(mysum);
#pragma unroll
            for (int i = 0; i < 4; ++i) { if (selm[i]) { p.ridx[(size_t)t * 8 + pos] = lane * 4 + i; p.rw[(size_t)t * 8 + pos] = s[tk][i] * inv; asg[tl * 8 + pos] = lane * 4 + i; ++pos;
                    atomicOr(&bm[(lane * 4 + i) * 3 + (tl >> 5)], 1u << (tl & 31)); } }
        }
    }
    __syncthreads();
    if (tid < 256) p.cntWG[bid * 256 + tid] = __builtin_popcount(bm[tid * 3]) + __builtin_popcount(bm[tid * 3 + 1]) + __builtin_popcount(bm[tid * 3 + 2]);
    for (int a = tid; a < 576; a += NTHR) { const int e = asg[a];
        if (e >= 0) { const int tl = a >> 3, w = tl >> 5, bit = tl & 31;
            int rk = __builtin_popcount(bm[e * 3 + w] & ((1u << bit) - 1u));
            if (w > 0) rk += __builtin_popcount(bm[e * 3]);
            if (w > 1) rk += __builtin_popcount(bm[e * 3 + 1]);
            p.lrank[(size_t)bid * 576 + a] = rk; } }
    __syncthreads();
}

__device__ __noinline__ void phase_slots(const Params& p, bool skip_ctx, float* lds) {
    const int tid = threadIdx.x, bid = blockIdx.x;
    int* tot = (int*)lds; int* pre = tot + 256; int* off = pre + 256;
    int* part = off + 320;
    {
        const int eg = tid & 63, q = tid >> 6;
        int s[4] = {0, 0, 0, 0}, mine[4] = {0, 0, 0, 0};
#pragma unroll 4
        for (int w = q * 32; w < q * 32 + 32; ++w) { const int4 c = *(const int4*)(p.cntWG + w * 256 + eg * 4); const bool lt = w < bid;
            s[0] += c.x; s[1] += c.y; s[2] += c.z; s[3] += c.w; mine[0] += lt ? c.x : 0; mine[1] += lt ? c.y : 0; mine[2] += lt ? c.z : 0; mine[3] += lt ? c.w : 0; }
        *(int4*)&part[(q * 2 + 0) * 256 + eg * 4] = make_int4(s[0], s[1], s[2], s[3]); *(int4*)&part[(q * 2 + 1) * 256 + eg * 4] = make_int4(mine[0], mine[1], mine[2], mine[3]);
    }
    __syncthreads();
    if (tid < 256) { int t = 0, m = 0;
#pragma unroll
        for (int q = 0; q < 8; ++q) { t += part[(q * 2) * 256 + tid]; m += part[(q * 2 + 1) * 256 + tid]; }
        tot[tid] = t; pre[tid] = m; }
    __syncthreads();
    if (tid < 64) {
        const int a0 = tot[tid * 4], a1 = tot[tid * 4 + 1], a2 = tot[tid * 4 + 2], a3 = tot[tid * 4 + 3];
        const int ls = a0 + a1 + a2 + a3; int inc = ls;
#pragma unroll
        for (int o = 1; o < 64; o <<= 1) { const int t2 = __shfl_up(inc, o); if (tid >= o) inc += t2; }
        const int ex = inc - ls;
        off[tid * 4] = ex; off[tid * 4 + 1] = ex + a0; off[tid * 4 + 2] = ex + a0 + a1; off[tid * 4 + 3] = ex + a0 + a1 + a2;
        if (tid == 63) off[256] = inc;
    }
    __syncthreads();
    if (bid == 0 && tid <= 256) p.eoff[tid] = off[tid];
    for (int a = tid; a < 576; a += NTHR) {
        const int t = bid * 72 + (a >> 3);
        if (skip_ctx && (t % LTOT) < CTXL) continue;
        const int e = p.ridx[(size_t)t * 8 + (a & 7)];
        const int slot = off[e] + pre[e] + p.lrank[(size_t)bid * 576 + a];
        p.slot_tok[slot] = t; p.tok_slot[(size_t)t * 8 + (a & 7)] = slot;
    }
}

__device__ __forceinline__ int build_units(const Params& p, int* ustart  ) {
    __syncthreads();
    if (threadIdx.x == 0) { int s = 0; for (int e = 0; e < 256; ++e) { ustart[e] = s; s += (p.eoff[e + 1] - p.eoff[e] + 63) >> 6; } ustart[256] = s; }
    __syncthreads();
    return ustart[256];
}
__device__ __forceinline__ int find_expert(const int* ustart, int ub) { int lo = 0, hi = 255; while (lo < hi) { const int mid = (lo + hi + 1) >> 1; if (ustart[mid] <= ub) lo = mid; else hi = mid - 1; } return lo; }
__device__ __noinline__ void phase_exp_up(const Params& p, int l, float* lds) {
    const int tid = threadIdx.x, ty = tid >> 5, tx = tid & 31;
    int* ustart = (int*)(lds + 4096);
    const int nub = build_units(p, ustart);
    for (int t = blockIdx.x; t < nub * 2; t += gridDim.x) {
        const int ub = t >> 1, ct = t & 1, col0 = ct * 128;
        const int e = find_expert(ustart, ub);
        const int s0 = p.eoff[e] + (ub - ustart[e]) * 64, s1 = p.eoff[e + 1];
        const float* wg = p.eg + ((size_t)l * 256 + e) * 1024 * 256; const float* wu = p.eu + ((size_t)l * 256 + e) * 1024 * 256;
        auto fa = [&](int r, int k) { const int s = s0 + r; return s < s1 ? ldv(p.u, (size_t)p.slot_tok[s] * DM + k) : 0.f; };
        float ag[4][4], au[4][4];
        sgemm_tile(ag, 1024, fa, [&](int k, int c) { return wg[(size_t)k * 256 + col0 + c]; }, lds);
        sgemm_tile(au, 1024, fa, [&](int k, int c) { return wu[(size_t)k * 256 + col0 + c]; }, lds);
#pragma unroll
        for (int i = 0; i < 4; ++i) { const int s = s0 + ty * 4 + i;
            if (s < s1) st4(p.Hs, (size_t)s * 256 + col0 + tx * 4, make_float4(siluf_(ag[i][0]) * au[i][0], siluf_(ag[i][1]) * au[i][1], siluf_(ag[i][2]) * au[i][2], siluf_(ag[i][3]) * au[i][3])); }
    }
}
__device__ __noinline__ void phase_exp_down(const Params& p, int l, float* lds) {
    const int tid = threadIdx.x, ty = tid >> 5, tx = tid & 31;
    int* ustart = (int*)(lds + 4096);
    const int nub = build_units(p, ustart);
    for (int t = blockIdx.x; t < nub * 8; t += gridDim.x) {
        const int ub = t >> 3, ct = t & 7, col0 = ct * 128;
        const int e = find_expert(ustart, ub);
        const int s0 = p.eoff[e] + (ub - ustart[e]) * 64, s1 = p.eoff[e + 1];
        const float* wd = p.ed + ((size_t)l * 256 + e) * 256 * 1024;
        float acc[4][4];
        sgemm_tile(acc, 256,
            [&](int r, int k) { const int s = s0 + r; return s < s1 ? ldv(p.Hs, (size_t)s * 256 + k) : 0.f; },
            [&](int k, int c) { return wd[(size_t)k * 1024 + col0 + c]; }, lds);
#pragma unroll
        for (int i = 0; i < 4; ++i) { const int s = s0 + ty * 4 + i;
            if (s < s1) { const float w = p.slot_w[s]; st4(p.Ys, (size_t)s * DM + col0 + tx * 4, make_float4(acc[i][0] * w, acc[i][1] * w, acc[i][2] * w, acc[i][3] * w)); } }
    }
}

__device__ __noinline__ void phase_ln2(const Params& p, int l) {
    const int wid = threadIdx.x >> 6, lane = threadIdx.x & 63;
    const int stride = gridDim.x * 8;
    int r = blockIdx.x * 8 + wid;
    int4 sa = make_int4(0, 0, 0, 0), sb = sa;
    if (r < T_ALL && !(l == 1 && (r % LTOT) < CTXL)) { sa = *(const int4*)(p.tok_slot + (size_t)r * 8); sb = *(const int4*)(p.tok_slot + (size_t)r * 8 + 4); }
    for (; r < T_ALL; r += stride) {
        const int rn = r + stride;
        int4 na = make_int4(0, 0, 0, 0), nb = na;
        if (rn < T_ALL && !(l == 1 && (rn % LTOT) < CTXL)) { na = *(const int4*)(p.tok_slot + (size_t)rn * 8); nb = *(const int4*)(p.tok_slot + (size_t)rn * 8 + 4); }
        const int sl[8] = {sa.x, sa.y, sa.z, sa.w, sb.x, sb.y, sb.z, sb.w};
        sa = na; sb = nb;
        if (l == 1 && (r % LTOT) < CTXL) continue;
        const float4 wa = *(const float4*)(p.rw + (size_t)r * 8), wb = *(const float4*)(p.rw + (size_t)r * 8 + 4);
        const float wk[8] = {wa.x, wa.y, wa.z, wa.w, wb.x, wb.y, wb.z, wb.w};
        unsigned yraw[8][4];
        const unsigned char* ys8 = (const unsigned char*)p.Ys;
#pragma unroll
        for (int k = 0; k < 8; ++k)
#pragma unroll
            for (int i = 0; i < 4; ++i) yraw[k][i] = *(const unsigned*)(ys8 + (size_t)sl[k] * DM + i * 256 + lane * 4);
        float ft[16];
#pragma unroll
        for (int i = 0; i < 4; ++i) { const int q = *(const int*)((const unsigned char*)p.f + (size_t)r * DM + i * 256 + lane * 4);
            ft[i * 4] = __builtin_amdgcn_cvt_f32_fp8(q, 0) * (1.f / 32.f); ft[i * 4 + 1] = __builtin_amdgcn_cvt_f32_fp8(q, 1) * (1.f / 32.f); ft[i * 4 + 2] = __builtin_amdgcn_cvt_f32_fp8(q, 2) * (1.f / 32.f); ft[i * 4 + 3] = __builtin_amdgcn_cvt_f32_fp8(q, 3) * (1.f / 32.f); }
        float fr8[16];
#pragma unroll
        for (int i = 0; i < 16; ++i) fr8[i] = 0.f;
#pragma unroll
        for (int k = 0; k < 8; ++k)
#pragma unroll
            for (int i = 0; i < 4; ++i) { const int q = (int)yraw[k][i];
                fr8[i * 4] += wk[k] * __builtin_amdgcn_cvt_f32_fp8(q, 0); fr8[i * 4 + 1] += wk[k] * __builtin_amdgcn_cvt_f32_fp8(q, 1); fr8[i * 4 + 2] += wk[k] * __builtin_amdgcn_cvt_f32_fp8(q, 2); fr8[i * 4 + 3] += wk[k] * __builtin_amdgcn_cvt_f32_fp8(q, 3); }
#pragma unroll
        for (int i = 0; i < 16; ++i) ft[i] += fr8[i] * (1.f / 16.f);
        float v[16];
#pragma unroll
        for (int i = 0; i < 4; ++i) { const float4 t = ld4((const bf16_t*)p.hbuf, (size_t)r * DM + i * 256 + lane * 4); v[i * 4] = t.x; v[i * 4 + 1] = t.y; v[i * 4 + 2] = t.z; v[i * 4 + 3] = t.w; }
        const int mi = mod_idx(r);
        const float* m5 = modv(p, l, mi, 5);
#pragma unroll
        for (int i = 0; i < 4; ++i) { const float4 m4 = *(const float4*)(m5 + i * 256 + lane * 4);
            v[i * 4] = ALPHA * v[i * 4] + m4.x * ft[i * 4]; v[i * 4 + 1] = ALPHA * v[i * 4 + 1] + m4.y * ft[i * 4 + 1]; v[i * 4 + 2] = ALPHA * v[i * 4 + 2] + m4.z * ft[i * 4 + 2]; v[i * 4 + 3] = ALPHA * v[i * 4 + 3] + m4.w * ft[i * 4 + 3]; }
        float mu, rstd; ln_stats(v, mu, rstd);
        const float* g = p.ln2g + l * DM; const float* bb = p.ln2b + l * DM;
        const int b = r / LTOT, j = r - b * LTOT;
#pragma unroll
        for (int i = 0; i < 4; ++i) { const int c = i * 256 + lane * 4; const float4 g4 = *(const float4*)(g + c), b4 = *(const float4*)(bb + c);
            v[i * 4 + 0] = (v[i * 4 + 0] - mu) * rstd * g4.x + b4.x; v[i * 4 + 1] = (v[i * 4 + 1] - mu) * rstd * g4.y + b4.y;
            v[i * 4 + 2] = (v[i * 4 + 2] - mu) * rstd * g4.z + b4.z; v[i * 4 + 3] = (v[i * 4 + 3] - mu) * rstd * g4.w + b4.w;
            const float4 o = make_float4(v[i * 4], v[i * 4 + 1], v[i * 4 + 2], v[i * 4 + 3]);
            if (l == 1) { if (j >= CTXL) *(float4*)(p.out + ((size_t)b * SEQ + (j - CTXL)) * DM + c) = o; }
            else st4((bf16_t*)p.hbuf, (size_t)r * DM + c, o); }
        if (l == 0) {
            ln_stats(v, mu, rstd);
            const float* sh = modv(p, 1, mi, 0); const float* sc = modv(p, 1, mi, 1);
#pragma unroll
            for (int i = 0; i < 4; ++i) { const int c = i * 256 + lane * 4; const float4 s4 = *(const float4*)(sh + c), c4 = *(const float4*)(sc + c);
                float4 o; o.x = (v[i * 4 + 0] - mu) * rstd * (1.f + c4.x) + s4.x; o.y = (v[i * 4 + 1] - mu) * rstd * (1.f + c4.y) + s4.y;
                o.z = (v[i * 4 + 2] - mu) * rstd * (1.f + c4.z) + s4.z; o.w = (v[i * 4 + 3] - mu) * rstd * (1.f + c4.w) + s4.w;
                st_fp8x4(p.u8, (size_t)r * DM + c, o); }
        }
    }
}

template <class T> __device__ __forceinline__ T* uni(T* p) { const unsigned long long v = (unsigned long long)p; const unsigned lo = __builtin_amdgcn_readfirstlane((unsigned)v), hi = __builtin_amdgcn_readfirstlane((unsigned)(v >> 32)); return (T*)(((unsigned long long)hi << 32) | lo); }
__device__ __forceinline__ int uni(int v) { return __builtin_amdgcn_readfirstlane(v); }
namespace pg8 {
#define PG8_LAS __attribute__((address_space(3)))
#define GAS __attribute__((address_space(1)))
typedef short bf16x8 __attribute__((ext_vector_type(8)));
typedef float f32x4 __attribute__((ext_vector_type(4)));
typedef unsigned u32x4 __attribute__((ext_vector_type(4)));
constexpr int BM = 256, BK = 64, HALF = 128, HTB = HALF * BK * 2, STAGE_BYTES = 8 * HTB, NXCD = 8, WGM = 8;
__host__ __device__ __forceinline__ int lds_byte(int r, int c) { const int st = (r >> 4) * 2 + (c >> 5), rr = r & 15, cc = c & 31, ob = rr * 64 + cc * 2; return st * 1024 + (ob ^ (((ob >> 9) & 1) << 5)); }
__host__ __device__ __forceinline__ void stage_rc(int b, int& R, int& C) { const int st = b / 1024, sb = b % 1024, swz = sb ^ (((sb >> 9) & 1) << 5); R = (st >> 1) * 16 + swz / 64; C = (st & 1) * 32 + (swz % 64) / 2; }
__host__ __device__ __forceinline__ int perm32(int rho) { const int n = rho >> 4, i = rho & 15; return 8 * (i >> 2) + 4 * n + (i & 3); }
struct Unit { const char* a; const char* b; int pm, pn, aux; };
typedef __bf16 bf16n2 __attribute__((ext_vector_type(2)));
typedef float f32n2 __attribute__((ext_vector_type(2)));
__device__ __forceinline__ unsigned cvt_pk_bf16(float lo, float hi) { return __builtin_bit_cast(unsigned, __builtin_convertvector((f32n2){lo, hi}, bf16n2)); }
__device__ __forceinline__ u32x4 pack8(const f32x4 v0, const f32x4 v1) { u32x4 w; w.x = cvt_pk_bf16(v0[0], v0[1]); w.y = cvt_pk_bf16(v0[2], v0[3]); w.z = cvt_pk_bf16(v1[0], v1[1]); w.w = cvt_pk_bf16(v1[2], v1[3]); return w; }

typedef int i32x8 __attribute__((ext_vector_type(8)));
typedef int i32x4 __attribute__((ext_vector_type(4)));
__device__ __forceinline__ f32x4 mfma_fp8(const bf16x8 (&b)[2], const bf16x8 (&a)[2], f32x4 c) {
    const i32x8 bv = __builtin_shufflevector(__builtin_bit_cast(i32x4, b[0]), __builtin_bit_cast(i32x4, b[1]), 0, 1, 2, 3, 4, 5, 6, 7);
    const i32x8 av = __builtin_shufflevector(__builtin_bit_cast(i32x4, a[0]), __builtin_bit_cast(i32x4, a[1]), 0, 1, 2, 3, 4, 5, 6, 7);
    asm volatile("v_mfma_f32_16x16x128_f8f6f4 %0, %1, %2, %0" : "+v"(c) : "v"(bv), "v"(av));
    return c;
}
typedef unsigned u32x2f __attribute__((ext_vector_type(2)));
__device__ __forceinline__ u32x2f pack8_fp8(const f32x4 v0, const f32x4 v1, const float s) {
    f32x4 a = v0 * s, b = v1 * s;
#pragma unroll
    for (int j = 0; j < 4; ++j) { a[j] = fminf(fmaxf(a[j], -448.f), 448.f); b[j] = fminf(fmaxf(b[j], -448.f), 448.f); }
    int q0 = 0, q1 = 0;
    q0 = __builtin_amdgcn_cvt_pk_fp8_f32(a[0], a[1], q0, false); q0 = __builtin_amdgcn_cvt_pk_fp8_f32(a[2], a[3], q0, true);
    q1 = __builtin_amdgcn_cvt_pk_fp8_f32(b[0], b[1], q1, false); q1 = __builtin_amdgcn_cvt_pk_fp8_f32(b[2], b[3], q1, true);
    return (u32x2f){(unsigned)q0, (unsigned)q1};
}
struct TileOrder {
    int nM, nN, nwg, G, c, sub, pn_off; bool skipctx;
    const char *A0, *B0; size_t a_tile, b_tile, a_sub, b_sub;
    __device__ __forceinline__ unsigned row_off(const Unit&, int) const { return 0u; }
    __device__ void init(int M, int N, int G_, int c_, int sub_) { nM = M / BM; nN = N / BM; nwg = nM * nN; G = G_; c = c_; sub = sub_; skipctx = false; pn_off = 0; }
    __device__ bool next(int i, Unit& u) const {
        const int ti = i / sub, s = i - ti * sub;
        const long L = (long)ti * G + c; if (L >= nwg) return false;
        int wgid = (int)L; { const int q = nwg / NXCD, r = nwg % NXCD, xcd = wgid % NXCD, off = wgid / NXCD; wgid = (xcd < r ? xcd * (q + 1) : r * (q + 1) + (xcd - r) * q) + off; }
        const int nig = WGM * nN, gid = wgid / nig, fm = gid * WGM, gsz = (nM - fm) < WGM ? (nM - fm) : WGM;
        u.pm = fm + ((wgid % nig) % gsz); u.pn = (wgid % nig) / gsz + pn_off; u.aux = s;
        if (skipctx) u.pm = (u.pm >> 3) * 9 + 1 + (u.pm & 7);
        u.a = A0 + (size_t)s * a_sub + (size_t)u.pm * a_tile; u.b = B0 + (size_t)s * b_sub + (size_t)u.pn * b_tile;
        return true;
    }
};

struct CtxKVOrder {
    int G, c; const char *A0, *B0; size_t a_tile, b_tile;
    __device__ __forceinline__ unsigned row_off(const Unit&, int) const { return 0u; }
    __device__ __forceinline__ bool next(int i, Unit& u) const {
        const int uid = i * G + c; if (uid >= 40) return false;
        const int b = uid / 5, k = uid - b * 5;
        u.pm = b * 9; u.pn = k == 0 ? 2 : 8 + k; u.aux = 0;
        u.a = A0 + (size_t)u.pm * a_tile; u.b = B0 + (size_t)u.pn * b_tile;
        return true;
    }
};
template <bool GATHER = false, bool FP8 = false, class Epi, class Sched>
__device__ __forceinline__ void gemm_phase(PG8_LAS unsigned char* lds, const int K, const int lda, const int ldb, const Sched& S, const Epi& E) {
    int tid = threadIdx.x; asm volatile("" : "+v"(tid));
    const int wid = __builtin_amdgcn_readfirstlane(tid >> 6), lane = tid & 63, wr = wid >> 2, wc = wid & 3, fr = lane & 15, fq = lane >> 4;
    const int nt = K / BK;
    unsigned voffA[2], voffB[2];
#pragma unroll
    for (int i = 0; i < 2; ++i) { int R, C; stage_rc(tid * 16 + i * 8192, R, C); const int Rb = (R & ~31) + perm32(R & 31);
        voffA[i] = (unsigned)(R * lda + C) * 2u; voffB[i] = (unsigned)(Rb * ldb + C) * 2u; }
    unsigned gc[2][2], gn[2][2];
    const size_t kstep = (size_t)(BK * 2);
    const size_t hstepA = (size_t)HALF * lda * 2, hstepB = (size_t)HALF * ldb * 2;
    const unsigned ldsw = (unsigned)wid * 1024u;
    const int aoff = lds_byte(wr * 64 + fr, fq * 8), boff = lds_byte(wc * 32 + fr, fq * 8);
#define PG8_SA(b, h) (((b) * 2 + (h)) * HTB)
#define PG8_SB(b, h) ((4 + (b) * 2 + (h)) * HTB)
#define PG8_STAGE(bufoff, gbase, voff) do { _Pragma("unroll") for (int _i = 0; _i < 2; ++_i) \
        __builtin_amdgcn_global_load_lds((const unsigned*)((const char*)(gbase) + (voff)[_i]), (PG8_LAS unsigned*)(lds + (bufoff) + ldsw + _i * 8192), 16, 0, 0); } while (0)
#define PG8_STAGE_A(bufoff, gbase, h, late) do { _Pragma("unroll") for (int _i = 0; _i < 2; ++_i) { \
        const size_t _o = GATHER ? (size_t)(((late) && last) ? gn[h][_i] : gc[h][_i]) : (size_t)voffA[_i] + (size_t)(h) * hstepA; \
        __builtin_amdgcn_global_load_lds((const unsigned*)((const char*)(gbase) + _o), (PG8_LAS unsigned*)(lds + (bufoff) + ldsw + _i * 8192), 16, 0, 0); } } while (0)
#define PG8_GOFF(dst, un) do { if (GATHER) { _Pragma("unroll") for (int _h = 0; _h < 2; ++_h) _Pragma("unroll") for (int _i = 0; _i < 2; ++_i) { int _R, _C; stage_rc(tid * 16 + _i * 8192, _R, _C); dst[_h][_i] = S.row_off(un, _h * HALF + _R) + (unsigned)(_C * 2); } } } while (0)
#define PG8_LDA(dst, b, h) do { _Pragma("unroll") for (int m = 0; m < 4; ++m) _Pragma("unroll") for (int k = 0; k < 2; ++k) dst[m][k] = *(const PG8_LAS bf16x8*)(lds + PG8_SA(b, h) + aoff + m * 2048 + k * 1024); } while (0)
#define PG8_LDB(dst, b, h) do { _Pragma("unroll") for (int n = 0; n < 2; ++n) _Pragma("unroll") for (int k = 0; k < 2; ++k) dst[n][k] = *(const PG8_LAS bf16x8*)(lds + PG8_SB(b, h) + boff + n * 2048 + k * 1024); } while (0)
#define PG8_MMA(ai, bj, At, Bt) do { __builtin_amdgcn_s_setprio(1); _Pragma("unroll") for (int m = 0; m < 4; ++m) _Pragma("unroll") for (int n = 0; n < 2; ++n) { \
        if constexpr (FP8) acc[ai][bj][m][n] = mfma_fp8(Bt[n], At[m], acc[ai][bj][m][n]); \
        else { _Pragma("unroll") for (int k = 0; k < 2; ++k) acc[ai][bj][m][n] = __builtin_amdgcn_mfma_f32_16x16x32_bf16(Bt[n][k], At[m][k], acc[ai][bj][m][n], 0, 0, 0); } } \
        __builtin_amdgcn_s_setprio(0); } while (0)
#define PG8_WAIT_V(n) asm volatile("s_waitcnt vmcnt(" #n ")" ::: "memory")
#define PG8_WAIT_L(n) asm volatile("s_waitcnt lgkmcnt(" #n ")" ::: "memory")
#define PG8_BAR __builtin_amdgcn_s_barrier()
#define PG8_SCHED __builtin_amdgcn_sched_barrier(0)
    Unit cur, nxt; int ui = 0;
    if (!S.next(0, cur)) return;
    f32x4 acc[2][2][4][2];
#pragma unroll
    for (int a = 0; a < 2; ++a)
#pragma unroll
        for (int b = 0; b < 2; ++b)
#pragma unroll
            for (int m = 0; m < 4; ++m)
#pragma unroll
                for (int n = 0; n < 2; ++n) acc[a][b][m][n] = (f32x4){0.f, 0.f, 0.f, 0.f};
    bf16x8 At[4][2], B0[2][2], B1[2][2];
    const char* cA = cur.a; const char* cB = cur.b;
    PG8_GOFF(gc, cur); PG8_GOFF(gn, cur);
    { const bool last = false;
    PG8_STAGE(PG8_SB(0, 0), cB, voffB); PG8_STAGE_A(PG8_SA(0, 0), cA, 0, false); PG8_STAGE(PG8_SB(0, 1), cB + hstepB, voffB); PG8_STAGE_A(PG8_SA(0, 1), cA, 1, false);
    if (wr == 1) PG8_BAR;
    PG8_WAIT_V(4); PG8_BAR;
    PG8_STAGE(PG8_SB(1, 0), cB + kstep, voffB); PG8_STAGE_A(PG8_SA(1, 0), cA + kstep, 0, false); PG8_STAGE(PG8_SB(1, 1), cB + hstepB + kstep, voffB); }
    PG8_WAIT_V(6); PG8_BAR;
    for (;;) {
        const bool has_next = S.next(ui + 1, nxt);
        const char* nA = has_next ? nxt.a : cA; const char* nB = has_next ? nxt.b : cB;
        if (has_next) PG8_GOFF(gn, nxt);
#pragma unroll 1
        for (int t = 0; t < nt; t += 2) {
            const bool last = (t == nt - 2);
            const char* a1 = cA + (size_t)(t + 1) * kstep;
            const char* a2 = last ? nA : cA + (size_t)(t + 2) * kstep; const char* b2 = last ? nB : cB + (size_t)(t + 2) * kstep;
            const char* a3 = a2 + kstep; const char* b3 = b2 + kstep;
            PG8_LDB(B0, 0, 0); PG8_SCHED; PG8_LDA(At, 0, 0); PG8_STAGE_A(PG8_SA(1, 1), a1, 1, false);
            PG8_WAIT_L(8); PG8_BAR; PG8_WAIT_L(0); PG8_MMA(0, 0, At, B0); PG8_BAR; PG8_SCHED;
            PG8_LDB(B1, 0, 1); PG8_STAGE(PG8_SB(0, 0), b2, voffB);
            PG8_BAR; PG8_WAIT_L(0); PG8_MMA(0, 1, At, B1); PG8_BAR;
            PG8_LDA(At, 0, 1); PG8_STAGE_A(PG8_SA(0, 0), a2, 0, true);
            PG8_BAR; PG8_WAIT_L(0); PG8_MMA(1, 0, At, B0); PG8_BAR; PG8_SCHED;
            PG8_STAGE(PG8_SB(0, 1), b2 + hstepB, voffB);
            PG8_WAIT_V(6); PG8_BAR; PG8_MMA(1, 1, At, B1); PG8_BAR;
            PG8_LDB(B0, 1, 0); PG8_SCHED; PG8_LDA(At, 1, 0); PG8_STAGE_A(PG8_SA(0, 1), a2, 1, true);
            PG8_WAIT_L(8); PG8_BAR; PG8_WAIT_L(0); PG8_MMA(0, 0, At, B0); PG8_BAR; PG8_SCHED;
            PG8_LDB(B1, 1, 1); PG8_STAGE(PG8_SB(1, 0), b3, voffB);
            PG8_BAR; PG8_WAIT_L(0); PG8_MMA(0, 1, At, B1); PG8_BAR;
            PG8_LDA(At, 1, 1); PG8_STAGE_A(PG8_SA(1, 0), a3, 0, true);
            PG8_BAR; PG8_WAIT_L(0); PG8_MMA(1, 0, At, B0); PG8_BAR; PG8_SCHED;
            PG8_STAGE(PG8_SB(1, 1), b3 + hstepB, voffB);
            PG8_WAIT_V(6); PG8_BAR; PG8_MMA(1, 1, At, B1); PG8_BAR;
        }
        if constexpr (FP8) asm volatile("s_nop 7\n\ts_nop 7\n\ts_nop 7" ::: "memory");
        const bool keep = E(acc, cur, wr, wc, fr, fq);
        if (!has_next) break;
        if (!keep) {
#pragma unroll
        for (int a = 0; a < 2; ++a)
#pragma unroll
            for (int b = 0; b < 2; ++b)
#pragma unroll
                for (int m = 0; m < 4; ++m)
#pragma unroll
                    for (int n = 0; n < 2; ++n) acc[a][b][m][n] = (f32x4){0.f, 0.f, 0.f, 0.f}; }
        cur = nxt; cA = nA; cB = nB; ++ui;
        if (GATHER) {
#pragma unroll
            for (int _h = 0; _h < 2; ++_h)
#pragma unroll
                for (int _i = 0; _i < 2; ++_i) gc[_h][_i] = gn[_h][_i]; }
    }
    PG8_WAIT_V(0);
    if (wr == 0) PG8_BAR;
    PG8_BAR;
#undef PG8_SA
#undef PG8_SB
#undef PG8_STAGE
#undef PG8_STAGE_A
#undef PG8_GOFF
#undef PG8_LDA
#undef PG8_LDB
#undef PG8_MMA
#undef PG8_WAIT_V
#undef PG8_WAIT_L
#undef PG8_BAR
#undef PG8_SCHED
}
typedef f32x4 Acc[2][2][4][2];

struct EpiStoreBf16 {
    bf16_t* O; int ldc;
    __device__ __forceinline__ bool operator()(Acc& acc, const Unit& u, int wr, int wc, int fr, int fq) const {
        const int row0 = u.pm * BM + wr * 64 + fr, col0 = u.pn * BM + wc * 32 + 8 * fq;
#pragma unroll
        for (int ai = 0; ai < 2; ++ai)
#pragma unroll
            for (int m = 0; m < 4; ++m) { bf16_t* rowp = O + (size_t)(row0 + ai * HALF + m * 16) * ldc + col0;
#pragma unroll
                for (int bj = 0; bj < 2; ++bj) *(GAS u32x4*)(rowp + bj * HALF) = pack8(acc[ai][bj][m][0], acc[ai][bj][m][1]); }
        return false;
    }
};
struct EpiStoreFp8 {
    unsigned char* O; int ldc; float scale;
    __device__ __forceinline__ bool operator()(Acc& acc, const Unit& u, int wr, int wc, int fr, int fq) const {
        const int row0 = u.pm * BM + wr * 64 + fr, col0 = u.pn * BM + wc * 32 + 8 * fq;
#pragma unroll
        for (int ai = 0; ai < 2; ++ai)
#pragma unroll
            for (int m = 0; m < 4; ++m) { unsigned char* rowp = O + (size_t)(row0 + ai * HALF + m * 16) * ldc + col0;
#pragma unroll
                for (int bj = 0; bj < 2; ++bj) *(GAS u32x2f*)(rowp + bj * HALF) = pack8_fp8(acc[ai][bj][m][0], acc[ai][bj][m][1], scale); }
        return false;
    }
};
struct EpiInproj {
    bf16_t* O; unsigned char* Gq; unsigned char* PF;
    __device__ __forceinline__ bool operator()(Acc& acc, const Unit& u, int wr, int wc, int fr, int fq) const {
        const int row0 = u.pm * BM + wr * 64 + fr, cw = wc * 32 + 8 * fq;
        const float sc = (u.pn >= 3 && u.pn < 7) ? 1.f / (16.f * 64.f) : 1.f / (16.f * 256.f);
        if (u.pn >= 3 && u.pn < 7) {
#pragma unroll
            for (int ai = 0; ai < 2; ++ai)
#pragma unroll
                for (int m = 0; m < 4; ++m) { unsigned char* rowp = PF + (size_t)(row0 + ai * HALF + m * 16) * 1024 + (u.pn - 3) * BM + cw;
#pragma unroll
                    for (int bj = 0; bj < 2; ++bj) *(GAS u32x2f*)(rowp + bj * HALF) = pack8_fp8(acc[ai][bj][m][0], acc[ai][bj][m][1], sc * 4.f); }
        } else if (u.pn < 13) {
#pragma unroll
            for (int ai = 0; ai < 2; ++ai)
#pragma unroll
                for (int m = 0; m < 4; ++m) { bf16_t* rowp = O + (size_t)(row0 + ai * HALF + m * 16) * PW + u.pn * BM + cw;
#pragma unroll
                    for (int bj = 0; bj < 2; ++bj) *(GAS u32x4*)(rowp + bj * HALF) = pack8(acc[ai][bj][m][0] * sc, acc[ai][bj][m][1] * sc); }
        } else {
            typedef unsigned u32x2e __attribute__((ext_vector_type(2)));
#pragma unroll
            for (int ai = 0; ai < 2; ++ai)
#pragma unroll
                for (int m = 0; m < 4; ++m) { unsigned char* rowp = Gq + (size_t)(row0 + ai * HALF + m * 16) * 1536 + (((u.pn - 13) * BM + cw) >> 1);
#pragma unroll
                    for (int bj = 0; bj < 2; ++bj) { const f32x4 a0 = acc[ai][bj][m][0], a1 = acc[ai][bj][m][1];
                        const float ce = -sc * 1.44269504089f;
                        unsigned w4 = 0u;
#pragma unroll
                        for (int j = 0; j < 4; ++j) { const float g0 = __builtin_amdgcn_rcpf(fmaf(__builtin_amdgcn_exp2f(a0[j] * ce), 0.0625f, 0.0625f)), g1 = __builtin_amdgcn_rcpf(fmaf(__builtin_amdgcn_exp2f(a1[j] * ce), 0.0625f, 0.0625f));
                            const unsigned n0 = (unsigned)fminf(g0, 15.f), n1 = (unsigned)fminf(g1, 15.f);
                            w4 |= (n0 << (4 * j)) | (n1 << (16 + 4 * j)); }
                        *(GAS unsigned*)(rowp + bj * (HALF / 2)) = w4; } }
        }
        return false;
    }
};
struct EpiF32 {
    float* C; int ldc;
    __device__ __forceinline__ bool operator()(Acc& acc, const Unit& u, int wr, int wc, int fr, int fq) const {
        const int row0 = u.pm * BM + wr * 64 + fr, col0 = u.pn * BM + wc * 32 + 8 * fq;
#pragma unroll
        for (int ai = 0; ai < 2; ++ai)
#pragma unroll
            for (int m = 0; m < 4; ++m) { float* rowp = C + (size_t)(row0 + ai * HALF + m * 16) * ldc + col0;
#pragma unroll
                for (int bj = 0; bj < 2; ++bj) { *(GAS f32x4*)(rowp + bj * HALF) = acc[ai][bj][m][0]; *(GAS f32x4*)(rowp + bj * HALF + 4) = acc[ai][bj][m][1]; } }
        return false;
    }
};
__device__ __forceinline__ float fsig(float v) { return __builtin_amdgcn_rcpf(1.f + __expf(-v)); }
__device__ __forceinline__ void unpack8(const u32x4 w, float (&g)[8]) {
    g[0] = __uint_as_float(w.x << 16); g[1] = __uint_as_float(w.x & 0xFFFF0000u); g[2] = __uint_as_float(w.y << 16); g[3] = __uint_as_float(w.y & 0xFFFF0000u);
    g[4] = __uint_as_float(w.z << 16); g[5] = __uint_as_float(w.z & 0xFFFF0000u); g[6] = __uint_as_float(w.w << 16); g[7] = __uint_as_float(w.w & 0xFFFF0000u);
}
struct EpiY {
    const unsigned char* Gq; unsigned char* y;
    __device__ __forceinline__ bool operator()(Acc& acc, const Unit& u, int wr, int wc, int fr, int fq) const {
        const int row0 = u.pm * BM + wr * 64 + fr, col0 = u.pn * BM + wc * 32 + 8 * fq, br = u.aux;
        unsigned ga[2][4][2], gb[2][4][2];
#pragma unroll
        for (int ai = 0; ai < 2; ++ai)
#pragma unroll
            for (int m = 0; m < 4; ++m)
#pragma unroll
                for (int bj = 0; bj < 2; ++bj) { const unsigned char* gp = Gq + (size_t)(row0 + ai * HALF + m * 16) * 1536 + br * 512 + ((col0 + bj * HALF) >> 1);
                    ga[ai][m][bj] = *(const GAS unsigned*)gp; gb[ai][m][bj] = br < 2 ? *(const GAS unsigned*)(gp + 512) : ga[ai][m][bj]; }
#pragma unroll
        for (int ai = 0; ai < 2; ++ai)
#pragma unroll
            for (int m = 0; m < 4; ++m)
#pragma unroll
                for (int bj = 0; bj < 2; ++bj) {
#pragma unroll
                    for (int j = 0; j < 8; ++j) { const float a = (float)((ga[ai][m][bj] >> (4 * j)) & 15u) * (1.f / 16.f) + (1.f / 32.f), b = (float)((gb[ai][m][bj] >> (4 * j)) & 15u) * (1.f / 16.f) + (1.f / 32.f);
                        const float f = br < 2 ? a * __builtin_amdgcn_rcpf(b) : a;
                        if (j < 4) acc[ai][bj][m][0][j] *= f; else acc[ai][bj][m][1][j - 4] *= f; }
                    if (br == 2) *(GAS u32x2f*)(y + (size_t)(row0 + ai * HALF + m * 16) * DM + col0 + bj * HALF) = pack8_fp8(acc[ai][bj][m][0], acc[ai][bj][m][1], 16.f / 4096.f); }
        return br != 2;
    }
};
struct EpiZ {
    const float* hsrc_x; const float* hsrc_ctx; const bf16_t* hbuf; const float* mod2; bf16_t* z; int layer;
    __device__ __forceinline__ bool operator()(Acc& acc, const Unit& u, int wr, int wc, int fr, int fq) const {
        const int b = u.pm / 9, jt = u.pm - b * 9;
        const float* hbase = jt == 0 ? hsrc_ctx + (size_t)b * CTXL * DM : hsrc_x + ((size_t)b * SEQ + (jt - 1) * 256) * DM;
        const bf16_t* hb16 = hbuf + (size_t)u.pm * BM * DM;
        const float* m2 = mod2 + (size_t)(jt == 0 ? 8 : b) * 6144;
        int rl0 = wr * 64 + fr; asm volatile("" : "+v"(rl0));
        const int col0 = u.pn * BM + wc * 32 + 8 * fq;
#pragma unroll
        for (int bj = 0; bj < 2; ++bj) { const int c = col0 + bj * HALF; const f32x4 ma = *(const GAS f32x4*)(m2 + c) * (1.f / 8192.f), mb = *(const GAS f32x4*)(m2 + c + 4) * (1.f / 8192.f);
#pragma unroll
            for (int ai = 0; ai < 2; ++ai) {
                f32x4 h0[4], h1[4];
                if (layer == 0) {
#pragma unroll
                    for (int m = 0; m < 4; ++m) { const float* hp = hbase + (size_t)(rl0 + ai * HALF + m * 16) * DM + c; h0[m] = *(const GAS f32x4*)hp; h1[m] = *(const GAS f32x4*)(hp + 4); }
                } else {
                    u32x4 hr[4];
#pragma unroll
                    for (int m = 0; m < 4; ++m) hr[m] = *(const GAS u32x4*)(hb16 + (size_t)(rl0 + ai * HALF + m * 16) * DM + c);
#pragma unroll
                    for (int m = 0; m < 4; ++m) { float t[8]; unpack8(hr[m], t); h0[m] = (f32x4){t[0], t[1], t[2], t[3]}; h1[m] = (f32x4){t[4], t[5], t[6], t[7]}; }
                }
#pragma unroll
                for (int m = 0; m < 4; ++m) { bf16_t* zp = z + ((size_t)u.pm * BM + rl0 + ai * HALF + m * 16) * DM + c;
                    *(GAS u32x4*)zp = pack8(ALPHA * h0[m] + ma * acc[ai][bj][m][0], ALPHA * h1[m] + mb * acc[ai][bj][m][1]); } } }
        return false;
    }
};
struct EpiG {
    float* logits; bf16_t* shact;
    __device__ __forceinline__ bool operator()(Acc& acc, const Unit& u, int wr, int wc, int fr, int fq) const {
        const int row0 = u.pm * BM + wr * 64 + fr, cw = wc * 32 + 8 * fq;
#pragma unroll
        for (int ai = 0; ai < 2; ++ai)
#pragma unroll
            for (int m = 0; m < 4; ++m) { const size_t row = (size_t)(row0 + ai * HALF + m * 16);
                if (u.pn == 0) {
#pragma unroll
                    for (int bj = 0; bj < 2; ++bj) { float* lp = logits + row * 256 + bj * HALF + cw; *(f32x4*)lp = acc[ai][bj][m][0]; *(GAS f32x4*)(lp + 4) = acc[ai][bj][m][1]; }
                } else {
                    f32x4 v0, v1;
#pragma unroll
                    for (int j = 0; j < 4; ++j) { const float g0 = acc[ai][0][m][0][j], g1 = acc[ai][0][m][1][j];
                        v0[j] = g0 * fsig(g0) * acc[ai][1][m][0][j]; v1[j] = g1 * fsig(g1) * acc[ai][1][m][1][j]; }
                    *(GAS u32x4*)(shact + row * 256 + (u.pn - 1) * 128 + cw) = pack8(v0, v1);
                } }
        return false;
    }
};

struct ExpOrder {
    const PG8_LAS int* ustart; const int* eoff; const int* slot_tok; int nct, nun, G, c; bool gather;
    const char* A; const char* B; size_t b_exp, b_tile; unsigned lda_bytes;
    __device__ __forceinline__ bool next(int i, Unit& u) const {
        if (i >= 32) return false;
        const int e = ustart[600 + 4 * i]; if (e < 0) return false;
        const int s0 = ustart[600 + 4 * i + 1], ct = ustart[600 + 4 * i + 3];
        u.pm = s0; u.aux = ustart[600 + 4 * i + 2]; u.pn = ct;
        u.b = B + (size_t)e * b_exp + (size_t)ct * b_tile; u.a = gather ? A : A + (size_t)s0 * lda_bytes;
        return true;
    }
    __device__ __forceinline__ unsigned row_off(const Unit& u, int r) const { const int s = u.pm + r; const int t = s < u.aux ? ((const GAS int*)slot_tok)[s] : 0; return (unsigned)t * lda_bytes; }
};
__device__ __forceinline__ u32x4 widen16(const unsigned ax, const unsigned ay, const unsigned bx, const unsigned by) {
    const auto rx = __builtin_amdgcn_permlane16_swap(ax, bx, false, false);
    const auto ry = __builtin_amdgcn_permlane16_swap(ay, by, false, false);
    return (u32x4){rx[0], ry[0], rx[1], ry[1]};
}
struct EpiHs {
    unsigned char* Hs; const float* slot_w;
    __device__ __forceinline__ bool operator()(Acc& acc, const Unit& u, int wr, int wc, int fr, int fq) const {
        const int cw = u.pn * 128 + wc * 32 + 8 * (fq & ~1);
#pragma unroll
        for (int ai = 0; ai < 2; ++ai)
#pragma unroll
            for (int mp = 0; mp < 4; mp += 2) {
                unsigned q[2][2];
#pragma unroll
                for (int d = 0; d < 2; ++d) { const int m = mp + d; const float ws = 4.f / 4096.f;
                    f32x4 v0, v1;
#pragma unroll
                    for (int j = 0; j < 4; ++j) { const float a0 = acc[ai][0][m][0][j], a1 = acc[ai][0][m][1][j];
                        const float ce = -1.44269504089f / 4096.f, wo = ws * (1.f / 4096.f);
                        v0[j] = fminf(fmaxf(a0 * acc[ai][1][m][0][j] * __builtin_amdgcn_rcpf(1.f + __builtin_amdgcn_exp2f(a0 * ce)) * wo, -448.f), 448.f);
                        v1[j] = fminf(fmaxf(a1 * acc[ai][1][m][1][j] * __builtin_amdgcn_rcpf(1.f + __builtin_amdgcn_exp2f(a1 * ce)) * wo, -448.f), 448.f); }
                    int q0 = 0, q1 = 0;
                    q0 = __builtin_amdgcn_cvt_pk_fp8_f32(v0[0], v0[1], q0, false); q0 = __builtin_amdgcn_cvt_pk_fp8_f32(v0[2], v0[3], q0, true);
                    q1 = __builtin_amdgcn_cvt_pk_fp8_f32(v1[0], v1[1], q1, false); q1 = __builtin_amdgcn_cvt_pk_fp8_f32(v1[2], v1[3], q1, true);
                    q[d][0] = (unsigned)q0; q[d][1] = (unsigned)q1; }
                const u32x4 w = widen16(q[0][0], q[0][1], q[1][0], q[1][1]);
                const int s = u.pm + ai * HALF + wr * 64 + (mp + (fq & 1)) * 16 + fr;
                if (s < u.aux) *(GAS u32x4*)(Hs + (size_t)s * 256 + cw) = w; }
        return false;
    }
};
struct EpiYs {
    unsigned char* Ys;
    __device__ __forceinline__ bool operator()(Acc& acc, const Unit& u, int wr, int wc, int fr, int fq) const {
        const int col0 = u.pn * BM + wc * 32 + 8 * (fq & ~1);
#pragma unroll
        for (int ai = 0; ai < 2; ++ai)
#pragma unroll
            for (int mp = 0; mp < 4; mp += 2) { const int s = u.pm + ai * HALF + wr * 64 + (mp + (fq & 1)) * 16 + fr;
#pragma unroll
                for (int bj = 0; bj < 2; ++bj) {
                    unsigned q[2][2];
#pragma unroll
                    for (int d = 0; d < 2; ++d) { f32x4 a0 = acc[ai][bj][mp + d][0] * (1.f / 64.f), a1 = acc[ai][bj][mp + d][1] * (1.f / 64.f);
#pragma unroll
                        for (int j = 0; j < 4; ++j) { a0[j] = fminf(fmaxf(a0[j], -400.f), 400.f); a1[j] = fminf(fmaxf(a1[j], -400.f), 400.f); }
                        int q0 = 0, q1 = 0;
                        q0 = __builtin_amdgcn_cvt_pk_fp8_f32(a0[0], a0[1], q0, false); q0 = __builtin_amdgcn_cvt_pk_fp8_f32(a0[2], a0[3], q0, true);
                        q1 = __builtin_amdgcn_cvt_pk_fp8_f32(a1[0], a1[1], q1, false); q1 = __builtin_amdgcn_cvt_pk_fp8_f32(a1[2], a1[3], q1, true);
                        q[d][0] = (unsigned)q0; q[d][1] = (unsigned)q1; }
                    const u32x4 w = widen16(q[0][0], q[0][1], q[1][0], q[1][1]);
                    if (s < u.aux) *(GAS u32x4*)(Ys + (size_t)s * DM + col0 + bj * HALF) = w; } }
        return false;
    }
};
}

__device__ __forceinline__ void xpose64(const float* src, size_t ldsrc, bf16_t* drow, size_t K) {
#pragma unroll 1
    for (int hh = 0; hh < 2; ++hh) {
        float4 v[32];
#pragma unroll
        for (int j = 0; j < 32; ++j) v[j] = *(const float4*)(src + (size_t)(hh * 32 + j) * ldsrc);
#pragma unroll
        for (int q = 0; q < 4; ++q) { pg8::u32x4 o;
            o.x = pg8::cvt_pk_bf16(v[8 * q + 0].x, v[8 * q + 1].x); o.y = pg8::cvt_pk_bf16(v[8 * q + 2].x, v[8 * q + 3].x); o.z = pg8::cvt_pk_bf16(v[8 * q + 4].x, v[8 * q + 5].x); o.w = pg8::cvt_pk_bf16(v[8 * q + 6].x, v[8 * q + 7].x);
            *(GAS pg8::u32x4*)(drow + hh * 32 + q * 8) = o; }
#pragma unroll
        for (int q = 0; q < 4; ++q) { pg8::u32x4 o;
            o.x = pg8::cvt_pk_bf16(v[8 * q + 0].y, v[8 * q + 1].y); o.y = pg8::cvt_pk_bf16(v[8 * q + 2].y, v[8 * q + 3].y); o.z = pg8::cvt_pk_bf16(v[8 * q + 4].y, v[8 * q + 5].y); o.w = pg8::cvt_pk_bf16(v[8 * q + 6].y, v[8 * q + 7].y);
            *(GAS pg8::u32x4*)(drow + K + hh * 32 + q * 8) = o; }
#pragma unroll
        for (int q = 0; q < 4; ++q) { pg8::u32x4 o;
            o.x = pg8::cvt_pk_bf16(v[8 * q + 0].z, v[8 * q + 1].z); o.y = pg8::cvt_pk_bf16(v[8 * q + 2].z, v[8 * q + 3].z); o.z = pg8::cvt_pk_bf16(v[8 * q + 4].z, v[8 * q + 5].z); o.w = pg8::cvt_pk_bf16(v[8 * q + 6].z, v[8 * q + 7].z);
            *(GAS pg8::u32x4*)(drow + 2 * K + hh * 32 + q * 8) = o; }
#pragma unroll
        for (int q = 0; q < 4; ++q) { pg8::u32x4 o;
            o.x = pg8::cvt_pk_bf16(v[8 * q + 0].w, v[8 * q + 1].w); o.y = pg8::cvt_pk_bf16(v[8 * q + 2].w, v[8 * q + 3].w); o.z = pg8::cvt_pk_bf16(v[8 * q + 4].w, v[8 * q + 5].w); o.w = pg8::cvt_pk_bf16(v[8 * q + 6].w, v[8 * q + 7].w);
            *(GAS pg8::u32x4*)(drow + 3 * K + hh * 32 + q * 8) = o; }
    }
}
__device__ __forceinline__ void phase_wprep(const Params& p, int part, float* lds) {
    int tid_ = threadIdx.x; asm volatile("" : "+v"(tid_));
    const int wid = tid_ >> 6, lane = tid_ & 63;
    const int gw = blockIdx.x * 8 + wid, ngw = gridDim.x * 8;
    {
        const int gtid = blockIdx.x * NTHR + tid_, gn = gridDim.x * NTHR;
        for (int i = gtid; i < 2 * 1024 * 2048 + 256 * 512; i += gn) {
            int ph; bool sn; bf16_t* dst;
            if (i < 2 * 1024 * 2048) { const int par = i >> 21, m = (i >> 11) & 1023, k = i & 2047, n = k & 1023; sn = k >= 1024; ph = ((2 * m + par) * n) & 2047; dst = (par ? p.Do : p.De) + (size_t)m * 2048 + k; }
            else { const int q = i - 2 * 1024 * 2048, kk = q >> 9, k = q & 511, n = k & 255; sn = k >= 256; ph = (8 * kk * n) & 2047; dst = p.Dc + q; }
            const float a = (float)ph * (1.f / 1024.f);
            *dst = f2bf(sn ? -sinpif(a) : cospif(a));
        }
    }
}

#define LDS_U(lds) ((PG8_LAS unsigned char*)(unsigned)__builtin_amdgcn_readfirstlane((unsigned)(unsigned long long)(PG8_LAS unsigned char*)(lds)))
__device__ __forceinline__ void phase_inproj_f(const Params& p, int l_, float* lds, bool deferred) {
    const int l = uni(l_);
    const int NC = l == 1 ? 23 : 24;
    pg8::EpiInproj E; E.O = uni(p.P); E.Gq = uni(p.Gq); E.PF = uni(p.PF);
    {
        pg8::TileOrder S;
        if (!deferred) S.init(l == 1 ? 64 * 256 : T_ALL, NC * 256, gridDim.x, blockIdx.x, 1);
        else { S.init(l == 1 ? 64 * 256 : T_ALL, (25 - NC) * 256, gridDim.x, (blockIdx.x + 128) & 255, 1); S.pn_off = NC; }
        S.skipctx = (l == 1);
        S.A0 = (const char*)uni(p.u8); S.B0 = (const char*)uni(p.Wt_in) + (size_t)l * PW * 1024; S.a_tile = (size_t)256 * 1024; S.b_tile = (size_t)256 * 1024; S.a_sub = 0; S.b_sub = 0;
        pg8::gemm_phase<false, true>(LDS_U(lds), 512, 512, 512, S, E);
    }
    if (l == 1 && !deferred) {
        pg8::CtxKVOrder S; S.G = gridDim.x; S.c = (blockIdx.x + 64) & 255;
        S.A0 = (const char*)uni(p.u8); S.B0 = (const char*)uni(p.Wt_in) + (size_t)l * PW * 1024; S.a_tile = (size_t)256 * 1024; S.b_tile = (size_t)256 * 1024;
        pg8::gemm_phase<false, true>(LDS_U(lds), 512, 512, 512, S, E);
    }
}
__device__ __forceinline__ void phase_ygemm_f(const Params& p, int l_, float* lds) {
    const int l = uni(l_);
    pg8::TileOrder S; S.init(l == 1 ? 64 * 256 : T_ALL, DM, gridDim.x, blockIdx.x, 3); S.skipctx = (l == 1);
    S.A0 = (const char*)uni(p.oa); S.a_sub = (size_t)T_ALL * 512 * 2;
    S.B0 = (const char*)uni(p.Wt_br) + (size_t)l * 3 * 1024 * 512; S.b_sub = (size_t)1024 * 512;
    S.a_tile = (size_t)256 * 512; S.b_tile = (size_t)256 * 512;
    pg8::EpiY E; E.Gq = uni(p.Gq); E.y = (unsigned char*)uni(p.y);
    pg8::gemm_phase<false, true>(LDS_U(lds), 256, 256, 256, S, E);
}
__device__ __forceinline__ void phase_outproj_f(const Params& p, int l_, float* lds) {
    const int l = uni(l_);
    pg8::TileOrder S; S.init(l == 1 ? 64 * 256 : T_ALL, DM, gridDim.x, blockIdx.x, 1); S.skipctx = (l == 1);
    S.A0 = (const char*)uni(p.y); S.B0 = (const char*)uni(p.Wt_out) + (size_t)l * 1024 * 1024; S.a_tile = (size_t)256 * 1024; S.b_tile = (size_t)256 * 1024; S.a_sub = 0; S.b_sub = 0;
    pg8::EpiZ E; E.hsrc_x = uni(p.x); E.hsrc_ctx = uni(p.ctx); E.hbuf = (const bf16_t*)uni(p.hbuf); E.mod2 = uni(p.mod) + (size_t)l * 9 * 6144 + 2 * 1024; E.z = (bf16_t*)uni(p.z); E.layer = l;
    pg8::gemm_phase<false, true>(LDS_U(lds), 512, 512, 512, S, E);
}
__device__ __forceinline__ void phase_router_shared_f(const Params& p, int l_, float* lds) {
    const int l = uni(l_);
    pg8::TileOrder S; S.init(l == 1 ? 64 * 256 : T_ALL, 768, gridDim.x, blockIdx.x, 1); S.skipctx = (l == 1);
    S.A0 = (const char*)uni(p.u); S.B0 = (const char*)(uni(p.Wt_g) + (size_t)l * 768 * 1024); S.a_tile = (size_t)256 * 1024 * 2; S.b_tile = (size_t)256 * 1024 * 2; S.a_sub = 0; S.b_sub = 0;
    pg8::EpiG E; E.logits = uni(p.logits); E.shact = uni(p.shact);
    pg8::gemm_phase(LDS_U(lds), 1024, 1024, 1024, S, E);
}
__device__ __forceinline__ void phase_shdown_f(const Params& p, int l_, float* lds) {
    const int l = uni(l_);
    pg8::TileOrder S; S.init(l == 1 ? 64 * 256 : T_ALL, DM, gridDim.x, blockIdx.x, 1); S.skipctx = (l == 1);
    S.A0 = (const char*)uni(p.shact); S.B0 = (const char*)(uni(p.Wt_sd) + (size_t)l * 1024 * 256); S.a_tile = (size_t)256 * 256 * 2; S.b_tile = (size_t)256 * 256 * 2; S.a_sub = 0; S.b_sub = 0;
    pg8::EpiStoreFp8 E; E.O = (unsigned char*)uni(p.f); E.ldc = DM; E.scale = 32.f;
    pg8::gemm_phase(LDS_U(lds), 256, 256, 256, S, E);
}

__device__ __noinline__ void phase_normrope(const Params& p, int l) {
    const int wid = threadIdx.x >> 6, lane = threadIdx.x & 63, li = lane & 7;
    float qg[8], kg[8];
#pragma unroll
    for (int j = 0; j < 8; ++j) { qg[j] = p.qn[l * 64 + li * 8 + j]; kg[j] = p.kn[l * 64 + li * 8 + j]; }
    const int tio = (li >> 2) * 16 + (li & 1) * 8;
    pg8::u32x4 raw[4], rawn[4]; float4 tb[4], tbn[4];
    auto load = [&](int r, pg8::u32x4 (&rw)[4], float4 (&t)[4]) {
        const int b = r / LTOT, j0 = r - b * LTOT; const int s = j0 >= CTXL ? j0 - CTXL : 0;
        t[0] = *(const float4*)(p.ropec + s * 32 + tio); t[1] = *(const float4*)(p.ropec + s * 32 + tio + 4); t[2] = *(const float4*)(p.ropes + s * 32 + tio); t[3] = *(const float4*)(p.ropes + s * 32 + tio + 4);
        const bf16_t* row = p.P + (size_t)r * PW;
        rw[0] = *(const pg8::u32x4*)(row + C_QA + lane * 8);
        rw[1] = lane < 16 ? *(const pg8::u32x4*)(row + C_KA + lane * 8) : (pg8::u32x4){0u, 0u, 0u, 0u};
        rw[2] = *(const pg8::u32x4*)(row + C_QC + lane * 8);
        rw[3] = *(const pg8::u32x4*)(row + C_KC + lane * 8); };
    const int stride = gridDim.x * 8;
    int r = blockIdx.x * 8 + wid;
    if (r < T_ALL) load(r, raw, tb);
    for (; r < T_ALL; r += stride) {
        if (r + stride < T_ALL) load(r + stride, rawn, tbn);
        const int b = r / LTOT, j0 = r - b * LTOT; const bool lat = j0 >= CTXL;
        float cs[8], sn[8];
        cs[0] = tb[0].x; cs[1] = tb[0].y; cs[2] = tb[0].z; cs[3] = tb[0].w; cs[4] = tb[1].x; cs[5] = tb[1].y; cs[6] = tb[1].z; cs[7] = tb[1].w;
        sn[0] = tb[2].x; sn[1] = tb[2].y; sn[2] = tb[2].z; sn[3] = tb[2].w; sn[4] = tb[3].x; sn[5] = tb[3].y; sn[6] = tb[3].z; sn[7] = tb[3].w;
        if (!lat) {
#pragma unroll
            for (int j = 0; j < 8; ++j) { cs[j] = 1.f; sn[j] = 0.f; } }
        bf16_t* row = p.P + (size_t)r * PW;
#pragma unroll
        for (int i = 0; i < 4; ++i) {
            float x[8]; pg8::unpack8(raw[i], x);
            if (i < 2) {
                float ss = 0.f;
#pragma unroll
                for (int j = 0; j < 8; ++j) ss += x[j] * x[j];
                ss += __shfl_xor(ss, 1); ss += __shfl_xor(ss, 2); ss += __shfl_xor(ss, 4);
                const float sc = rsqrtf(ss * (1.f / 64.f) + 1e-6f);
#pragma unroll
                for (int j = 0; j < 8; ++j) x[j] *= sc * (i == 0 ? qg[j] : kg[j]);
            }
            float y[8];
#pragma unroll
            for (int j = 0; j < 8; ++j) { const float pr = __shfl_xor(x[j], 2); const float rot = (li & 2) ? pr : -pr; y[j] = x[j] * cs[j] + rot * sn[j]; }
            pg8::u32x4 o; o.x = pg8::cvt_pk_bf16(y[0], y[1]); o.y = pg8::cvt_pk_bf16(y[2], y[3]); o.z = pg8::cvt_pk_bf16(y[4], y[5]); o.w = pg8::cvt_pk_bf16(y[6], y[7]);
            const int col = i == 0 ? C_QA : i == 1 ? C_KA : i == 2 ? C_QC : C_KC;
            if (i != 1 || lane < 16) *(pg8::u32x4*)(row + col + lane * 8) = o;
        }
#pragma unroll
        for (int i = 0; i < 4; ++i) { raw[i] = rawn[i]; tb[i] = tbn[i]; }
    }
}
__device__ __noinline__ void phase_xt(const Params& p, bool do_ctx, float* lds) {
    const int wid = threadIdx.x >> 6, lane = threadIdx.x & 63;
    bf16_t* te = (bf16_t*)lds + wid * (2 * 64 * 72);
    bf16_t* to = te + 64 * 72;
    __syncthreads();
    const int gw = blockIdx.x * 8 + wid, ngw = gridDim.x * 8;
    const int nlat = 8 * 2 * 8 * 16, nctx = do_ctx ? 8 * 2 * 8 * 4 : 0;
    for (int it = gw; it < nlat + nctx; it += ngw) {
        const bool lat = it < nlat; const int q = lat ? it : it - nlat;
        int b, wh, cb, nb;
        if (lat) { b = q >> 8; wh = (q >> 7) & 1; cb = (q >> 4) & 7; nb = q & 15; } else { b = q >> 6; wh = (q >> 5) & 1; cb = (q >> 2) & 7; nb = q & 3; }
        const int r8 = lane >> 3, c8 = (lane & 7) * 8;
#pragma unroll
        for (int i = 0; i < 8; ++i) {
            const int n = nb * 64 + i * 8 + r8;
            const size_t row = (size_t)b * LTOT + (lat ? CTXL + n : n);
            const unsigned char* src = p.PF + row * 1024 + wh * 512 + cb * 64 + c8;
            float x0[8], x1[8];
            typedef float f32x2x __attribute__((ext_vector_type(2)));
            { const pg8::u32x2f w0 = *(const GAS pg8::u32x2f*)src, w1 = lat ? *(const GAS pg8::u32x2f*)(src + (size_t)1024 * 1024) : w0;
#pragma unroll
              for (int h = 0; h < 2; ++h) { const int a = (int)(h ? w0.y : w0.x), bq = (int)(h ? w1.y : w1.x);
                  const f32x2x a0 = __builtin_amdgcn_cvt_pk_f32_fp8(a, false), a1 = __builtin_amdgcn_cvt_pk_f32_fp8(a, true), b0 = __builtin_amdgcn_cvt_pk_f32_fp8(bq, false), b1 = __builtin_amdgcn_cvt_pk_f32_fp8(bq, true);
                  x0[4 * h] = a0[0] * 0.25f; x0[4 * h + 1] = a0[1] * 0.25f; x0[4 * h + 2] = a1[0] * 0.25f; x0[4 * h + 3] = a1[1] * 0.25f;
                  x1[4 * h] = b0[0] * 0.25f; x1[4 * h + 1] = b0[1] * 0.25f; x1[4 * h + 2] = b1[0] * 0.25f; x1[4 * h + 3] = b1[1] * 0.25f; } }
#pragma unroll
            for (int j = 0; j < 8; ++j) { te[(c8 + j) * 72 + i * 8 + r8] = f2bf(lat ? x0[j] + x1[j] : x0[j]); if (lat) to[(c8 + j) * 72 + i * 8 + r8] = f2bf(x0[j] - x1[j]); }
        }
        asm volatile("s_waitcnt lgkmcnt(0)" ::: "memory");
#pragma unroll
        for (int i = 0; i < 8; ++i) {
            const int cc = i * 8 + r8;
            const size_t xr = (size_t)b * 512 + cb * 64 + cc;
            if (lat) {
                *(GAS pg8::u32x4*)(p.XTe + xr * 2048 + wh * 1024 + nb * 64 + c8) = *(const pg8::u32x4*)(te + cc * 72 + c8);
                *(GAS pg8::u32x4*)(p.XTo + xr * 2048 + wh * 1024 + nb * 64 + c8) = *(const pg8::u32x4*)(to + cc * 72 + c8);
            } else *(GAS pg8::u32x4*)(p.XTc + xr * 512 + wh * 256 + nb * 64 + c8) = *(const pg8::u32x4*)(te + cc * 72 + c8);
        }
        asm volatile("s_waitcnt lgkmcnt(0)" ::: "memory");
    }
    for (int it = gw; it < 8 * 10 * 36; it += ngw) {
        const int b = it / 360, r = it - b * 360, cb = r / 36, kb = r - cb * 36;
        const int scol = cb < 2 ? C_VA + cb * 64 : C_VC + (cb - 2) * 64;
        bf16_t* dst = cb < 2 ? p.VTa + ((size_t)b * 128 + cb * 64) * LTOT : p.VTc + ((size_t)b * 512 + (cb - 2) * 64) * LTOT;
        const int r8 = lane >> 3, c8 = (lane & 7) * 8;
#pragma unroll
        for (int i = 0; i < 8; ++i) {
            const bf16_t* s = p.P + ((size_t)b * LTOT + kb * 64 + i * 8 + r8) * PW + scol + c8;
            const pg8::u32x4 w = *(const pg8::u32x4*)s;
            const unsigned ww[4] = {w.x, w.y, w.z, w.w};
#pragma unroll
            for (int j = 0; j < 8; ++j) te[(c8 + j) * 72 + i * 8 + r8] = (bf16_t)(ww[j >> 1] >> ((j & 1) * 16));
        }
        asm volatile("s_waitcnt lgkmcnt(0)" ::: "memory");
#pragma unroll
        for (int i = 0; i < 8; ++i) { const int cc = i * 8 + r8;
            *(GAS pg8::u32x4*)(dst + (size_t)cc * LTOT + kb * 64 + c8) = *(const pg8::u32x4*)(te + cc * 72 + c8); }
        asm volatile("s_waitcnt lgkmcnt(0)" ::: "memory");
    }
}
namespace pg8 {
struct FoOrder {
    const char *De, *Do, *XTe, *XTo; int nun, G, c; bool ctx;
    __device__ __forceinline__ unsigned row_off(const Unit&, int) const { return 0u; }
    __device__ __forceinline__ bool next(int i, Unit& u) const {
        const int uid = i * G + c; if (uid >= nun) return false;
        u.pm = ctx ? 0 : uid >> 4; u.pn = uid & 15; u.aux = 0;
        const size_t kb = ctx ? 512 * 2 : 2048 * 2;
        u.a = (u.pm < 4 ? De + (size_t)u.pm * 256 * kb : Do + (size_t)(u.pm - 4) * 256 * kb);
        u.b = (u.pm < 4 ? XTe : XTo) + (size_t)u.pn * 256 * kb;
        return true;
    }
};
struct EpiFo {
    unsigned char* ob; float scale; bool ctx;
    __device__ __forceinline__ bool operator()(Acc& acc, const Unit& u, int wr, int wc, int fr, int fq) const {
        const int b = u.pn >> 1, col0 = (u.pn & 1) * 256 + wc * 32 + 8 * fq;
        const int par = u.pm >> 2, m0 = (u.pm & 3) * 256;
#pragma unroll
        for (int ai = 0; ai < 2; ++ai)
#pragma unroll
            for (int m = 0; m < 4; ++m) { const int rl = ai * HALF + wr * 64 + m * 16 + fr;
                const size_t row = (size_t)b * LTOT + (ctx ? rl : CTXL + 2 * (m0 + rl) + par);
#pragma unroll
                for (int bj = 0; bj < 2; ++bj) *(GAS u32x2f*)(ob + row * 512 + col0 + bj * HALF) = pack8_fp8(acc[ai][bj][m][0], acc[ai][bj][m][1], scale * 16.f); }
        return false;
    }
};
}
__device__ __forceinline__ void phase_fourier_f(const Params& p, bool do_ctx, float* lds) {
    {
        pg8::FoOrder S; S.De = (const char*)uni(p.De); S.Do = (const char*)uni(p.Do); S.XTe = (const char*)uni(p.XTe); S.XTo = (const char*)uni(p.XTo); S.nun = 128; S.G = gridDim.x; S.c = blockIdx.x; S.ctx = false;
        pg8::EpiFo E; E.ob = (unsigned char*)uni(p.ob); E.scale = 1.f / 512.f; E.ctx = false;
        pg8::gemm_phase<false>(LDS_U(lds), 2048, 2048, 2048, S, E);
    }
    if (do_ctx) {
        pg8::FoOrder S; S.De = (const char*)uni(p.Dc); S.Do = S.De; S.XTe = (const char*)uni(p.XTc); S.XTo = S.XTe; S.nun = 16; S.G = gridDim.x; S.c = (blockIdx.x + 56) & 255; S.ctx = true;
        pg8::EpiFo E; E.ob = (unsigned char*)uni(p.ob); E.scale = 0.00552427172802f; E.ctx = true;
        pg8::gemm_phase<false>(LDS_U(lds), 512, 512, 512, S, E);
    }
}

namespace fa {
typedef short bf16x8 __attribute__((ext_vector_type(8)));
typedef short bf16x4 __attribute__((ext_vector_type(4)));
typedef float f32x16 __attribute__((ext_vector_type(16)));
typedef unsigned u32x2 __attribute__((ext_vector_type(2)));
typedef float f32x2 __attribute__((ext_vector_type(2)));
#define FA_KROW 144
#define FA_VROW 136
#define FA_C 0.18033688011f
template <int DV>
__device__ __forceinline__ void attn_unit_f(const Params& p, const int l, const int b, const int head, const int qblk, const bool ctxq, LAS unsigned char* lds, int tid) {
    constexpr int NK = DV == 64 ? 1 : 2, NDT = DV / 32, BUFSZ = NK * 64 * FA_KROW + DV * FA_VROW, NCH = DV == 64 ? 1 : 2;
    const int wid = __builtin_amdgcn_readfirstlane(tid >> 6), lane = tid & 63, lq = lane & 31, lh = lane >> 5;
    const int nt = ctxq ? 4 : 36;
    const bf16_t* P = uni(p.P);
    const size_t rowb = (size_t)b * LTOT;
    int tok0, qcol, kmap;
    if (DV == 64) { tok0 = qblk * 64 + (wid & 1) * 32; qcol = C_QA + (head * 4 + (wid >> 1)) * 64; kmap = 0; }
    else { tok0 = qblk * 128 + (wid & 3) * 32; qcol = C_QC + head * 128 + (wid >> 2) * 64; kmap = wid >> 2; }
    const size_t qrow = rowb + (ctxq ? 0 : CTXL) + tok0 + lq;
    bf16x8 Q[4];
#pragma unroll
    for (int ks = 0; ks < 4; ++ks) Q[ks] = *(const GAS bf16x8*)(P + qrow * PW + qcol + ks * 16 + 8 * lh);
    const bf16_t* ksrc[NCH]; const bf16_t* vsrc[NCH]; int kdst[NCH], vdst[NCH];
#pragma unroll
    for (int i = 0; i < NCH; ++i) {
        const int c = tid + i * NTHR, mm = c >> 9, key = (c >> 3) & 63, piece = c & 7;
        ksrc[i] = P + (rowb + key) * PW + (DV == 64 ? C_KA + head * 64 : C_KC + head * 128 + mm * 64) + piece * 8;
        kdst[i] = mm * 64 * FA_KROW + key * FA_KROW + piece * 16;
        const int d = c >> 3;
        vsrc[i] = (DV == 64 ? uni(p.VTa) + ((size_t)(b * 2 + head) * 64 + d) * LTOT : uni(p.VTc) + ((size_t)(b * 4 + head) * 128 + d) * LTOT) + piece * 8;
        vdst[i] = NK * 64 * FA_KROW + d * FA_VROW + piece * 16;
    }
    pg8::u32x4 kreg[NCH], vreg[NCH];
#define FA_LOAD(t) do { _Pragma("unroll") for (int _i = 0; _i < NCH; ++_i) { kreg[_i] = *(const GAS pg8::u32x4*)(ksrc[_i] + (size_t)(t) * 64 * PW); vreg[_i] = *(const GAS pg8::u32x4*)(vsrc[_i] + (t) * 64); } } while (0)
#define FA_WRITE(bufo) do { _Pragma("unroll") for (int _i = 0; _i < NCH; ++_i) { *(LAS pg8::u32x4*)(lds + (bufo) + kdst[_i]) = kreg[_i]; \
        *(LAS u32x2*)(lds + (bufo) + vdst[_i]) = (u32x2){vreg[_i].x, vreg[_i].y}; *(LAS u32x2*)(lds + (bufo) + vdst[_i] + 8) = (u32x2){vreg[_i].z, vreg[_i].w}; } } while (0)
    f32x16 O[NDT];
#pragma unroll
    for (int dt = 0; dt < NDT; ++dt)
#pragma unroll
        for (int i = 0; i < 16; ++i) O[dt][i] = 0.f;
    float mrow = -1.0e30f, lrow = 0.f;
    __syncthreads();
    FA_LOAD(0); FA_WRITE(0); FA_LOAD(1); FA_WRITE(BUFSZ); FA_LOAD(2);
    const int koff = kmap * 64 * FA_KROW + lq * FA_KROW + 16 * lh;
    const int voff = NK * 64 * FA_KROW + lq * FA_VROW + 8 * lh;
    f32x16 S0, S1;
    constexpr bool HOISTK = (DV == 64);
    bf16x8 kf[8];
#define FA_KREAD(bufo) do { _Pragma("unroll") for (int ks = 0; ks < 4; ++ks) { kf[2 * ks] = *(const LAS bf16x8*)(lds + (bufo) + koff + ks * 32); kf[2 * ks + 1] = *(const LAS bf16x8*)(lds + (bufo) + koff + ks * 32 + 32 * FA_KROW); } } while (0)
#define FA_QK(A0, A1) do { _Pragma("unroll") for (int i = 0; i < 16; ++i) { A0[i] = 0.f; A1[i] = 0.f; } __builtin_amdgcn_s_setprio(1); \
        _Pragma("unroll") for (int ks = 0; ks < 4; ++ks) { \
            A0 = __builtin_amdgcn_mfma_f32_32x32x16_bf16(kf[2 * ks], Q[ks], A0, 0, 0, 0); \
            A1 = __builtin_amdgcn_mfma_f32_32x32x16_bf16(kf[2 * ks + 1], Q[ks], A1, 0, 0, 0); } __builtin_amdgcn_s_setprio(0); } while (0)
    __syncthreads();
    FA_KREAD(0); FA_QK(S0, S1);
    int bcur = 0, bnx1 = BUFSZ, bnx2 = 2 * BUFSZ;
#pragma unroll 1
    for (int t = 0; t < nt; ++t) {
        __syncthreads();
        if (t + 2 < nt) FA_WRITE(bnx2);
        if (t + 3 < nt) FA_LOAD(t + 3);
        if (HOISTK && t + 1 < nt) FA_KREAD(bnx1);
        constexpr int NVF = DV == 64 ? 4 : 0;
        pg8::u32x4 vf[NVF > 0 ? NVF : 1][2];
#pragma unroll
        for (int q4 = 0; q4 < NVF; ++q4)
#pragma unroll
            for (int dt = 0; dt < 2; ++dt) { const int a = bcur + voff + dt * 32 * FA_VROW + q4 * 32;
                const u32x2 lo = *(const LAS u32x2*)(lds + a), hi = *(const LAS u32x2*)(lds + a + 16); vf[q4][dt] = (pg8::u32x4){lo.x, lo.y, hi.x, hi.y}; }
        f32x16 N0, N1;
        if (t + 1 < nt) { if (!HOISTK) FA_KREAD(bnx1); FA_QK(N0, N1); }
        float mx;
        { float m8[8];
#pragma unroll
          for (int i = 0; i < 8; ++i) asm("v_max3_f32 %0, %1, %2, %3" : "=v"(m8[i]) : "v"(S0[2 * i]), "v"(S0[2 * i + 1]), "v"(S1[2 * i]));
#pragma unroll
          for (int i = 0; i < 4; ++i) asm("v_max3_f32 %0, %1, %2, %3" : "=v"(m8[i]) : "v"(m8[i]), "v"(S1[4 * i + 1]), "v"(S1[4 * i + 3]));
          float a, b, c, d;
          asm("v_max3_f32 %0, %1, %2, %3" : "=v"(a) : "v"(m8[0]), "v"(m8[1]), "v"(m8[2]));
          asm("v_max3_f32 %0, %1, %2, %3" : "=v"(b) : "v"(m8[3]), "v"(m8[4]), "v"(m8[5]));
          asm("v_max3_f32 %0, %1, %2, %3" : "=v"(c) : "v"(m8[6]), "v"(m8[7]), "v"(a));
          asm("v_max3_f32 %0, %1, %2, %3" : "=v"(d) : "v"(b), "v"(c), "v"(mrow));
          mx = d; }
        float mnew; { const auto sw = __builtin_amdgcn_permlane32_swap(__float_as_uint(mx), __float_as_uint(mx), false, false); mnew = fmaxf(__uint_as_float(sw[0]), __uint_as_float(sw[1])); }
        if (__builtin_amdgcn_ballot_w64(mnew > mrow) != 0ull) {
            const float alpha = __builtin_amdgcn_exp2f((mrow - mnew) * FA_C);
            lrow *= alpha;
#pragma unroll
            for (int dt = 0; dt < NDT; ++dt)
#pragma unroll
                for (int i = 0; i < 16; ++i) O[dt][i] *= alpha;
            mrow = mnew;
        }
        const float mc = mrow * FA_C;
        f32x2 rs2 = {0.f, 0.f};
#pragma unroll
        for (int i = 0; i < 8; ++i) {
            f32x2 e0 = {S0[2 * i], S0[2 * i + 1]}, e1 = {S1[2 * i], S1[2 * i + 1]};
            e0 = e0 * FA_C - mc; e1 = e1 * FA_C - mc;
            e0.x = __builtin_amdgcn_exp2f(e0.x); e0.y = __builtin_amdgcn_exp2f(e0.y); e1.x = __builtin_amdgcn_exp2f(e1.x); e1.y = __builtin_amdgcn_exp2f(e1.y);
            S0[2 * i] = e0.x; S0[2 * i + 1] = e0.y; S1[2 * i] = e1.x; S1[2 * i + 1] = e1.y;
            rs2 += e0 + e1;
        }
        lrow += rs2.x + rs2.y;
#pragma unroll
        for (int kh = 0; kh < 2; ++kh)
#pragma unroll
            for (int s2 = 0; s2 < 2; ++s2) {
                pg8::u32x4 pw;
                if (kh == 0) { pw.x = pg8::cvt_pk_bf16(S0[8 * s2], S0[8 * s2 + 1]); pw.y = pg8::cvt_pk_bf16(S0[8 * s2 + 2], S0[8 * s2 + 3]); pw.z = pg8::cvt_pk_bf16(S0[8 * s2 + 4], S0[8 * s2 + 5]); pw.w = pg8::cvt_pk_bf16(S0[8 * s2 + 6], S0[8 * s2 + 7]); }
                else { pw.x = pg8::cvt_pk_bf16(S1[8 * s2], S1[8 * s2 + 1]); pw.y = pg8::cvt_pk_bf16(S1[8 * s2 + 2], S1[8 * s2 + 3]); pw.z = pg8::cvt_pk_bf16(S1[8 * s2 + 4], S1[8 * s2 + 5]); pw.w = pg8::cvt_pk_bf16(S1[8 * s2 + 6], S1[8 * s2 + 7]); }
                const bf16x8 pf = __builtin_bit_cast(bf16x8, pw);
#pragma unroll
                for (int dt = 0; dt < NDT; ++dt) {
                    pg8::u32x4 vw;
                    if (dt < 2 && kh * 2 + s2 < NVF) vw = vf[kh * 2 + s2 < NVF ? kh * 2 + s2 : 0][dt];
                    else { const int a = bcur + voff + dt * 32 * FA_VROW + (kh * 32 + 16 * s2) * 2;
                        const u32x2 lo = *(const LAS u32x2*)(lds + a), hi = *(const LAS u32x2*)(lds + a + 16); vw = (pg8::u32x4){lo.x, lo.y, hi.x, hi.y}; }
                    O[dt] = __builtin_amdgcn_mfma_f32_32x32x16_bf16(__builtin_bit_cast(bf16x8, vw), pf, O[dt], 0, 0, 0);
                }
            }
        S0 = N0; S1 = N1;
        { const int tmp = bcur; bcur = bnx1; bnx1 = bnx2; bnx2 = tmp; }
    }
#undef FA_QK
#undef FA_KREAD
    { const auto sw = __builtin_amdgcn_permlane32_swap(__float_as_uint(lrow), __float_as_uint(lrow), false, false); lrow = __uint_as_float(sw[0]) + __uint_as_float(sw[1]); }
    const float inv = 1.f / lrow;
    const size_t orow = rowb + (ctxq ? 0 : CTXL) + tok0 + lq;
    if (DV == 64) {
        unsigned char* o = (unsigned char*)uni(p.oa) + orow * 512 + (head * 4 + (wid >> 1)) * 64 + 4 * lh;
        const float i16 = inv * 16.f;
#pragma unroll
        for (int dt = 0; dt < NDT; ++dt)
#pragma unroll
            for (int g4 = 0; g4 < 4; ++g4) { int q = 0;
                q = __builtin_amdgcn_cvt_pk_fp8_f32(fminf(fmaxf(O[dt][4 * g4] * i16, -448.f), 448.f), fminf(fmaxf(O[dt][4 * g4 + 1] * i16, -448.f), 448.f), q, false);
                q = __builtin_amdgcn_cvt_pk_fp8_f32(fminf(fmaxf(O[dt][4 * g4 + 2] * i16, -448.f), 448.f), fminf(fmaxf(O[dt][4 * g4 + 3] * i16, -448.f), 448.f), q, true);
                *(GAS int*)(o + dt * 32 + 8 * g4) = q; }
    } else {
        __syncthreads();
        LAS float* xch = (LAS float*)lds + (wid & 3) * (64 * 64) + lane;
        if (wid >= 4) {
#pragma unroll
            for (int dt = 0; dt < NDT; ++dt)
#pragma unroll
                for (int i = 0; i < 16; ++i) xch[(dt * 16 + i) * 64] = O[dt][i] * inv;
        }
        __syncthreads();
        if (wid < 4) {
            const float lam = uni(p.lam)[l];
            float ss = 0.f;
#pragma unroll
            for (int dt = 0; dt < NDT; ++dt)
#pragma unroll
                for (int i = 0; i < 16; ++i) { const float v = O[dt][i] * inv - lam * xch[(dt * 16 + i) * 64]; O[dt][i] = v; ss += v * v; }
            { const auto sw = __builtin_amdgcn_permlane32_swap(__float_as_uint(ss), __float_as_uint(ss), false, false); ss = __uint_as_float(sw[0]) + __uint_as_float(sw[1]); }
            const float sc = rsqrtf(ss * (1.f / 128.f) + 1e-6f) * (1.f - lam_init_of(l)) * 16.f;
            const float* gsub = uni(p.subln) + l * 128 + 4 * lh;
            unsigned char* o = (unsigned char*)uni(p.oc) + orow * 512 + head * 128 + 4 * lh;
#pragma unroll
            for (int dt = 0; dt < NDT; ++dt)
#pragma unroll
                for (int g4 = 0; g4 < 4; ++g4) { const pg8::f32x4 g = *(const GAS pg8::f32x4*)(gsub + dt * 32 + 8 * g4);
                    int q = 0;
                    q = __builtin_amdgcn_cvt_pk_fp8_f32(fminf(fmaxf(O[dt][4 * g4] * sc * g.x, -448.f), 448.f), fminf(fmaxf(O[dt][4 * g4 + 1] * sc * g.y, -448.f), 448.f), q, false);
                    q = __builtin_amdgcn_cvt_pk_fp8_f32(fminf(fmaxf(O[dt][4 * g4 + 2] * sc * g.z, -448.f), 448.f), fminf(fmaxf(O[dt][4 * g4 + 3] * sc * g.w, -448.f), 448.f), q, true);
                    *(GAS int*)(o + dt * 32 + 8 * g4) = q; }
        }
    }
#undef FA_LOAD
#undef FA_WRITE
}
}
__device__ __noinline__ void phase_conv_dma(const Params& p, int mode, int l, int t_begin, int ntiles, int t_step, float* ldsf);
__device__ __noinline__ void phase_conv_ring(const Params& p, int l, int chunk, float* ldsf, unsigned* ctr);
__device__ __forceinline__ void phase_attn_f(const Params& p, int l_, bool do_ctx, unsigned char* smem, float* ldsf) {
    const int l = uni(l_);
    LAS unsigned char* lds = LDS_U(ldsf);
    unsigned* ctr = uni(p.actr) + l * 32 + (blockIdx.x & 7);
    volatile LAS unsigned* slot = (volatile LAS unsigned*)smem + 8;
    const int NA = do_ctx ? 144 : 128;
    const int LIM = l == 0 ? CONV_LIM0 : 384;
    bool have_next = false;
    for (;;) {
        int tid = threadIdx.x; asm volatile("" : "+v"(tid));
        __syncthreads();
        if (tid == 0) { const unsigned k = have_next ? *(volatile LAS unsigned*)36 : atomicAdd(ctr, 1u), q = blockIdx.x & 7; unsigned item;
            int a = -1, j = -1;
            const int G2 = NA < LIM / 2 ? NA : LIM / 2;
            if (k < 3u * G2) { const int g = (int)(k / 3u), r = (int)(k - 3u * (unsigned)g); if (r == 0) a = g; else j = 2 * g + (r - 1); }
            else { const int k2 = (int)(k - 3u * G2); if (k2 < NA - G2) a = G2 + k2; else j = 2 * G2 + (k2 - (NA - G2)); }
            if (a >= 0) item = a < 64 ? q * 64 + a : a < 128 ? 512 + q * 64 + (a - 64) : a < 136 ? 1024 + q * 8 + (a - 128) : 1088 + q * 8 + (a - 136);
            else item = j < LIM ? (0x10000u | (q * 384 + (unsigned)j)) : 0xFFFFFFFFu;
            *slot = item; }
        __syncthreads();
        const unsigned us = (unsigned)__builtin_amdgcn_readfirstlane((int)*slot);
        if (us == 0xFFFFFFFFu) break;
        if (us & 0x10000u) { const int ch = (int)(us & 0xFFFFu); phase_conv_ring(p, l, ch, ldsf, ctr); have_next = true; continue; }
        have_next = false;
        const int u = (int)us;
        if (u < 512) fa::attn_unit_f<128>(p, l, u >> 6, (u >> 4) & 3, u & 15, false, lds, tid);
        else if (u < 1024) { const int v = u - 512; fa::attn_unit_f<64>(p, l, v >> 6, (v >> 5) & 1, v & 31, false, lds, tid); }
        else if (u < 1088) { const int v = u - 1024; fa::attn_unit_f<128>(p, l, v >> 3, (v >> 1) & 3, v & 1, true, lds, tid); }
        else { const int v = u - 1088; fa::attn_unit_f<64>(p, l, v >> 3, (v >> 2) & 1, v & 3, true, lds, tid); }
    }
}

__device__ __forceinline__ void conv_fill(const Params& p, int l, int lim, int maxchunks, float* ldsf) {
    unsigned* ctr2 = uni(p.actr) + l * 32 + 8 + (blockIdx.x & 7);
    volatile LAS unsigned* slot = (volatile LAS unsigned*)32;
    for (int c = 0; c < maxchunks; ++c) {
        int tid = threadIdx.x; asm volatile("" : "+v"(tid));
        __syncthreads();
        if (tid == 0) *slot = atomicAdd(ctr2, 1u);
        __syncthreads();
        const int j = lim + __builtin_amdgcn_readfirstlane((int)*slot);
        if (j >= 384) break;
        const int ch = (blockIdx.x & 7) * 384 + j;
        phase_conv_ring(p, l, ch, ldsf, nullptr);
    }
}
__device__ __forceinline__ void xpose64x2(const float* src, size_t ldsrc, bf16_t* drow, size_t K) {
    typedef float f2v __attribute__((ext_vector_type(2)));
    f2v v[64];
#pragma unroll
    for (int j = 0; j < 64; ++j) v[j] = __builtin_nontemporal_load((const f2v*)(src + (size_t)j * ldsrc));
#pragma unroll
    for (int q = 0; q < 8; ++q) { pg8::u32x4 o;
        o.x = pg8::cvt_pk_bf16(v[8 * q + 0].x, v[8 * q + 1].x); o.y = pg8::cvt_pk_bf16(v[8 * q + 2].x, v[8 * q + 3].x); o.z = pg8::cvt_pk_bf16(v[8 * q + 4].x, v[8 * q + 5].x); o.w = pg8::cvt_pk_bf16(v[8 * q + 6].x, v[8 * q + 7].x);
        *(pg8::u32x4*)(drow + q * 8) = o; }
#pragma unroll
    for (int q = 0; q < 8; ++q) { pg8::u32x4 o;
        o.x = pg8::cvt_pk_bf16(v[8 * q + 0].y, v[8 * q + 1].y); o.y = pg8::cvt_pk_bf16(v[8 * q + 2].y, v[8 * q + 3].y); o.z = pg8::cvt_pk_bf16(v[8 * q + 4].y, v[8 * q + 5].y); o.w = pg8::cvt_pk_bf16(v[8 * q + 6].y, v[8 * q + 7].y);
        *(pg8::u32x4*)(drow + K + q * 8) = o; }
}
__device__ __forceinline__ void phase_econv(const Params& p, int l, float* lds) {
    int tid_ = threadIdx.x; asm volatile("" : "+v"(tid_));
    const int wid = tid_ >> 6, lane = tid_ & 63;
    const int gw = blockIdx.x * 8 + wid, ngw = gridDim.x * 8;
    for (int it = gw; it < 256 * 96; it += ngw) {
        const int e = it / 96, r = it - e * 96;
        if (r < 64) { const int m = r >> 5, nb = (r >> 4) & 1, kb = r & 15, n = nb * 128 + lane * 2;
            const float* w = (m ? p.eu : p.eg) + ((size_t)l * 256 + e) * 1024 * 256;
            const int row = nb * 256 + m * 128 + lane * 2;
            xpose64x2(w + (size_t)kb * 64 * 256 + n, 256, p.Wt_e1 + (size_t)e * 512 * 1024 + (size_t)row * 1024 + kb * 64, 1024);
        } else { const int q = r - 64, nb = q >> 2, kb = q & 3, n = nb * 128 + lane * 2;
            xpose64x2(p.ed + ((size_t)l * 256 + e) * 256 * 1024 + (size_t)kb * 64 * 1024 + n, 1024, p.Wt_e2 + (size_t)e * 1024 * 256 + (size_t)n * 256 + kb * 64, 256); }
    }
}
struct ConvTile { const float* src; size_t rs; bf16_t* dst; bool skip; float f8; };
__device__ __forceinline__ ConvTile conv_tile(const Params& p, int mode, int l, int tile, int n) {
    ConvTile c; c.skip = false; c.f8 = 0.f;
    if (mode == 0) {
        const int e = tile / 48, r = tile - e * 48;
        if (r < 32) { const int m = r >> 4, kb = r & 15; c.src = (m ? p.eu : p.eg) + ((size_t)l * 256 + e) * 1024 * 256 + (size_t)kb * 64 * 256; c.rs = 256;
            c.dst = p.Wt_e1 + (size_t)e * 512 * 1024 + (size_t)((n >> 7) * 256 + m * 128 + (n & 127)) * 1024 + kb * 64; }
        else { const int q = r - 32, nb = q >> 2, kb = q & 3; c.src = p.ed + ((size_t)l * 256 + e) * 256 * 1024 + (size_t)kb * 64 * 1024 + nb * 256; c.rs = 1024;
            c.dst = p.Wt_e2 + (size_t)e * 1024 * 256 + (size_t)(nb * 256 + n) * 256 + kb * 64; }
    } else if (mode == 1) {
        const int ll = tile / 592; int r = tile - ll * 592;
        if (r < 368) { const int nb = r >> 4, kb = r & 15, ns = nb * 256 + n;
            c.skip = (nb == 3 || nb == 4);
            c.src = p.w_in + (size_t)ll * 1024 * IN_W + (size_t)kb * 64 * IN_W + nb * 256; c.rs = IN_W;
            c.dst = (bf16_t*)((unsigned char*)p.Wt_in + (size_t)ll * PW * 1024 + (size_t)(ns < 768 ? ns : ns + 512) * 1024 + kb * 64); c.f8 = 256.f; }
        else if (r < 368 + 96) { const int q = r - 368, br = q >> 5, nb = (q >> 3) & 3, kb = q & 7;
            c.src = (br == 0 ? p.wa : br == 1 ? p.wb : p.wc) + (size_t)ll * 512 * 1024 + (size_t)kb * 64 * 1024 + nb * 256; c.rs = 1024;
            c.dst = (bf16_t*)((unsigned char*)p.Wt_br + ((size_t)ll * 3 + br) * 1024 * 512 + (size_t)(nb * 256 + n) * 512 + kb * 64); c.f8 = 256.f; }
        else if (r < 368 + 96 + 64) { const int q = r - 464, nb = q >> 4, kb = q & 15;
            c.src = p.wout + (size_t)ll * 1024 * 1024 + (size_t)kb * 64 * 1024 + nb * 256; c.rs = 1024;
            c.dst = (bf16_t*)((unsigned char*)p.Wt_out + (size_t)ll * 1024 * 1024 + (size_t)(nb * 256 + n) * 1024 + kb * 64); c.f8 = 512.f; }
        else if (r < 368 + 96 + 64 + 48) { const int q = r - 528, m = q >> 4, kb = q & 15;
            c.src = (m == 0 ? p.wr : m == 1 ? p.sg : p.su) + (size_t)ll * 1024 * 256 + (size_t)kb * 64 * 256; c.rs = 256;
            c.dst = p.Wt_g + (size_t)ll * 768 * 1024 + (size_t)(m == 0 ? n : 256 + (n >> 7) * 256 + (m - 1) * 128 + (n & 127)) * 1024 + kb * 64; }
        else { const int q = r - 576, nb = q >> 2, kb = q & 3;
            c.src = p.sd + (size_t)ll * 256 * 1024 + (size_t)kb * 64 * 1024 + nb * 256; c.rs = 1024;
            c.dst = p.Wt_sd + (size_t)ll * 1024 * 256 + (size_t)(nb * 256 + n) * 256 + kb * 64; }
    } else {
        const int ll = tile >> 6, nb = (tile >> 4) & 3, kb = tile & 15;
        c.src = p.WF + (size_t)ll * 1024 * 1024 + (size_t)kb * 64 * 1024 + nb * 256; c.rs = 1024;
        c.dst = (bf16_t*)((unsigned char*)p.Wt_in + (size_t)ll * PW * 1024 + (size_t)(768 + nb * 256 + n) * 1024 + kb * 64); c.f8 = 64.f;
    }
    return c;
}
__device__ __noinline__ void phase_conv_dma(const Params& p, int mode, int l, int t_begin, int ntiles, int t_step, float* ldsf) {
    const int tid = threadIdx.x, wid = tid >> 6, lane = tid & 63;
    LAS unsigned char* lds = (LAS unsigned char*)ldsf;
    const int kc = lane & 7, nl = wid * 32 + (lane >> 3);
    constexpr int SLOT = 65536 + 128;
    __syncthreads();
    int t = t_begin;
    auto issue = [&](int tile, int slot) {
        const ConvTile c = conv_tile(p, mode, l, tile, 0);
#pragma unroll
        for (int j = 0; j < 8; ++j) { const int row = wid * 8 + j;
            __builtin_amdgcn_global_load_lds((const unsigned*)(c.src + (size_t)row * c.rs + lane * 4), (LAS unsigned*)(lds + slot * SLOT + row * 1024 + wid * 16), 16, 0, 2); }
    };
    if (t < ntiles) issue(t, 0);
    for (int i = 0; t < ntiles; t += t_step, ++i) {
        asm volatile("s_waitcnt vmcnt(0)" ::: "memory");
        __syncthreads();
        if (t + t_step < ntiles) issue(t + t_step, (i + 1) & 1);
        if (conv_tile(p, mode, l, t, 0).skip) continue;
        const LAS float* base = (const LAS float*)(lds + (i & 1) * SLOT) + (kc * 8) * 256 + kc * 4;
#pragma unroll
        for (int it = 0; it < 4; ++it) { const int n = nl + it * 8;
            const ConvTile c = conv_tile(p, mode, l, t, n);
            float x[8];
#pragma unroll
            for (int k = 0; k < 8; ++k) x[k] = base[k * 256 + n];
            if (c.f8 != 0.f) {
                typedef unsigned u32x2e __attribute__((ext_vector_type(2)));
#pragma unroll
                for (int k = 0; k < 8; ++k) x[k] = fminf(fmaxf(x[k] * c.f8, -448.f), 448.f);
                int q0 = 0, q1 = 0;
                q0 = __builtin_amdgcn_cvt_pk_fp8_f32(x[0], x[1], q0, false); q0 = __builtin_amdgcn_cvt_pk_fp8_f32(x[2], x[3], q0, true);
                q1 = __builtin_amdgcn_cvt_pk_fp8_f32(x[4], x[5], q1, false); q1 = __builtin_amdgcn_cvt_pk_fp8_f32(x[6], x[7], q1, true);
                *(GAS u32x2e*)((unsigned char*)c.dst + kc * 8) = (u32x2e){(unsigned)q0, (unsigned)q1};
            } else {
            pg8::u32x4 o;
            o.x = pg8::cvt_pk_bf16(x[0], x[1]); o.y = pg8::cvt_pk_bf16(x[2], x[3]); o.z = pg8::cvt_pk_bf16(x[4], x[5]); o.w = pg8::cvt_pk_bf16(x[6], x[7]);
            __builtin_nontemporal_store(o, (GAS pg8::u32x4*)(c.dst + kc * 8)); } }
    }
    asm volatile("s_waitcnt vmcnt(0)" ::: "memory");
    __syncthreads();
}
__device__ __noinline__ void phase_conv_ring(const Params& p, int l, int chunk, float* ldsf, unsigned* ctr) {
    const int tid = threadIdx.x, wid = tid >> 6, lane = tid & 63;
    LAS unsigned char* lds = (LAS unsigned char*)ldsf;
    const float* const eg_ = uni(p.eg); const float* const eu_ = uni(p.eu); const float* const ed_ = uni(p.ed);
    unsigned char* const w1_ = (unsigned char*)uni(p.Wt_e1); unsigned char* const w2_ = (unsigned char*)uni(p.Wt_e2);
    const int kc = lane & 7, n = wid * 8 + (lane >> 3);
    constexpr int SLOT = 32768 + 128;
    const int t0 = chunk * 8;
    auto issue = [&](int jt) {
        const int tile = t0 + jt, e = tile / 96, r = tile - e * 96;
        const float* src; int rs;
        if (r < 64) { const int m = r >> 5, kb = (r >> 2) & 7, nq = r & 3; src = (m ? eu_ : eg_) + ((size_t)l * 256 + e) * 1024 * 256 + (size_t)kb * 128 * 256 + nq * 64; rs = 256; }
        else { const int q = r - 64, nb = q >> 1, kb = q & 1; src = ed_ + ((size_t)l * 256 + e) * 256 * 1024 + (size_t)kb * 128 * 1024 + nb * 64; rs = 1024; }
#pragma unroll
        for (int q = 0; q < 4; ++q) { const int row = wid * 16 + q * 4 + (lane >> 4);
            __builtin_amdgcn_global_load_lds((const unsigned*)(src + (size_t)row * rs + (lane & 15) * 4), (LAS unsigned*)(lds + (jt & 3) * SLOT + (wid * 16 + q * 4) * 256 + wid * 16), 16, 0, 2); } };
    __syncthreads();
    unsigned kn; asm volatile("v_mov_b32 %0, 0" : "=v"(kn));
    issue(0); issue(1); issue(2);
#pragma unroll
    for (int jt = 0; jt < 8; ++jt) {
        if (jt < 6) asm volatile("s_waitcnt vmcnt(8)" ::: "memory");
        else if (jt == 6) asm volatile("s_waitcnt vmcnt(4)" ::: "memory");
        else asm volatile("s_waitcnt vmcnt(0)" ::: "memory");
        asm volatile("s_waitcnt lgkmcnt(0)" ::: "memory"); __builtin_amdgcn_s_barrier(); asm volatile("" ::: "memory");
        if (jt + 3 < 8) issue(jt + 3);
        if (jt == 5 && ctr != nullptr && tid == 0) kn = __hip_atomic_fetch_add((GAS unsigned*)ctr, 1u, __ATOMIC_RELAXED, __HIP_MEMORY_SCOPE_AGENT);
        const int tile = t0 + jt, e = tile / 96, r = tile - e * 96;
        const LAS float* base = (const LAS float*)(lds + (jt & 3) * SLOT) + (kc * 16) * 64 + kc * 4 + n;
        float x[16];
#pragma unroll
        for (int k = 0; k < 16; ++k) x[k] = fminf(fmaxf(base[k * 64] * 256.f, -448.f), 448.f);
        unsigned char* dst;
        if (r < 64) { const int m = r >> 5, kb = (r >> 2) & 7, nq = r & 3, nn = nq * 64 + n; dst = w1_ + (size_t)e * 512 * 1024 + (size_t)((nn >> 7) * 256 + m * 128 + (nn & 127)) * 1024 + kb * 128; }
        else { const int q = r - 64, nb = q >> 1, kb = q & 1; dst = w2_ + (size_t)e * 1024 * 256 + (size_t)(nb * 64 + n) * 256 + kb * 128; }
        pg8::i32x4 o;
#pragma unroll
        for (int q = 0; q < 4; ++q) { int w8 = 0; w8 = __builtin_amdgcn_cvt_pk_fp8_f32(x[4 * q], x[4 * q + 1], w8, false); w8 = __builtin_amdgcn_cvt_pk_fp8_f32(x[4 * q + 2], x[4 * q + 3], w8, true); o[q] = w8; }
        __builtin_nontemporal_store(o, (GAS pg8::i32x4*)(dst + kc * 16));
    }
    if (ctr != nullptr && tid == 0) *(volatile LAS unsigned*)36 = kn;
    asm volatile("s_waitcnt lgkmcnt(0)" ::: "memory"); __builtin_amdgcn_s_barrier(); asm volatile("" ::: "memory");
}
__device__ __forceinline__ int build_units256(const Params& p, int* ustart  , const int nct, const int c, const int G) {
    int tid_ = threadIdx.x; asm volatile("" : "+v"(tid_));
    const int wid = tid_ >> 6, lane = tid_ & 63;
    __syncthreads();
    if (tid_ <= 256) ustart[320 + tid_] = p.eoff[tid_];
    __syncthreads();
    int cnt = 0;
    if (tid_ < 256) cnt = (ustart[320 + tid_ + 1] - ustart[320 + tid_] + 255) >> 8;
    int incl = cnt;
#pragma unroll
    for (int o = 1; o < 64; o <<= 1) { const int t2 = __builtin_amdgcn_ds_bpermute(((lane - o) & 63) << 2, incl); if (lane >= o) incl += t2; }
    if (tid_ < 256 && lane == 63) ustart[584 + wid] = incl;
    __syncthreads();
    if (tid_ < 256) { int base = 0;
#pragma unroll
        for (int w = 0; w < 3; ++w) base += w < wid ? ustart[584 + w] : 0;
        ustart[tid_] = base + incl - cnt; if (tid_ == 255) ustart[256] = base + incl; }
    __syncthreads();
    const int nub = ustart[256];
    if (tid_ < 32) {
        const int cv = ((c & 7) << 5) | (c >> 3);
        const int uid = tid_ * G + cv; int e = -1, s0 = 0, aux = 0, ct = 0;
        if (uid < nub * nct) { const int ub = uid / nct; ct = uid - ub * nct;
            int lo = 0, hi = 255; while (lo < hi) { const int mid = (lo + hi + 1) >> 1; if (ustart[mid] <= ub) lo = mid; else hi = mid - 1; }
            e = lo; s0 = ustart[320 + e] + (ub - ustart[e]) * 256; aux = ustart[320 + e + 1]; }
        ustart[600 + 4 * tid_] = e; ustart[600 + 4 * tid_ + 1] = s0; ustart[600 + 4 * tid_ + 2] = aux; ustart[600 + 4 * tid_ + 3] = ct; }
    __syncthreads();
    return nub;
}
__device__ __forceinline__ void phase_exp_up_f(const Params& p, int* ustart, float* lds) {
    const int nub = uni(build_units256(p, ustart, 2, blockIdx.x, gridDim.x));
    pg8::ExpOrder S; S.ustart = (const PG8_LAS int*)ustart; S.eoff = uni(p.eoff); S.slot_tok = uni(p.slot_tok); S.nct = 2; S.nun = nub * 2; S.G = gridDim.x; S.c = blockIdx.x; S.gather = true;
    S.A = (const char*)uni(p.u8); S.B = (const char*)uni(p.Wt_e1); S.b_exp = (size_t)512 * 1024; S.b_tile = (size_t)256 * 1024; S.lda_bytes = 1024u;
    pg8::EpiHs E; E.Hs = (unsigned char*)uni(p.Hs); E.slot_w = uni(p.slot_w);
    pg8::gemm_phase<true, true>(LDS_U(lds), 512, 512, 512, S, E);
}
__device__ __forceinline__ void phase_exp_down_f(const Params& p, int* ustart, float* lds) {
    const int nub = uni(build_units256(p, ustart, 4, blockIdx.x, gridDim.x));
    pg8::ExpOrder S; S.ustart = (const PG8_LAS int*)ustart; S.eoff = uni(p.eoff); S.slot_tok = uni(p.slot_tok); S.nct = 4; S.nun = nub * 4; S.G = gridDim.x; S.c = blockIdx.x; S.gather = false;
    S.A = (const char*)uni(p.Hs); S.B = (const char*)uni(p.Wt_e2); S.b_exp = (size_t)1024 * 256; S.b_tile = (size_t)256 * 256; S.lda_bytes = 256u;
    pg8::EpiYs E; E.Ys = (unsigned char*)uni(p.Ys);
    pg8::gemm_phase<false, true>(LDS_U(lds), 128, 128, 128, S, E);
}

__global__ void __launch_bounds__(NTHR, 2) fwd(Params pk) {
    extern __shared__ __attribute__((aligned(16))) unsigned char smem[];
    if (threadIdx.x == 0) *(uint4*)smem = make_uint4(0u, 0u, 0u, 0u);
    Params* ps = (Params*)(smem + 64);
    if (threadIdx.x < sizeof(Params) / 8) ((unsigned long long*)ps)[threadIdx.x] = ((const unsigned long long*)&pk)[threadIdx.x];
    __syncthreads();
    const Params& p = *ps;
    (void)xcd_barrier_post(pk.bar, (volatile LAS unsigned*)smem);
#define GRID_BARRIER() do { XcdBarrier _b; _b.bar = uni(ps->bar); _b.x = xb_xcc_id(); _b.st = (volatile LAS unsigned*)smem; xcd_barrier(_b); } while (0)
    int* ustart = (int*)(smem + 1024);
    float* lds = (float*)(smem + 4096);
    phase_pro(p, lds);
    phase_wprep(p, 0, lds);
    if (blockIdx.x < 192) phase_conv_dma(p, 1, 0, blockIdx.x, 672, 192, lds);
    else phase_conv_dma(p, 1, 0, 672 + (blockIdx.x - 192), 2 * 592, 64, lds);
    GRID_BARRIER();
    phase_conv_dma(p, 2, 0, blockIdx.x, 128, gridDim.x, lds);
    phase_lnmod0(p);
    GRID_BARRIER();
#pragma unroll 1
    for (int l = 0; l < 2; ++l) {
        phase_inproj_f(p, l, lds, false);
        GRID_BARRIER();
        phase_normrope(p, l);
        phase_xt(p, l == 0, lds);
        GRID_BARRIER();
        phase_inproj_f(p, l, lds, true);
        phase_fourier_f(p, l == 0, lds);
        phase_attn_f(p, l, l == 0, smem, lds);
        GRID_BARRIER();
        phase_ygemm_f(p, l, lds);
        if (l == 0 && blockIdx.x >= 32) conv_fill(p, 0, CONV_LIM0, 3, lds);
        GRID_BARRIER();
        phase_outproj_f(p, l, lds);
        if (l == 0 && blockIdx.x >= 32) conv_fill(p, 0, CONV_LIM0, 2, lds);
        GRID_BARRIER();
        phase_ln1(p, l);
        GRID_BARRIER();
        phase_router_shared_f(p, l, lds);
        GRID_BARRIER();
        phase_route(p, l, lds);
        phase_shdown_f(p, l, lds);
        GRID_BARRIER();
        phase_slots(p, l == 1, lds);
        if (l == 0) conv_fill(p, 0, CONV_LIM0, 1 << 20, lds);
        GRID_BARRIER();
        phase_exp_up_f(p, ustart, lds);
        GRID_BARRIER();
        phase_exp_down_f(p, ustart, lds);
        GRID_BARRIER();
        phase_ln2(p, l);
        if (l == 0) GRID_BARRIER();
    }
}

static inline size_t bump(size_t& off, size_t bytes) { const size_t o = off; off = (off + bytes + 255) & ~(size_t)255; return o; }

extern "C" void kernel_launch(void* const* d_in, const int* in_sizes, int n_in, void* d_out, int out_size, void* d_ws, size_t ws_size, hipStream_t stream) {
    static int grid = 0;
    if (grid == 0) {
        int dev = 0, cus = 0, per_cu = 0;
        hipGetDevice(&dev);
        hipDeviceGetAttribute(&cus, hipDeviceAttributeMultiprocessorCount, dev);
        hipFuncSetAttribute((const void*)fwd, hipFuncAttributeMaxDynamicSharedMemorySize, LDS_BYTES);
        hipOccupancyMaxActiveBlocksPerMultiprocessor(&per_cu, (const void*)fwd, NTHR, LDS_BYTES);
        (void)hipGetLastError();
        grid = 256;
        if (cus < 256 || per_cu < 1) fprintf(stderr, "kernel_launch: needs 256 CUs with one resident workgroup each (cus %d, per_cu %d)\n", cus, per_cu);
    }
    Params p{};
    const float* const* in = (const float* const*)d_in;
    p.x = in[0]; p.c = in[1]; p.ctx = in[2]; p.c_ctx = in[3]; p.w_mod = in[4]; p.b_mod = in[5]; p.w_in = in[6]; p.qn = in[7]; p.kn = in[8];
    p.lq1 = in[9]; p.lk1 = in[10]; p.lq2 = in[11]; p.lk2 = in[12]; p.subln = in[13]; p.wa = in[14]; p.wb = in[15]; p.wc = in[16]; p.wout = in[17];
    p.ln1g = in[18]; p.ln1b = in[19]; p.wr = in[20]; p.br = in[21]; p.sg = in[22]; p.su = in[23]; p.sd = in[24]; p.eg = in[25]; p.eu = in[26]; p.ed = in[27];
    p.ln2g = in[28]; p.ln2b = in[29];
    p.out = (float*)d_out;
    char* ws = (char*)d_ws; size_t off = 0;
    p.bar = (unsigned*)(ws + bump(off, XCD_BAR_WORDS * 4));
    p.mod = (float*)(ws + bump(off, (size_t)2 * 9 * 6144 * 4));
    p.WF = (float*)(ws + bump(off, (size_t)2 * 1024 * 1024 * 4));
    p.ropec = (float*)(ws + bump(off, 2048 * 32 * 4)); p.ropes = (float*)(ws + bump(off, 2048 * 32 * 4));
    p.tc = (float*)(ws + bump(off, 2048 * 4)); p.ts = (float*)(ws + bump(off, 2048 * 4));
    p.lam = (float*)(ws + bump(off, 256));
    p.hbuf = (float*)(ws + bump(off, (size_t)T_ALL * DM * 4));
    p.z = (float*)(ws + bump(off, (size_t)T_ALL * DM * 4));
    p.logits = (float*)(ws + bump(off, (size_t)T_ALL * 256 * 4));
    p.f = (float*)(ws + bump(off, (size_t)T_ALL * DM * 4));
    p.slot_w = (float*)(ws + bump(off, (size_t)NSLOT * 4));
    p.rw = (float*)(ws + bump(off, (size_t)T_ALL * 8 * 4));
    p.ridx = (int*)(ws + bump(off, (size_t)T_ALL * 8 * 4));
    p.lrank = (int*)(ws + bump(off, (size_t)256 * 576 * 4));
    p.cntWG = (int*)(ws + bump(off, (size_t)256 * 256 * 4));
    p.slot_tok = (int*)(ws + bump(off, (size_t)NSLOT * 4));
    p.tok_slot = (int*)(ws + bump(off, (size_t)T_ALL * 8 * 4));
    p.eoff = (int*)(ws + bump(off, 257 * 4));
    p.u = (act_t*)(ws + bump(off, (size_t)T_ALL * DM * sizeof(act_t)));
    p.u8 = (unsigned char*)(ws + bump(off, (size_t)T_ALL * DM));
    p.PF = (unsigned char*)(ws + bump(off, (size_t)T_ALL * 1024));
    p.oa = (act_t*)(ws + bump(off, (size_t)T_ALL * 512 * sizeof(act_t)));
    p.ob = (act_t*)(ws + bump(off, (size_t)T_ALL * 512 * sizeof(act_t)));
    p.oc = (act_t*)(ws + bump(off, (size_t)T_ALL * 512 * sizeof(act_t)));
    p.y = (act_t*)(ws + bump(off, (size_t)T_ALL * DM * sizeof(act_t)));
    p.shact = (act_t*)(ws + bump(off, (size_t)T_ALL * 256 * sizeof(act_t)));
    p.Hs = (act_t*)(ws + bump(off, (size_t)(NSLOT + 256) * 256 * sizeof(act_t)));
    p.Wt_e1 = (bf16_t*)(ws + bump(off, (size_t)256 * 512 * 1024 * 2));
    p.Wt_e2 = (bf16_t*)(ws + bump(off, (size_t)256 * 1024 * 256 * 2));
    p.Wt_in = (bf16_t*)(ws + bump(off, (size_t)2 * PW * 1024 * 2));
    p.Wt_br = (bf16_t*)(ws + bump(off, (size_t)2 * 3 * 1024 * 512 * 2));
    p.Wt_out = (bf16_t*)(ws + bump(off, (size_t)2 * 1024 * 1024 * 2));
    p.Wt_g = (bf16_t*)(ws + bump(off, (size_t)2 * 768 * 1024 * 2));
    p.Wt_sd = (bf16_t*)(ws + bump(off, (size_t)2 * 1024 * 256 * 2));
    p.ytmp = (float*)(ws + bump(off, (size_t)T_ALL * DM * 4));
    p.Gq = (unsigned char*)(ws + bump(off, (size_t)T_ALL * 3072));
    p.VTa = (bf16_t*)(ws + bump(off, (size_t)8 * 128 * LTOT * 2)); p.VTc = (bf16_t*)(ws + bump(off, (size_t)8 * 512 * LTOT * 2));
    p.actr = (unsigned*)(ws + bump(off, 256));
    p.De = (bf16_t*)(ws + bump(off, (size_t)1024 * 2048 * 2)); p.Do = (bf16_t*)(ws + bump(off, (size_t)1024 * 2048 * 2)); p.Dc = (bf16_t*)(ws + bump(off, (size_t)256 * 512 * 2));
    p.XTe = (bf16_t*)(ws + bump(off, (size_t)4096 * 2048 * 2)); p.XTo = (bf16_t*)(ws + bump(off, (size_t)4096 * 2048 * 2)); p.XTc = (bf16_t*)(ws + bump(off, (size_t)4096 * 512 * 2));
    const size_t psz = (size_t)T_ALL * PW * sizeof(act_t), ysz = (size_t)NSLOT * DM * sizeof(act_t);
    const size_t shared = bump(off, psz > ysz ? psz : ysz);
    p.P = (act_t*)(ws + shared); p.Ys = (act_t*)(ws + shared);
    if (off > ws_size) { fprintf(stderr, "kernel_launch: workspace too small: need %zu, have %zu\n", off, ws_size); return; }
    hipMemsetAsync(p.bar, 0, XCD_BAR_WORDS * 4, stream);
    hipLaunchKernelGGL(fwd, dim3(grid), dim3(NTHR), LDS_BYTES, stream, p);
}
```
